# Optimizing an MI355X kernel written in HIP

```python
import math
import jax, jax.numpy as jnp
from jax import lax
import numpy as np

D_MODEL = 1024
BATCH = 8
SEQ = 8192
DEPTH = 1

ATTN_HEADS = 8
HEAD_DIM = 64
ATTN_WIDTH = ATTN_HEADS * HEAD_DIM
Q_BLOCK = 128
SSM_GROUP_CH = 16
SSM_GROUPS = 32
SSM_WIDTH = SSM_GROUPS * SSM_GROUP_CH
SSM_STATE = 64
DT_MIN = 1e-3
DT_MAX = 1e-1
NORM_EPS = 1e-6
MASK_VALUE = -1e30
SPLIT_SIZES = (ATTN_WIDTH, ATTN_WIDTH, ATTN_WIDTH, ATTN_HEADS, ATTN_WIDTH,
               SSM_WIDTH, SSM_WIDTH, D_MODEL, D_MODEL)
IN_COLS = 5 * ATTN_WIDTH + ATTN_HEADS + 2 * SSM_WIDTH + 2 * D_MODEL

kernel_name = "fox_s5_gated_hybrid_block"


def rms_norm(x, gain):
    xf = x.astype(jnp.float32)
    y = xf * lax.rsqrt(jnp.mean(xf * xf, axis=-1, keepdims=True) + NORM_EPS)
    return (y * gain.astype(jnp.float32)).astype(x.dtype)


def split_columns(proj):
    parts = []
    start = 0
    for size in SPLIT_SIZES:
        parts.append(proj[..., start:start + size])
        start += size
    return parts


def forgetting_attention(q, k, v, f_logit):
    b, l, _ = q.shape
    nb = l // Q_BLOCK
    to_heads = lambda t: t.reshape(b, l, ATTN_HEADS, HEAD_DIM).transpose(0, 2, 1, 3)
    q, k, v = to_heads(q), to_heads(k), to_heads(v)
    log_f = jax.nn.log_sigmoid(f_logit.astype(jnp.float32))
    cum = jnp.cumsum(log_f, axis=1).transpose(0, 2, 1)
    scale = 1.0 / math.sqrt(HEAD_DIM)
    q_blocks = q.reshape(b, ATTN_HEADS, nb, Q_BLOCK, HEAD_DIM).transpose(2, 0, 1, 3, 4)
    c_blocks = cum.reshape(b, ATTN_HEADS, nb, Q_BLOCK).transpose(2, 0, 1, 3)
    starts = jnp.arange(nb, dtype=jnp.int32) * Q_BLOCK
    k_pos = jnp.arange(l, dtype=jnp.int32)

    def one_block(args):
        q_blk, c_blk, start = args
        s = jnp.einsum('bhqd,bhkd->bhqk', q_blk, k).astype(jnp.float32)
        logits = s * scale + c_blk[..., None] - cum[:, :, None, :]
        q_pos = start + jnp.arange(Q_BLOCK, dtype=jnp.int32)
        causal = k_pos[None, :] <= q_pos[:, None]
        logits = jnp.where(causal[None, None], logits, jnp.float32(MASK_VALUE))
        p = jax.nn.softmax(logits, axis=-1)
        return jnp.einsum('bhqk,bhkd->bhqd', p.astype(v.dtype), v)

    out = lax.map(one_block, (q_blocks, c_blocks, starts))
    return out.transpose(1, 0, 3, 2, 4).reshape(b, l, ATTN_WIDTH)


def _complex_combine(e1, e2):
    a1r, a1i, b1r, b1i = e1
    a2r, a2i, b2r, b2i = e2
    return (a2r * a1r - a2i * a1i,
            a2r * a1i + a2i * a1r,
            a2r * b1r - a2i * b1i + b2r,
            a2r * b1i + a2i * b1r + b2i)


def s5_ssm(u, lam_re, lam_im, log_dt, b_re, b_im, c_re, c_im, d_skip):
    bsz, l, _ = u.shape
    uf = u.astype(jnp.float32).reshape(bsz, l, SSM_GROUPS, SSM_GROUP_CH)
    lr = lam_re.astype(jnp.float32)
    li = lam_im.astype(jnp.float32)
    dt = jnp.exp(log_dt.astype(jnp.float32))[:, None]
    mag = jnp.exp(lr * dt)
    ab_re = mag * jnp.cos(li * dt)
    ab_im = mag * jnp.sin(li * dt)
    den = lr * lr + li * li
    n_re = ab_re - 1.0
    fac_re = (n_re * lr + ab_im * li) / den
    fac_im = (ab_im * lr - n_re * li) / den
    br = b_re.astype(jnp.float32)
    bi = b_im.astype(jnp.float32)
    bb_re = fac_re[..., None] * br - fac_im[..., None] * bi
    bb_im = fac_re[..., None] * bi + fac_im[..., None] * br
    bu_re = jnp.einsum('blgc,gpc->blgp', uf, bb_re)
    bu_im = jnp.einsum('blgc,gpc->blgp', uf, bb_im)
    a_re = jnp.broadcast_to(ab_re, bu_re.shape)
    a_im = jnp.broadcast_to(ab_im, bu_im.shape)
    _, _, s_re, s_im = lax.associative_scan(_complex_combine, (a_re, a_im, bu_re, bu_im), axis=1)
    y = (jnp.einsum('blgp,gcp->blgc', s_re, c_re.astype(jnp.float32))
         - jnp.einsum('blgp,gcp->blgc', s_im, c_im.astype(jnp.float32))
         + d_skip.astype(jnp.float32) * uf)
    return y.reshape(bsz, l, SSM_WIDTH).astype(u.dtype)


def hybrid_layer(x, norm_pre, w_in, b_forget, lam_re, lam_im, log_dt, b_re, b_im,
                 c_re, c_im, d_skip, w_glu, b_glu, w_branch_a, w_branch_s, w_out, norm_post):
    h = rms_norm(x, norm_pre)
    proj = h @ w_in
    q, k, v, f_logit, gate_a, u, gate_s, mix_a, mix_s = split_columns(proj)
    y_a = forgetting_attention(q, k, v, f_logit + b_forget) * jax.nn.silu(gate_a)
    y_s = jax.nn.gelu(s5_ssm(u, lam_re, lam_im, log_dt, b_re, b_im, c_re, c_im, d_skip))
    y_s = y_s * jax.nn.sigmoid(y_s @ w_glu + b_glu)
    y_s = y_s * jax.nn.silu(gate_s)
    merged = jax.nn.sigmoid(mix_a) * (y_a @ w_branch_a) + jax.nn.sigmoid(mix_s) * (y_s @ w_branch_s)
    out = merged @ w_out
    return x + rms_norm(out, norm_post)


def setup_inputs(seed: int = 0) -> dict:
    key = jax.random.key(seed)
    ks = jax.random.split(key, 20)
    f32 = jnp.float32
    nrm = lambda k, shape, s: jax.random.normal(k, shape, f32) * s
    G, P, C = SSM_GROUPS, SSM_STATE, SSM_GROUP_CH
    x = jax.random.normal(ks[0], (BATCH, SEQ, D_MODEL), f32)
    norm_pre = 1.0 + nrm(ks[1], (DEPTH, D_MODEL), 0.01)
    w_in = nrm(ks[2], (DEPTH, D_MODEL, IN_COLS), D_MODEL ** -0.5)
    b_forget = 2.0 + nrm(ks[3], (DEPTH, ATTN_HEADS), 0.5)
    n_idx = jnp.arange(P, dtype=f32)
    lam_re = -0.5 + nrm(ks[4], (DEPTH, G, P), 0.01)
    lam_im = jnp.pi * n_idx + nrm(ks[5], (DEPTH, G, P), 0.01)
    log_dt = jax.random.uniform(ks[6], (DEPTH, G), f32, math.log(DT_MIN), math.log(DT_MAX))
    b_re = nrm(ks[7], (DEPTH, G, P, C), (2 * C) ** -0.5)
    b_im = nrm(ks[8], (DEPTH, G, P, C), (2 * C) ** -0.5)
    c_re = nrm(ks[9], (DEPTH, G, C, P), P ** -0.5)
    c_im = nrm(ks[10], (DEPTH, G, C, P), P ** -0.5)
    d_skip = nrm(ks[11], (DEPTH, G, C), 1.0)
    w_glu = nrm(ks[12], (DEPTH, SSM_WIDTH, SSM_WIDTH), SSM_WIDTH ** -0.5)
    b_glu = nrm(ks[13], (DEPTH, SSM_WIDTH), 0.01)
    w_branch_a = nrm(ks[14], (DEPTH, ATTN_WIDTH, D_MODEL), ATTN_WIDTH ** -0.5)
    w_branch_s = nrm(ks[15], (DEPTH, SSM_WIDTH, D_MODEL), SSM_WIDTH ** -0.5)
    w_out = nrm(ks[16], (DEPTH, D_MODEL, D_MODEL), D_MODEL ** -0.5)
    norm_post = 1.0 + nrm(ks[17], (DEPTH, D_MODEL), 0.01)
    return {"x": x, "norm_pre": norm_pre, "w_in": w_in, "b_forget": b_forget,
            "lam_re": lam_re, "lam_im": lam_im, "log_dt": log_dt, "b_re": b_re, "b_im": b_im,
            "c_re": c_re, "c_im": c_im, "d_skip": d_skip, "w_glu": w_glu, "b_glu": b_glu,
            "w_branch_a": w_branch_a, "w_branch_s": w_branch_s, "w_out": w_out,
            "norm_post": norm_post}


def reference(x, norm_pre, w_in, b_forget, lam_re, lam_im, log_dt, b_re, b_im, c_re, c_im,
              d_skip, w_glu, b_glu, w_branch_a, w_branch_s, w_out, norm_post):
    for l in range(DEPTH):
        x = hybrid_layer(x, norm_pre[l], w_in[l], b_forget[l], lam_re[l], lam_im[l], log_dt[l],
                         b_re[l], b_im[l], c_re[l], c_im[l], d_skip[l], w_glu[l], b_glu[l],
                         w_branch_a[l], w_branch_s[l], w_out[l], norm_post[l])
    return x
```

```cpp
#include <hip/hip_runtime.h>
#include <hip/hip_cooperative_groups.h>
#include <hip/hip_bf16.h>
#include <cstdio>
#include <cstdint>
#include <cmath>
namespace cg = cooperative_groups;

#ifndef MK_MULTI
#define MK_MULTI 0
#endif

namespace pg8 {
#define PG8_LAS __attribute__((address_space(3)))
typedef unsigned short bf16_t;
typedef short bf16x8 __attribute__((ext_vector_type(8)));
typedef float f32x4 __attribute__((ext_vector_type(4)));
typedef unsigned u32x4 __attribute__((ext_vector_type(4)));
constexpr int BM = 256, BK = 64, HALF = 128, HTB = HALF * BK * 2, STAGE_BYTES = 8 * HTB, NXCD = 8, WGM = 8;

__host__ __device__ __forceinline__ int lds_byte(int r, int c) { const int st = (r >> 4) * 2 + (c >> 5), rr = r & 15, cc = c & 31, ob = rr * 64 + cc * 2; return st * 1024 + (ob ^ (((ob >> 9) & 1) << 5)); }
__host__ __device__ __forceinline__ void stage_rc(int b, int& R, int& C) { const int st = b / 1024, sb = b % 1024, swz = sb ^ (((sb >> 9) & 1) << 5); R = (st >> 1) * 16 + swz / 64; C = (st & 1) * 32 + (swz % 64) / 2; }
__host__ __device__ __forceinline__ int perm32(int rho) { const int n = rho >> 4, i = rho & 15; return 8 * (i >> 2) + 4 * n + (i & 3); }

struct Unit { int pm, pn, z; };
struct Gemm { const bf16_t* A; const bf16_t* Bt; int K, lda, ldb; long zsA, zsB; const bf16_t* A2; const bf16_t* Bt2; int ksplit; long cgA; };

__device__ __forceinline__ void swz_map(int L, int nM, int nN, int& pm, int& pn) {
    const int nwg = nM * nN; int wgid = L; { const int q = nwg / NXCD, r = nwg % NXCD, xcd = wgid % NXCD, off = wgid / NXCD; wgid = (xcd < r ? xcd * (q + 1) : r * (q + 1) + (xcd - r) * q) + off; }
    const int nig = WGM * nN, gid = wgid / nig, fm = gid * WGM, gsz = (nM - fm) < WGM ? (nM - fm) : WGM;
    pm = fm + ((wgid % nig) % gsz); pn = (wgid % nig) / gsz;
}
struct TileOrder {
    int nM, nN, nz, G, c, swz;
    __device__ __forceinline__ bool next(int i, Unit& u) const {
        const long L = (long)i * G + c; const int per = nM * nN; if (L >= (long)per * nz) return false;
        const int z = (int)(L / per), l = (int)(L % per); u.z = z;
        if (swz) swz_map(l, nM, nN, u.pm, u.pn); else { u.pm = l % nM; u.pn = l / nM; }
        return true;
    }
    __device__ __forceinline__ int nt(const Unit&, int K) const { return K / BK; }
};
struct SsmYOrder {
    int G, c;
    __device__ __forceinline__ bool next(int i, Unit& u) const {
        const long L = (long)i * G + c; if (L >= 32 * 16) return false;
        u.z = (int)(L >> 4); const int l = (int)(L & 15); u.pm = l & 3; u.pn = (i & 1) ? 3 - (l >> 2) : (l >> 2); return true;
    }
    __device__ __forceinline__ int nt(const Unit& u, int) const { return 6 + 4 * u.pn; }
};
struct PassOrder {
    int nM, nN, G, c;
    __device__ __forceinline__ bool next(int i, Unit& u) const {
        const long L = (long)(i >> 1) * G + c; if (L >= (long)nM * nN) return false;
        u.z = i & 1; swz_map((int)L, nM, nN, u.pm, u.pn); return true;
    }
    __device__ __forceinline__ int nt(const Unit&, int K) const { return K / BK; }
};

__device__ __forceinline__ unsigned cvt_pk_bf16(float lo, float hi) { unsigned r; asm volatile("v_cvt_pk_bf16_f32 %0, %1, %2" : "=v"(r) : "v"(lo), "v"(hi)); return r; }
__device__ __forceinline__ float bf_lo(unsigned w) { return __uint_as_float(w << 16); }
__device__ __forceinline__ float bf_hi(unsigned w) { return __uint_as_float(w & 0xffff0000u); }
__device__ __forceinline__ float sigm(float v) { return __builtin_amdgcn_rcpf(1.0f + __expf(-v)); }

template <class Epi, class Sched>
__device__ __forceinline__ void gemm_phase(PG8_LAS unsigned char* lds, const Gemm g, const Sched& S, const Epi& E) {
    const int tid = threadIdx.x, wid = __builtin_amdgcn_readfirstlane(tid >> 6), lane = tid & 63, wr = wid >> 2, wc = wid & 3, fr = lane & 15, fq = lane >> 4;
    unsigned voffA[2], voffB[2];
#pragma unroll
    for (int i = 0; i < 2; ++i) { int R, C; stage_rc(tid * 16 + i * 8192, R, C); const int Rb = (R & ~31) + perm32(R & 31);
        voffA[i] = (unsigned)(R * g.lda + (C & 15) + (long)(C >> 4) * g.cgA) * 2u; voffB[i] = (unsigned)(Rb * g.ldb + C) * 2u; }
    const size_t kstepA = (size_t)(4 * g.cgA * 2), kstepB = (size_t)(BK * 2);
    const size_t hstepA = (size_t)HALF * g.lda * 2, hstepB = (size_t)HALF * g.ldb * 2;
    const size_t tstepA = 2 * hstepA, tstepB = 2 * hstepB;
    const unsigned ldsw = (unsigned)wid * 1024u;
    const int aoff = lds_byte(wr * 64 + fr, fq * 8), boff = lds_byte(wc * 32 + fr, fq * 8);
#define PG8_SA(b, h) (((b) * 2 + (h)) * HTB)
#define PG8_SB(b, h) ((4 + (b) * 2 + (h)) * HTB)
#define PG8_STAGE(bufoff, gbase, voff) do { _Pragma("unroll") for (int _i = 0; _i < 2; ++_i) \
        __builtin_amdgcn_global_load_lds((const unsigned*)((const char*)(gbase) + (voff)[_i]), (PG8_LAS unsigned*)(lds + (bufoff) + ldsw + _i * 8192), 16, 0, 0); } while (0)
#define PG8_LDA(dst, b, h) do { _Pragma("unroll") for (int m = 0; m < 4; ++m) _Pragma("unroll") for (int k = 0; k < 2; ++k) dst[m][k] = *(const PG8_LAS bf16x8*)(lds + PG8_SA(b, h) + aoff + m * 2048 + k * 1024); } while (0)
#define PG8_LDB(dst, b, h) do { _Pragma("unroll") for (int n = 0; n < 2; ++n) _Pragma("unroll") for (int k = 0; k < 2; ++k) dst[n][k] = *(const PG8_LAS bf16x8*)(lds + PG8_SB(b, h) + boff + n * 2048 + k * 1024); } while (0)
#define PG8_MMA(ai, bj, At, Bt) do { __builtin_amdgcn_s_setprio(1); _Pragma("unroll") for (int m = 0; m < 4; ++m) _Pragma("unroll") for (int n = 0; n < 2; ++n) _Pragma("unroll") for (int k = 0; k < 2; ++k) \
        acc[ai][bj][m][n] = __builtin_amdgcn_mfma_f32_16x16x32_bf16(Bt[n][k], At[m][k], acc[ai][bj][m][n], 0, 0, 0); __builtin_amdgcn_s_setprio(0); } while (0)
#define PG8_WAIT_V(n) asm volatile("s_waitcnt vmcnt(" #n ")" ::: "memory")
#define PG8_WAIT_L(n) asm volatile("s_waitcnt lgkmcnt(" #n ")" ::: "memory")
#define PG8_BAR __builtin_amdgcn_s_barrier()
#define PG8_SCHED __builtin_amdgcn_sched_barrier(0)
    Unit cur, nxt; int ui = 0;
    if (!S.next(0, cur)) return;
    f32x4 acc[2][2][4][2];
#pragma unroll
    for (int a = 0; a < 2; ++a)
#pragma unroll
        for (int b = 0; b < 2; ++b)
#pragma unroll
            for (int m = 0; m < 4; ++m)
#pragma unroll
                for (int n = 0; n < 2; ++n) acc[a][b][m][n] = (f32x4){0.f, 0.f, 0.f, 0.f};
    bf16x8 At[4][2], B0[2][2], B1[2][2];
    const char* cA = (const char*)(g.A + (size_t)cur.z * g.zsA) + (size_t)cur.pm * tstepA; const char* cB = (const char*)(g.Bt + (size_t)cur.z * g.zsB) + (size_t)cur.pn * tstepB;
    PG8_STAGE(PG8_SB(0, 0), cB, voffB); PG8_STAGE(PG8_SB(0, 1), cB + hstepB, voffB); PG8_STAGE(PG8_SA(0, 0), cA, voffA); PG8_STAGE(PG8_SA(0, 1), cA + hstepA, voffA);
    if (wr == 1) PG8_BAR;
    PG8_WAIT_V(2); PG8_BAR;
    PG8_STAGE(PG8_SB(1, 0), cB + kstepB, voffB); PG8_STAGE(PG8_SA(1, 0), cA + kstepA, voffA); PG8_STAGE(PG8_SB(1, 1), cB + hstepB + kstepB, voffB);
    PG8_WAIT_V(6); PG8_BAR;
    for (;;) {
        const bool has_next = S.next(ui + 1, nxt);
        const int nt = S.nt(cur, g.K);
        const char* nA = has_next ? (const char*)(g.A + (size_t)nxt.z * g.zsA) + (size_t)nxt.pm * tstepA : cA; const char* nB = has_next ? (const char*)(g.Bt + (size_t)nxt.z * g.zsB) + (size_t)nxt.pn * tstepB : cB;
        const int ks = g.ksplit;
        const char* cA2 = ks ? (const char*)g.A2 + (size_t)cur.pm * tstepA - (size_t)ks * kstepA : cA; const char* cB2 = ks ? (const char*)g.Bt2 + (size_t)cur.pn * tstepB - (size_t)ks * kstepB : cB;
        for (int t = 0; t < nt; t += 2) {
            const bool last = (t == nt - 2);
            if constexpr (Epi::HAS_MID) { if (t == ks) E.mid(acc, cur, wr, wc, fr, fq); }
            const bool s1 = ks && (t + 1 >= ks), s2 = ks && (t + 2 >= ks);
            const char* a1 = (s1 ? cA2 : cA) + (size_t)(t + 1) * kstepA;
            const char* a2 = last ? nA : (s2 ? cA2 : cA) + (size_t)(t + 2) * kstepA; const char* b2 = last ? nB : (s2 ? cB2 : cB) + (size_t)(t + 2) * kstepB;
            const char* a3 = a2 + kstepA; const char* b3 = b2 + kstepB;
            PG8_LDB(B0, 0, 0); PG8_LDB(B1, 0, 1); PG8_SCHED; PG8_LDA(At, 0, 0); PG8_STAGE(PG8_SA(1, 1), a1 + hstepA, voffA);
            PG8_WAIT_V(8); PG8_WAIT_L(0); PG8_BAR; PG8_MMA(0, 0, At, B0); PG8_MMA(0, 1, At, B1); PG8_BAR; PG8_SCHED;
            PG8_LDA(At, 0, 1); PG8_STAGE(PG8_SB(0, 0), b2, voffB); PG8_STAGE(PG8_SB(0, 1), b2 + hstepB, voffB); PG8_STAGE(PG8_SA(0, 0), a2, voffA);
            PG8_WAIT_V(8); PG8_WAIT_L(0); PG8_BAR; PG8_MMA(1, 0, At, B0); PG8_MMA(1, 1, At, B1); PG8_BAR; PG8_SCHED;
            PG8_LDB(B0, 1, 0); PG8_LDB(B1, 1, 1); PG8_SCHED; PG8_LDA(At, 1, 0); PG8_STAGE(PG8_SA(0, 1), a2 + hstepA, voffA);
            PG8_WAIT_V(8); PG8_WAIT_L(0); PG8_BAR; PG8_MMA(0, 0, At, B0); PG8_MMA(0, 1, At, B1); PG8_BAR; PG8_SCHED;
            PG8_LDA(At, 1, 1); PG8_STAGE(PG8_SB(1, 0), b3, voffB); PG8_STAGE(PG8_SB(1, 1), b3 + hstepB, voffB); PG8_STAGE(PG8_SA(1, 0), a3, voffA);
            PG8_WAIT_V(8); PG8_WAIT_L(0); PG8_BAR; PG8_MMA(1, 0, At, B0); PG8_MMA(1, 1, At, B1); PG8_BAR; PG8_SCHED;
        }
        if (wr == 0) PG8_BAR;
        E(acc, cur, wr, wc, fr, fq);
        if (!has_next) break;
#pragma unroll
        for (int a = 0; a < 2; ++a)
#pragma unroll
            for (int b = 0; b < 2; ++b)
#pragma unroll
                for (int m = 0; m < 4; ++m)
#pragma unroll
                    for (int n = 0; n < 2; ++n) acc[a][b][m][n] = (f32x4){0.f, 0.f, 0.f, 0.f};
        cur = nxt; cA = nA; cB = nB; ++ui;
        if (wr == 1) PG8_BAR;
    }
    PG8_WAIT_V(0);
    PG8_BAR;
#undef PG8_SA
#undef PG8_SB
#undef PG8_STAGE
#undef PG8_LDA
#undef PG8_LDB
#undef PG8_MMA
#undef PG8_WAIT_V
#undef PG8_WAIT_L
#undef PG8_BAR
#undef PG8_SCHED
}
}

using pg8::bf16_t; using pg8::f32x4; using pg8::u32x4; using pg8::Unit; using pg8::cvt_pk_bf16; using pg8::bf_lo; using pg8::bf_hi; using pg8::sigm;
#define LAS __attribute__((address_space(3)))

constexpr int BATCH = 8, SEQ = 8192, DM = 1024, MTOK = BATCH * SEQ;
constexpr int NH = 8, HD = 64, AW = 512, SW = 512, NG = 32, GC = 16, NP = 64;
constexpr int INC = 5640;
constexpr int NPROJ = 5120;
constexpr int CH = 64, NCHK = MTOK / CH;
constexpr int KX = 1152;
constexpr float C2 = 0.125f * 1.4426950408889634f;
constexpr float LOG2E = 1.4426950408889634f;
constexpr float SKIP_LOG2 = 40.0f;

constexpr size_t MiB = 1u << 20;
constexpr size_t WS_SUMSQ = 0;
constexpr size_t WS_NRM = 512 * 1024;
constexpr size_t WS_LAM64 = 520 * 1024;
constexpr size_t WS_CNT = 576 * 1024;
constexpr size_t WS_BAR = 640 * 1024;
constexpr size_t WS_WIN = 1 * MiB;
constexpr size_t WS_WGLU = 11 * MiB;
constexpr size_t WS_WA = 12 * MiB;
constexpr size_t WS_WS = 13 * MiB;
constexpr size_t WS_WOUT = 14 * MiB;
constexpr size_t WS_LOGF = 16 * MiB;
constexpr size_t WS_CUM = 18 * MiB;
constexpr size_t WS_WEND = 20 * MiB;
constexpr size_t WS_E = 36 * MiB;
constexpr size_t WS_TZ = 52 * MiB;
constexpr size_t WS_U2 = 124 * MiB;
constexpr size_t WS_H = 196 * MiB;
constexpr size_t WS_YA = WS_H, WS_YS = WS_H + 64 * MiB;
constexpr size_t WS_Q = 324 * MiB, WS_K = 388 * MiB, WS_V = 452 * MiB, WS_GA = 516 * MiB, WS_GS = 580 * MiB;
constexpr size_t WS_MERGED = WS_Q;
constexpr size_t WS_MIXA = 644 * MiB, WS_MIXS = 772 * MiB;
constexpr size_t WS_PRE = WS_MIXA;
constexpr size_t WS_YS2 = 900 * MiB;
constexpr size_t WS_END = 964 * MiB;

constexpr int LDS_BYTES = 147456;

struct Params {
    const float *x, *norm_pre, *w_in, *b_forget, *lam_re, *lam_im, *log_dt, *b_re, *b_im, *c_re, *c_im, *d_skip, *w_glu, *b_glu, *w_a, *w_s, *w_out, *norm_post;
    float* out; unsigned char* ws; int ph_lo, ph_hi;
};

#define EPI_LOOP_BEGIN \
    _Pragma("unroll") for (int ai = 0; ai < 2; ++ai) _Pragma("unroll") for (int m = 0; m < 4; ++m) { const int row = u.pm * 256 + ai * 128 + wr * 64 + m * 16 + fr; \
    _Pragma("unroll") for (int bj = 0; bj < 2; ++bj) { const int ct = bj * 128 + wc * 32 + 8 * fq; f32x4 v0 = acc[ai][bj][m][0], v1 = acc[ai][bj][m][1];
#define EPI_LOOP_END } }
__device__ __forceinline__ u32x4 pack8(f32x4 a, f32x4 b) { u32x4 w; w.x = cvt_pk_bf16(a[0], a[1]); w.y = cvt_pk_bf16(a[2], a[3]); w.z = cvt_pk_bf16(b[0], b[1]); w.w = cvt_pk_bf16(b[2], b[3]); return w; }
__device__ __forceinline__ void unpack8(u32x4 w, f32x4& a, f32x4& b) { a = (f32x4){bf_lo(w.x), bf_hi(w.x), bf_lo(w.y), bf_hi(w.y)}; b = (f32x4){bf_lo(w.z), bf_hi(w.z), bf_lo(w.w), bf_hi(w.w)}; }

struct EpiProj {
    static constexpr bool HAS_MID = false;
    unsigned char* ws;
    __device__ __forceinline__ void operator()(const f32x4 (&acc)[2][2][4][2], const Unit& u, int wr, int wc, int fr, int fq) const {
        const int pn = u.pn;
        int act = 0, pitch = 512, cb = (pn & 1) * 256; size_t off; float sc = 1.f;
        if (pn < 2) { off = WS_Q; sc = C2; } else if (pn < 4) off = WS_K; else if (pn < 6) off = WS_V; else if (pn < 8) { off = WS_GA; act = 1; }
        else if (pn < 10) { off = WS_U2; act = 3; } else if (pn < 12) { off = WS_GS; act = 1; }
        else {
            bf16_t* RA = (bf16_t*)(ws + WS_MIXA); bf16_t* SS = (bf16_t*)(ws + WS_MIXS);
#pragma unroll
            for (int ai = 0; ai < 2; ++ai)
#pragma unroll
                for (int m = 0; m < 4; ++m) { const int row = u.pm * 256 + ai * 128 + wr * 64 + m * 16 + fr; const size_t o = (size_t)row * DM + (pn - 12) * 128 + wc * 32 + 8 * fq;
                    f32x4 r0, r1, s0, s1;
#pragma unroll
                    for (int e = 0; e < 4; ++e) {
                        const float ea0 = __expf(-fmaxf(acc[ai][0][m][0][e], -30.f)), ea1 = __expf(-fmaxf(acc[ai][0][m][1][e], -30.f));
                        const float es0 = __expf(-fmaxf(acc[ai][1][m][0][e], -30.f)), es1 = __expf(-fmaxf(acc[ai][1][m][1][e], -30.f));
                        r0[e] = (1.f + es0) * __builtin_amdgcn_rcpf(1.f + ea0); r1[e] = (1.f + es1) * __builtin_amdgcn_rcpf(1.f + ea1);
                        s0[e] = __builtin_amdgcn_rcpf(1.f + es0); s1[e] = __builtin_amdgcn_rcpf(1.f + es1); }
                    *(u32x4*)(RA + o) = pack8(r0, r1); *(u32x4*)(SS + o) = pack8(s0, s1); }
            return;
        }
        bf16_t* base = (bf16_t*)(ws + off);
        float mx0 = 0.f, mx1 = 0.f;
        EPI_LOOP_BEGIN
            v0 = v0 * sc; v1 = v1 * sc;
            if (act == 1) {
#pragma unroll
                for (int e = 0; e < 4; ++e) { v0[e] = v0[e] * sigm(v0[e]); v1[e] = v1[e] * sigm(v1[e]); }
            } else if (act == 2) {
#pragma unroll
                for (int e = 0; e < 4; ++e) { v0[e] = sigm(fmaxf(v0[e], -30.f)); v1[e] = sigm(fmaxf(v1[e], -30.f)); }
            }
            const u32x4 w = pack8(v0, v1);
            if (act == 3) { const int cu = cb + ct, gg = cu >> 4, c0 = cu & 15; *(u32x4*)(base + ((size_t)(gg * NCHK + (row >> 6)) * KX + 128 + (row & 63) * 16 + c0)) = w; }
            else *(u32x4*)(base + (size_t)row * pitch + cb + ct) = w;
            if (pn < 4) {
                float s = (v0[0] * v0[0] + v0[1] * v0[1]) + (v0[2] * v0[2] + v0[3] * v0[3]) + (v1[0] * v1[0] + v1[1] * v1[1]) + (v1[2] * v1[2] + v1[3] * v1[3]);
                s += __shfl_xor(s, 16); s += __shfl_xor(s, 32);
                if (bj == 0) mx0 = fmaxf(mx0, s); else mx1 = fmaxf(mx1, s);
            }
        EPI_LOOP_END
        if (pn < 4) {
#pragma unroll
            for (int o = 1; o < 16; o <<= 1) { mx0 = fmaxf(mx0, __shfl_xor(mx0, o)); mx1 = fmaxf(mx1, __shfl_xor(mx1, o)); }
            if ((threadIdx.x & 63) == 0) {
                unsigned* nrm = (unsigned*)(ws + WS_NRM); const int b = u.pm >> 5, which = (pn >> 1) * 2 + (wc & 1);
                const int h0 = (pn & 1) * 4 + (wc >> 1), h1 = h0 + 2;
                atomicMax(nrm + (b * 8 + h0) * 4 + which, __float_as_uint(mx0 * 1.02f));
                atomicMax(nrm + (b * 8 + h1) * 4 + which, __float_as_uint(mx1 * 1.02f));
            }
        }
    }
};
struct EpiSsmE {
    static constexpr bool HAS_MID = false;
    float* E;
    __device__ __forceinline__ void operator()(const f32x4 (&acc)[2][2][4][2], const Unit& u, int wr, int wc, int fr, int fq) const {
        EPI_LOOP_BEGIN
            if (bj == 0) { float* p = E + ((size_t)(u.z * NCHK + row) * 128 + ct); *(f32x4*)p = v0; *(f32x4*)(p + 4) = v1; }
        EPI_LOOP_END
    }
};
__device__ __forceinline__ float gelu_t(float x) { const float y = 0.7978845608028654f * (x + 0.044715f * x * x * x); return x * sigm(2.0f * y); }
struct EpiSsmY {
    static constexpr bool HAS_MID = false;
    bf16_t* YS;
    __device__ __forceinline__ void operator()(const f32x4 (&acc)[2][2][4][2], const Unit& u, int wr, int wc, int fr, int fq) const {
        EPI_LOOP_BEGIN
#pragma unroll
            for (int e = 0; e < 4; ++e) { v0[e] = gelu_t(v0[e]); v1[e] = gelu_t(v1[e]); }
            const int j = u.pn * 256 + ct, t = j >> 4, c0 = j & 15;
            *(u32x4*)(YS + (((size_t)u.z * MTOK + row * CH + t) * 16 + c0)) = pack8(v0, v1);
        EPI_LOOP_END
    }
};
struct EpiGlu {
    static constexpr bool HAS_MID = false;
    const bf16_t* YS; const bf16_t* GS; const float* bias; bf16_t* O;
    __device__ __forceinline__ void operator()(const f32x4 (&acc)[2][2][4][2], const Unit& u, int wr, int wc, int fr, int fq) const {
        EPI_LOOP_BEGIN
            const int col = u.pn * 256 + ct; const size_t o = (size_t)row * SW + col;
            const f32x4 b0 = *(const f32x4*)(bias + col), b1 = *(const f32x4*)(bias + col + 4);
            f32x4 y0, y1, g0, g1; unpack8(*(const u32x4*)(YS + (((size_t)(col >> 4) * MTOK + row) * 16 + (col & 15))), y0, y1); unpack8(*(const u32x4*)(GS + o), g0, g1);
#pragma unroll
            for (int e = 0; e < 4; ++e) { v0[e] = y0[e] * sigm(v0[e] + b0[e]) * g0[e]; v1[e] = y1[e] * sigm(v1[e] + b1[e]) * g1[e]; }
            *(u32x4*)(O + o) = pack8(v0, v1);
        EPI_LOOP_END
    }
};
struct EpiMerge {
    static constexpr bool HAS_MID = true;
    const bf16_t* MA; const bf16_t* MS; bf16_t* O;
    __device__ __forceinline__ void mid(f32x4 (&acc)[2][2][4][2], const Unit& u, int wr, int wc, int fr, int fq) const {
        __builtin_amdgcn_sched_barrier(0);
        unsigned o0 = (unsigned)((u.pm * 256 + wr * 64 + fr) * DM + u.pn * 256 + wc * 32 + 8 * fq);
        asm volatile("" : "+v"(o0));
#pragma unroll
        for (int ai = 0; ai < 2; ++ai) { u32x4 rr[2][4];
#pragma unroll
            for (int bj = 0; bj < 2; ++bj)
#pragma unroll
                for (int m = 0; m < 4; ++m) rr[bj][m] = *(const u32x4*)(MA + (o0 + (unsigned)((ai * 128 + m * 16) * DM + bj * 128)));
#pragma unroll
            for (int bj = 0; bj < 2; ++bj)
#pragma unroll
                for (int m = 0; m < 4; ++m) { f32x4 a0, a1; unpack8(rr[bj][m], a0, a1); acc[ai][bj][m][0] *= a0; acc[ai][bj][m][1] *= a1; }
            __builtin_amdgcn_sched_barrier(0); }
    }
    __device__ __forceinline__ void operator()(const f32x4 (&acc)[2][2][4][2], const Unit& u, int wr, int wc, int fr, int fq) const {
        unsigned o0 = (unsigned)((u.pm * 256 + wr * 64 + fr) * DM + u.pn * 256 + wc * 32 + 8 * fq);
#pragma unroll
        for (int ai = 0; ai < 2; ++ai) { u32x4 gg[2][4];
#pragma unroll
            for (int bj = 0; bj < 2; ++bj)
#pragma unroll
                for (int m = 0; m < 4; ++m) gg[bj][m] = *(const u32x4*)(MS + (o0 + (unsigned)((ai * 128 + m * 16) * DM + bj * 128)));
#pragma unroll
            for (int bj = 0; bj < 2; ++bj)
#pragma unroll
                for (int m = 0; m < 4; ++m) { f32x4 s0, s1; unpack8(gg[bj][m], s0, s1);
                    *(u32x4*)(O + (o0 + (unsigned)((ai * 128 + m * 16) * DM + bj * 128))) = pack8(acc[ai][bj][m][0] * s0, acc[ai][bj][m][1] * s1); }
            __builtin_amdgcn_sched_barrier(0); }
    }
};
struct EpiOut {
    static constexpr bool HAS_MID = false;
    bf16_t* pre; float* sumsq;
    __device__ __forceinline__ void operator()(const f32x4 (&acc)[2][2][4][2], const Unit& u, int wr, int wc, int fr, int fq) const {
#pragma unroll
        for (int ai = 0; ai < 2; ++ai)
#pragma unroll
            for (int m = 0; m < 4; ++m) { const int row = u.pm * 256 + ai * 128 + wr * 64 + m * 16 + fr; float s = 0.f;
#pragma unroll
                for (int bj = 0; bj < 2; ++bj) { const f32x4 v0 = acc[ai][bj][m][0], v1 = acc[ai][bj][m][1];
                    *(u32x4*)(pre + (size_t)row * DM + u.pn * 256 + bj * 128 + wc * 32 + 8 * fq) = pack8(v0, v1);
                    s += (v0[0] * v0[0] + v0[1] * v0[1]) + (v0[2] * v0[2] + v0[3] * v0[3]) + (v1[0] * v1[0] + v1[1] * v1[1]) + (v1[2] * v1[2] + v1[3] * v1[3]); }
                s += __shfl_xor(s, 16); s += __shfl_xor(s, 32);
                if (fq == 0) atomicAdd(sumsq + row, s); }
    }
};

namespace att {
#define LBAR() asm volatile("s_waitcnt lgkmcnt(0)\n\ts_barrier" ::: "memory")
typedef short bf16x8 __attribute__((ext_vector_type(8)));
typedef short s16x4 __attribute__((ext_vector_type(4)));
typedef float f32x16 __attribute__((ext_vector_type(16)));
constexpr int SLOTB = 8192;
constexpr int L_K = 0, L_V = 2 * SLOTB, L_B = 5 * SLOTB, L_WS = L_B + 512,
                         L_CNT = L_WS + 2048, L_OST = L_CNT + 128;
static_assert(L_OST + 8 * 8192 <= 131072, "attention LDS");
__device__ __forceinline__ int crow(int r, int hi) { return (r & 3) + 8 * (r >> 2) + 4 * hi; }
typedef float f32x2_t __attribute__((ext_vector_type(2))); typedef __bf16 bf16x2_t __attribute__((ext_vector_type(2)));
__device__ __forceinline__ unsigned cvtpk_s(float lo, float hi) { f32x2_t v = {lo, hi}; bf16x2_t b = __builtin_convertvector(v, bf16x2_t); return __builtin_bit_cast(unsigned, b); }
__device__ __forceinline__ float rowmax(const f32x16& p0, const f32x16& p1) {
    float a = fmaxf(p0[0], p1[0]);
#pragma unroll
    for (int r = 1; r < 16; ++r) a = fmaxf(a, fmaxf(p0[r], p1[r]));
    auto rr = __builtin_amdgcn_permlane32_swap(__float_as_uint(a), __float_as_uint(a), false, false);
    return fmaxf(__uint_as_float(rr[0]), __uint_as_float(rr[1]));
}
__device__ __forceinline__ void pv(f32x16* o, int vb, bf16x8 pa0, bf16x8 pa1, bf16x8 pa2, bf16x8 pa3) {
#pragma unroll
    for (int d0 = 0; d0 < 2; ++d0) { s16x4 lo[4], hi[4];
#pragma unroll
        for (int ks = 0; ks < 4; ++ks) {
            asm volatile("ds_read_b64_tr_b16 %0,%1 offset:%c2" : "=&v"(lo[ks]) : "v"(vb), "i"(d0 * 4096 + ks * 1024) : "memory");
            asm volatile("ds_read_b64_tr_b16 %0,%1 offset:%c2" : "=&v"(hi[ks]) : "v"(vb), "i"(d0 * 4096 + ks * 1024 + 512) : "memory"); }
        asm volatile("s_waitcnt lgkmcnt(0)" ::: "memory"); __builtin_amdgcn_sched_barrier(0);
#define PK(k) (bf16x8){lo[k][0], lo[k][1], lo[k][2], lo[k][3], hi[k][0], hi[k][1], hi[k][2], hi[k][3]}
        o[d0] = __builtin_amdgcn_mfma_f32_32x32x16_bf16(pa0, PK(0), o[d0], 0, 0, 0);
        o[d0] = __builtin_amdgcn_mfma_f32_32x32x16_bf16(pa1, PK(1), o[d0], 0, 0, 0);
        o[d0] = __builtin_amdgcn_mfma_f32_32x32x16_bf16(pa2, PK(2), o[d0], 0, 0, 0);
        o[d0] = __builtin_amdgcn_mfma_f32_32x32x16_bf16(pa3, PK(3), o[d0], 0, 0, 0);
#undef PK
    }
}
__device__ __forceinline__ void attn_unit(int b, int h, int qb, unsigned char* ws, LAS unsigned char* shm) {
    const int tid = threadIdx.x, lane = tid & 63, r32 = lane & 31, hi = lane >> 5; const int wid = __builtin_amdgcn_readfirstlane(tid >> 6);
    const long rowbase = (long)b * SEQ; const int q0 = qb * 256;
    const bf16_t* Qw = (const bf16_t*)(ws + WS_Q) + (rowbase + q0 + wid * 32) * AW + h * HD;
    const bf16_t* Kh = (const bf16_t*)(ws + WS_K) + rowbase * AW + h * HD; const bf16_t* Vh = (const bf16_t*)(ws + WS_V) + rowbase * AW + h * HD;
    const float* cum = (const float*)(ws + WS_CUM) + (size_t)(b * NH + h) * SEQ;
    const unsigned lds0 = (unsigned)(uintptr_t)shm;
    LAS float* wsf = (LAS float*)(shm + L_WS) + wid * 64;
    LAS int* cnt = (LAS int*)(shm + L_CNT);
    const float cref = cum[q0];
    const unsigned* nr = (const unsigned*)(ws + WS_NRM) + (b * NH + h) * 4;
    const float qn2 = __uint_as_float(nr[0]) + __uint_as_float(nr[1]), kn2 = __uint_as_float(nr[2]) + __uint_as_float(nr[3]);
    const float X = SKIP_LOG2 + 2.0f * (sqrtf(qn2 * kn2) * 1.01f + 0.01f);
    const float Sb = sqrtf(qn2 * kn2) * 1.01f + 0.01f;
    float cend = 0.f; if (tid < 4 * qb) cend = cum[64 * tid + 63];
    const int NT = 4 * qb + 4;
    bf16x8 qr[4];
#pragma unroll
    for (int d0 = 0; d0 < 4; ++d0) qr[d0] = *(const bf16x8*)(Qw + (long)r32 * AW + d0 * 16 + hi * 8);
    const bf16_t* ksrc = Kh + (long)lane * AW + wid * 8;
    const bf16_t* vsrc = Vh + (long)(16 * (wid & 3) + (lane >> 2)) * AW + (wid >> 2) * 32 + (lane & 3) * 8;
    u32x4 kA = *(const u32x4*)(ksrc + (long)(NT - 1) * 64 * AW), vA = *(const u32x4*)(vsrc + (long)(NT - 1) * 64 * AW);
    u32x4 kB = *(const u32x4*)(ksrc + (long)(NT - 2) * 64 * AW), vB = *(const u32x4*)(vsrc + (long)(NT - 2) * 64 * AW);
    const float bend = cref - cend;
    int pred = (tid < 4 * qb && bend < -X) ? 1 : 0;
    { const unsigned long long bal = __ballot(pred); if (lane == 0) cnt[wid] = __popcll(bal); }
    LBAR();
    int tile_lo = 0;
#pragma unroll
    for (int w = 0; w < 8; ++w) tile_lo += cnt[w];
    const int koff = wid * 1024 + lane * 16;
    const int vb0 = (int)(lds0 + L_V) + ((lane >> 4) & 1) * 32 + (lane & 3) * 8 + (4 * hi + ((lane & 15) >> 2)) * 64;
    int t = NT - 1;
    float bA = (tid < 64) ? (cref - cum[64 * t + tid]) : 0.f;
    float bB = (tid < 64) ? (cref - cum[64 * (t - 1) + tid]) : 0.f;
    float mhat = -1e30f, l_reg = 0.f; f32x16 o[2]; o[0] = f32x16{}; o[1] = f32x16{};
    const int qrel = wid * 32 + r32;
    int cur = 0, vcur = 0, vprev = 2;
    u32x4 pw0 = (u32x4){0u, 0u, 0u, 0u}, pw1 = pw0, pw2 = pw0, pw3 = pw0;
#define ATT_STEP(KR, VR, BR) do { \
        *(LAS u32x4*)(shm + L_K + cur * SLOTB + koff) = KR; *(LAS u32x4*)(shm + L_V + vcur * SLOTB + koff) = VR; \
        if (tid < 64) *(LAS float*)(shm + L_B + cur * 256 + tid * 4) = BR; \
        asm volatile("s_waitcnt lgkmcnt(0)\n\ts_barrier" ::: "memory");     \
        if (t - 2 >= tile_lo) { KR = *(const u32x4*)(ksrc + (long)(t - 2) * 64 * AW); VR = *(const u32x4*)(vsrc + (long)(t - 2) * 64 * AW); BR = (tid < 64) ? (cref - cum[64 * (t - 2) + tid]) : 0.f; } \
        att_tile(); \
    } while (0)
    auto att_tile = [&]() __attribute__((always_inline)) {
        const int jb = t - (NT - 4);
        if (jb <= (wid >> 1)) {
            f32x16 p0, p1;
            { const LAS float* bb = (const LAS float*)(shm + L_B + cur * 256);
#pragma unroll
              for (int g4 = 0; g4 < 4; ++g4) { const f32x4 a = *(const LAS f32x4*)(bb + 8 * g4 + 4 * hi), c = *(const LAS f32x4*)(bb + 32 + 8 * g4 + 4 * hi);
#pragma unroll
                  for (int e = 0; e < 4; ++e) { p0[4 * g4 + e] = a[e]; p1[4 * g4 + e] = c[e]; } } }
            { const LAS unsigned char* kb = shm + L_K + cur * SLOTB + hi * 1024 + r32 * 16;
#pragma unroll
              for (int d0 = 0; d0 < 4; ++d0) { const bf16x8 b0 = *(const LAS bf16x8*)(kb + d0 * 2048), b1 = *(const LAS bf16x8*)(kb + d0 * 2048 + 512);
                  p0 = __builtin_amdgcn_mfma_f32_32x32x16_bf16(b0, qr[d0], p0, 0, 0, 0); p1 = __builtin_amdgcn_mfma_f32_32x32x16_bf16(b1, qr[d0], p1, 0, 0, 0); } }
            pv(o, vb0 + vprev * SLOTB, __builtin_bit_cast(bf16x8, pw0), __builtin_bit_cast(bf16x8, pw1), __builtin_bit_cast(bf16x8, pw2), __builtin_bit_cast(bf16x8, pw3));
            if (jb >= 0) { const int kb0 = 64 * jb + 4 * hi;
#pragma unroll
                for (int r = 0; r < 16; ++r) { const int kv = kb0 + (r & 3) + 8 * (r >> 2); if (kv > qrel) p0[r] = -INFINITY; if (kv + 32 > qrel) p1[r] = -INFINITY; } }
            const float rm = rowmax(p0, p1);
            const float mnew = fmaxf(mhat, rm);
            if (__any(mnew > mhat)) {
                const float alpha = __builtin_amdgcn_exp2f(mhat - mnew); l_reg *= alpha; mhat = mnew;
                if (hi == 0) wsf[r32] = alpha;
                asm volatile("s_waitcnt lgkmcnt(0)" ::: "memory");
#pragma unroll
                for (int r = 0; r < 16; ++r) { const float f = wsf[crow(r, hi)]; o[0][r] *= f; o[1][r] *= f; }
            }
            float sacc = 0.f;
#pragma unroll
            for (int r = 0; r < 16; ++r) { p0[r] = __builtin_amdgcn_exp2f(p0[r] - mhat); p1[r] = __builtin_amdgcn_exp2f(p1[r] - mhat); sacc += p0[r] + p1[r]; }
            l_reg += sacc;
            pw0 = (u32x4){cvtpk_s(p0[0], p0[1]), cvtpk_s(p0[2], p0[3]), cvtpk_s(p0[4], p0[5]), cvtpk_s(p0[6], p0[7])};
            pw1 = (u32x4){cvtpk_s(p0[8], p0[9]), cvtpk_s(p0[10], p0[11]), cvtpk_s(p0[12], p0[13]), cvtpk_s(p0[14], p0[15])};
            pw2 = (u32x4){cvtpk_s(p1[0], p1[1]), cvtpk_s(p1[2], p1[3]), cvtpk_s(p1[4], p1[5]), cvtpk_s(p1[6], p1[7])};
            pw3 = (u32x4){cvtpk_s(p1[8], p1[9]), cvtpk_s(p1[10], p1[11]), cvtpk_s(p1[12], p1[13]), cvtpk_s(p1[14], p1[15])};
        }
        cur ^= 1; vprev = vcur; vcur = (vcur == 2) ? 0 : vcur + 1;
        if (jb == 0 && tile_lo < NT - 4) {
            float mm = mhat;
#pragma unroll
            for (int o2 = 1; o2 < 64; o2 <<= 1) mm = fminf(mm, __shfl_xor(mm, o2));
            LAS float* mw = (LAS float*)(shm + L_CNT) + 8;
            if (lane == 0) mw[wid] = mm;
            LBAR();
            float mmin = mw[0];
#pragma unroll
            for (int w = 1; w < 8; ++w) mmin = fminf(mmin, mw[w]);
            const float X2 = SKIP_LOG2 + Sb - mmin;
            const int pred2 = (tid < 4 * qb && bend < -X2) ? 1 : 0;
            { const unsigned long long bal = __ballot(pred2); if (lane == 0) cnt[wid] = __popcll(bal); }
            LBAR();
            int tl2 = 0;
#pragma unroll
            for (int w = 0; w < 8; ++w) tl2 += cnt[w];
            tile_lo = tl2 > tile_lo ? tl2 : tile_lo;
        }
    };
    for (;;) {
        ATT_STEP(kA, vA, bA); --t; if (t < tile_lo) break;
        ATT_STEP(kB, vB, bB); --t; if (t < tile_lo) break;
    }
#undef ATT_STEP
    pv(o, vb0 + vprev * SLOTB, __builtin_bit_cast(bf16x8, pw0), __builtin_bit_cast(bf16x8, pw1), __builtin_bit_cast(bf16x8, pw2), __builtin_bit_cast(bf16x8, pw3));
    { auto rr = __builtin_amdgcn_permlane32_swap(__float_as_uint(l_reg), __float_as_uint(l_reg), false, false); l_reg = __uint_as_float(rr[0]) + __uint_as_float(rr[1]); }
    if (hi == 0) wsf[32 + r32] = l_reg;
    asm volatile("s_waitcnt lgkmcnt(0)" ::: "memory");
    LAS float* stg = (LAS float*)(shm + L_OST) + wid * 2048;
#pragma unroll
    for (int r = 0; r < 16; ++r) { const int orow = crow(r, hi); const float rl = __builtin_amdgcn_rcpf(wsf[32 + orow]);
        stg[orow * 64 + r32] = o[0][r] * rl; stg[orow * 64 + 32 + r32] = o[1][r] * rl; }
    asm volatile("s_waitcnt lgkmcnt(0)" ::: "memory");
    const bf16_t* GAw = (const bf16_t*)(ws + WS_GA) + (rowbase + q0 + wid * 32) * AW + h * HD;
    bf16_t* Ow = (bf16_t*)(ws + WS_YA) + (rowbase + q0 + wid * 32) * AW + h * HD;
#pragma unroll
    for (int i = 0; i < 4; ++i) { const int row = i * 8 + (lane >> 3), ch = lane & 7;
        f32x4 a = *(const LAS f32x4*)(stg + row * 64 + ch * 8), c = *(const LAS f32x4*)(stg + row * 64 + ch * 8 + 4);
        f32x4 g0, g1; unpack8(*(const u32x4*)(GAw + (long)row * AW + ch * 8), g0, g1);
        *(u32x4*)(Ow + (long)row * AW + ch * 8) = pack8(a * g0, c * g1); }
    LBAR();
}
}

__device__ __forceinline__ unsigned f2bf(float f) { unsigned u = __builtin_bit_cast(unsigned, f); return (u + 0x7fffu + ((u >> 16) & 1u)) >> 16; }
__device__ __forceinline__ unsigned pk2(float lo, float hi) { return f2bf(lo) | (f2bf(hi) << 16); }
__device__ __forceinline__ float wave_sum(float v) {
#pragma unroll
    for (int o = 1; o < 64; o <<= 1) v += __shfl_xor(v, o);
    return v;
}
__device__ __forceinline__ void transpose_item(const float* W, int K, int ldw, int N, int col_shift_from, bf16_t* WT, LAS float* scr, int item, int lane) {
    const int nblk = N / 32, kb = item / nblk, nb = item % nblk, k0 = 64 * kb, n0 = 32 * nb;
    int sc0 = n0;
    if (col_shift_from >= 0) { if (n0 >= 3072) { const int T = (n0 - 3072) >> 8, j = (n0 - 3072) & 255; sc0 = (j < 128) ? 3080 + T * 128 + j : 4104 + T * 128 + (j - 128); } else if (n0 >= 1536) sc0 = n0 + 8; }
#pragma unroll 8
    for (int i = 0; i < 32; ++i) { const int kk = 2 * i + (lane >> 5); scr[kk * 33 + (lane & 31)] = W[(size_t)(k0 + kk) * ldw + sc0 + (lane & 31)]; }
    asm volatile("s_waitcnt lgkmcnt(0)" ::: "memory");
    const int c = lane & 7;
#pragma unroll
    for (int j = 0; j < 4; ++j) { const int n = (lane >> 3) + 8 * j; const LAS float* s = scr + (8 * c) * 33 + n;
        u32x4 o; o.x = pk2(s[0 * 33], s[1 * 33]); o.y = pk2(s[2 * 33], s[3 * 33]); o.z = pk2(s[4 * 33], s[5 * 33]); o.w = pk2(s[6 * 33], s[7 * 33]);
        *(u32x4*)(WT + (size_t)(n0 + n) * K + k0 + 8 * c) = o; }
    asm volatile("s_waitcnt lgkmcnt(0)" ::: "memory");
}
__device__ __forceinline__ void sincos_d(double x, double& s, double& c) {
    const double k = rint(x * 0.63661977236758134308);
    const double r = (x - k * 1.57079632679489655800) - k * 6.123233995736766035869e-17;
    const double r2 = r * r;
    const double sp = r * (1.0 + r2 * (-1.0 / 6 + r2 * (1.0 / 120 + r2 * (-1.0 / 5040 + r2 * (1.0 / 362880 + r2 * (-1.0 / 39916800 + r2 * (1.0 / 6227020800.0)))))));
    const double cp = 1.0 + r2 * (-0.5 + r2 * (1.0 / 24 + r2 * (-1.0 / 720 + r2 * (1.0 / 40320 + r2 * (-1.0 / 3628800 + r2 * (1.0 / 479001600.0 + r2 * (-1.0 / 87178291200.0)))))));
    const int q = ((int)k) & 3;
    s = (q == 0) ? sp : (q == 1) ? cp : (q == 2) ? -sp : -cp;
    c = (q == 0) ? cp : (q == 1) ? -sp : (q == 2) ? -cp : sp;
}
__device__ __forceinline__ double exp_d(double x) {
    const double n = rint(x * 1.44269504088896340736);
    const double r = (x - n * 0.693147180369123816490) - n * 1.90821492927058770002e-10;
    double p = 1.0 / 6227020800.0;
    p = p * r + 1.0 / 479001600.0; p = p * r + 1.0 / 39916800.0; p = p * r + 1.0 / 3628800.0; p = p * r + 1.0 / 362880.0; p = p * r + 1.0 / 40320.0;
    p = p * r + 1.0 / 5040.0; p = p * r + 1.0 / 720.0; p = p * r + 1.0 / 120.0; p = p * r + 1.0 / 24.0; p = p * r + 1.0 / 6.0; p = p * r + 0.5; p = p * r + 1.0; p = p * r + 1.0;
    const long long bits = ((long long)((int)n + 1023)) << 52;
    return p * __builtin_bit_cast(double, bits);
}

__device__ __forceinline__ void ssm_ops_item(const Params& p, int g, int c, LAS unsigned char* lds) {
    typedef float f32x2 __attribute__((ext_vector_type(2)));
    LAS f32x2* P = (LAS f32x2*)lds;
    LAS f32x2* Bb = (LAS f32x2*)(lds + 33280);
    LAS f32x2* Cc = (LAS f32x2*)(lds + 41472);
    LAS float* Km = (LAS float*)(lds + 41984);
    const int tid = threadIdx.x;
    if (tid < 64) {
        const int pp = tid;
        const double dt = exp_d((double)p.log_dt[g]); const double lr = (double)p.lam_re[g * 64 + pp], li = (double)p.lam_im[g * 64 + pp];
        const double mag = exp_d(lr * dt); double sn, cs; sincos_d(li * dt, sn, cs);
        const double abr = mag * cs, abi = mag * sn, den = lr * lr + li * li, nre = abr - 1.0;
        const double fre = (nre * lr + abi * li) / den, fim = (abi * lr - nre * li) / den;
        double pr = 1.0, pi = 0.0;
        for (int j = 0; j <= 64; ++j) { P[j * 64 + pp] = (f32x2){(float)pr, (float)pi}; const double nr = pr * abr - pi * abi, ni = pr * abi + pi * abr; pr = nr; pi = ni; }
        if (c == 0) ((f32x2*)(p.ws + WS_LAM64))[g * 64 + pp] = P[64 * 64 + pp];
        for (int q = 0; q < 16; ++q) { const double br = (double)p.b_re[(g * 64 + pp) * 16 + q], bi = (double)p.b_im[(g * 64 + pp) * 16 + q];
            Bb[pp * 16 + q] = (f32x2){(float)(fre * br - fim * bi), (float)(fre * bi + fim * br)}; }
        Cc[pp] = (f32x2){p.c_re[(g * 16 + c) * 64 + pp], p.c_im[(g * 16 + c) * 64 + pp]};
    }
    __syncthreads();
    {
        const int j = tid >> 3, q0 = (tid & 7) * 2;
        float k0 = 0.f, k1 = 0.f;
        for (int pp = 0; pp < 64; ++pp) {
            const f32x2 cc = Cc[pp], gg = P[j * 64 + pp], b0 = Bb[pp * 16 + q0], b1 = Bb[pp * 16 + q0 + 1];
            const float clr = cc.x * gg.x - cc.y * gg.y, cli = cc.x * gg.y + cc.y * gg.x;
            k0 += clr * b0.x - cli * b0.y; k1 += clr * b1.x - cli * b1.y;
        }
        if (j == 0) { const float d = p.d_skip[g * 16 + c]; if (q0 == c) k0 += d; if (q0 + 1 == c) k1 += d; }
        Km[j * 16 + q0] = k0; Km[j * 16 + q0 + 1] = k1;
    }
    __syncthreads();
    {
        bf16_t* TZ = (bf16_t*)(p.ws + WS_TZ) + (size_t)g * 1024 * KX;
        for (int idx = tid; idx < 64 * 144; idx += 512) {
            const int t = idx / 144, i = idx % 144, col = 8 * i;
            float v[8];
            if (col >= 128) { const int s = (col - 128) >> 4, chh = (col >> 3) & 1;
                if (s <= t) { const LAS float* k = Km + (t - s) * 16 + chh * 8;
#pragma unroll
                    for (int e = 0; e < 8; ++e) v[e] = k[e]; }
                else {
#pragma unroll
                    for (int e = 0; e < 8; ++e) v[e] = 0.f; }
            } else { const int p0 = col >> 1;
#pragma unroll
                for (int e = 0; e < 4; ++e) { const f32x2 cc = Cc[p0 + e], gg = P[(t + 1) * 64 + p0 + e]; v[2 * e] = cc.x * gg.x - cc.y * gg.y; v[2 * e + 1] = -(cc.x * gg.y + cc.y * gg.x); } }
            u32x4 w; w.x = pk2(v[0], v[1]); w.y = pk2(v[2], v[3]); w.z = pk2(v[4], v[5]); w.w = pk2(v[6], v[7]);
            *(u32x4*)(TZ + (size_t)(t * 16 + c) * KX + col) = w;
        }
        bf16_t* WE = (bf16_t*)(p.ws + WS_WEND) + (size_t)g * 256 * 1024;
        for (int idx = tid; idx < 16 * 128; idx += 512) {
            const int rl = idx >> 7, i = idx & 127, s = i >> 1, chh = i & 1;
            const int row = (rl < 8) ? (8 * c + rl) : (128 + 8 * c + (rl - 8));
            float v[8];
            if (rl < 8) { const int pp = row >> 1, ri = row & 1; const f32x2 gg = P[(63 - s) * 64 + pp];
#pragma unroll
                for (int e = 0; e < 8; ++e) { const f32x2 bb = Bb[pp * 16 + chh * 8 + e]; v[e] = ri ? (gg.x * bb.y + gg.y * bb.x) : (gg.x * bb.x - gg.y * bb.y); } }
            else {
#pragma unroll
                for (int e = 0; e < 8; ++e) v[e] = 0.f; }
            u32x4 w; w.x = pk2(v[0], v[1]); w.y = pk2(v[2], v[3]); w.z = pk2(v[4], v[5]); w.w = pk2(v[6], v[7]);
            *(u32x4*)(WE + (size_t)row * 1024 + 8 * i) = w;
        }
    }
    __syncthreads();
}

#define XB_TMO      128
#define XB_XCNT(j)  (256  + 64 * (j))
#define XB_XSUB(j)  (1280 + 64 * (j))
#define XB_XGEN(j)  (2304 + 64 * (j))
#define XB_TOP      3328
#define XB_TOPGEN   3392
#define XCD_BAR_WORDS 3456
#define XB_SPIN_CAP (1u << 18)
__device__ __forceinline__ unsigned xb_ld(unsigned* p)              { return __hip_atomic_load(p, __ATOMIC_RELAXED, __HIP_MEMORY_SCOPE_AGENT); }
__device__ __forceinline__ unsigned xb_add(unsigned* p, unsigned v) { return __hip_atomic_fetch_add(p, v, __ATOMIC_RELAXED, __HIP_MEMORY_SCOPE_AGENT); }
__device__ __forceinline__ unsigned xb_xcc_id() { return (unsigned)__builtin_amdgcn_s_getreg((3 << 11) | 20) & 0xFu; }
#define XB_SPIN(cond, bar) do { unsigned _sp = 0; while (cond) { __builtin_amdgcn_s_sleep(1); \
    if ((++_sp & 255u) == 0u) { if (xb_ld(&(bar)[XB_TMO])) break; if (_sp > XB_SPIN_CAP) { atomicAdd(&(bar)[XB_TMO], 1u); break; } } } } while (0)
struct XcdBarrier { unsigned* bar; unsigned x; volatile LAS unsigned* st; };
__device__ __forceinline__ XcdBarrier xcd_barrier_post(unsigned* bar, volatile LAS unsigned* st) {
    XcdBarrier b; b.bar = bar; b.x = xb_xcc_id(); b.st = st;
    if (threadIdx.x == 0) (void)xb_add(&bar[XB_XCNT(b.x)], 1u);
    return b;
}
__device__ __forceinline__ void xcd_barrier_complete(unsigned* bar, unsigned x, unsigned& nloc, unsigned& nx) {
    const unsigned G = gridDim.x * gridDim.y * gridDim.z;
    unsigned sum, cnt, mine, sp = 0u;
    for (;;) {
        sum = 0u; cnt = 0u; mine = 0u;
#pragma unroll
        for (unsigned j = 0; j < 16; ++j) { const unsigned c = xb_ld(&bar[XB_XCNT(j)]); sum += c; cnt += (c > 0u) ? 1u : 0u; mine = (j == x) ? c : mine; }
        if (sum == G) break;
        __builtin_amdgcn_s_sleep(1);
        if ((++sp & 255u) == 0u) { if (xb_ld(&bar[XB_TMO])) break; if (sp > XB_SPIN_CAP) { atomicAdd(&bar[XB_TMO], 1u); break; } }
    }
    nloc = mine > 0u ? mine : 1u; nx = cnt > 0u ? cnt : 1u;
}
__device__ __forceinline__ void xcd_barrier(const XcdBarrier& b) {
    asm volatile("s_waitcnt vmcnt(0)" ::: "memory");
    __syncthreads();
    if (threadIdx.x == 0) {
        unsigned* bar = b.bar;
        __builtin_amdgcn_s_waitcnt(0);
        unsigned nloc = b.st[0], nx = b.st[1];
        if (nloc == 0u) { xcd_barrier_complete(bar, b.x, nloc, nx); b.st[0] = nloc; b.st[1] = nx; }
        const unsigned old = xb_add(&bar[XB_XSUB(b.x)], 1u);
        const unsigned gen = old / nloc;
        if (old + 1u == (gen + 1u) * nloc) {
            __builtin_amdgcn_fence(__ATOMIC_RELEASE, "agent");
            asm volatile("s_waitcnt vmcnt(0)" ::: "memory");
            const unsigned og = xb_add(&bar[XB_TOP], 1u);
            const unsigned tg = og / nx;
            if (og + 1u == (tg + 1u) * nx) xb_add(&bar[XB_TOPGEN], 1u);
            else XB_SPIN(xb_ld(&bar[XB_TOPGEN]) == tg, bar);
            __builtin_amdgcn_fence(__ATOMIC_ACQUIRE, "agent");
            xb_add(&bar[XB_XGEN(b.x)], 1u);
            asm volatile("s_waitcnt vmcnt(0)" ::: "memory");
        } else {
            XB_SPIN(xb_ld(&bar[XB_XGEN(b.x)]) == gen, bar);
            __builtin_amdgcn_fence(__ATOMIC_ACQUIRE, "agent");
            asm volatile("s_waitcnt vmcnt(0)" ::: "memory");
        }
    }
    __syncthreads();
}

__global__ void __launch_bounds__(512) fwd_megakernel(Params p) {
    extern __shared__ __attribute__((aligned(16))) unsigned char lds_raw[];
    LAS unsigned char* lds = (LAS unsigned char*)lds_raw;
    cg::grid_group grid = cg::this_grid();
    const int tid = threadIdx.x, lane = tid & 63, wave = __builtin_amdgcn_readfirstlane(tid >> 6);
    const int G = gridDim.x, bx = blockIdx.x;
    unsigned char* ws = p.ws;
    const int lo = p.ph_lo, hi = p.ph_hi;
#define IN(k) (lo <= (k) && (k) < hi)
    volatile LAS unsigned* bst = (volatile LAS unsigned*)(lds + 131072 + 128);
    if (tid == 0) { bst[0] = 0u; bst[1] = 0u; }
    __syncthreads();
    XcdBarrier xbar; xbar.bar = (unsigned*)(ws + WS_BAR); xbar.x = 0; xbar.st = bst;
#define SEAM(k) do { if (IN(k) && IN((k) + 1)) { if ((k) == 0) { grid.sync(); xbar = xcd_barrier_post((unsigned*)(ws + WS_BAR), bst); } else xcd_barrier(xbar); } } while (0)

    if (IN(0)) {
        for (int i = bx * 512 + tid; i < MTOK; i += G * 512) ((float*)(ws + WS_SUMSQ))[i] = 0.f;
        if (bx == 0) for (int i = tid; i < 2048; i += 512) ((unsigned*)(ws + WS_NRM))[i] = 0u;
        if (bx == 1 || G == 1) for (int i = tid; i < 256 * 64; i += 512) ((unsigned*)(ws + WS_CNT))[i] = 0u;
        if (bx == 2 || G < 3) for (int i = tid; i < XCD_BAR_WORDS; i += 512) ((unsigned*)(ws + WS_BAR))[i] = 0u;
        const int gw = bx * 8 + wave, NGW = G * 8;
        auto partL = [&]() __attribute__((always_inline)) {
        for (int it = bx; it < NG * 16; it += G) ssm_ops_item(p, it >> 4, it & 15, lds);
        LAS float* scr = (LAS float*)(lds + wave * 8704);
        constexpr int I_IN = 16 * (NPROJ / 32), I_GLU = 8 * 16, I_A = 8 * 32, I_S = 8 * 32, I_O = 16 * 32, NIT = I_IN + I_GLU + I_A + I_S + I_O;
        for (int it = gw; it < NIT; it += NGW) {
            int r = it;
            if (r < I_IN) { transpose_item(p.w_in, DM, INC, NPROJ, 0, (bf16_t*)(ws + WS_WIN), scr, r, lane); continue; } r -= I_IN;
            if (r < I_GLU) { transpose_item(p.w_glu, SW, SW, SW, -1, (bf16_t*)(ws + WS_WGLU), scr, r, lane); continue; } r -= I_GLU;
            if (r < I_A) { transpose_item(p.w_a, AW, DM, DM, -1, (bf16_t*)(ws + WS_WA), scr, r, lane); continue; } r -= I_A;
            if (r < I_S) { transpose_item(p.w_s, SW, DM, DM, -1, (bf16_t*)(ws + WS_WS), scr, r, lane); continue; } r -= I_S;
            transpose_item(p.w_out, DM, DM, DM, -1, (bf16_t*)(ws + WS_WOUT), scr, r, lane);
        }
        };
        auto partR = [&]() __attribute__((always_inline)) {
        LAS float* wf = (LAS float*)(lds + 73728);
        for (int i = tid; i < 8192; i += 512) { const int k = i >> 3, j = i & 7; wf[j * 1024 + k] = p.w_in[(size_t)k * INC + 1536 + j]; }
        __syncthreads();
        f32x4 gn[4];
#pragma unroll
        for (int j = 0; j < 4; ++j) gn[j] = ((const f32x4*)p.norm_pre)[lane + 64 * j];
        f32x4 wreg[8][4];
#pragma unroll
        for (int e = 0; e < 8; ++e)
#pragma unroll
            for (int j = 0; j < 4; ++j) wreg[e][j] = *(const LAS f32x4*)(wf + e * 1024 + 4 * lane + 256 * j);
        const int fidx = ((lane & 1) << 2) | (lane & 2) | ((lane & 4) >> 2);
        const float bfg = p.b_forget[fidx];
        f32x4 vn[4];
        if (gw < MTOK) {
#pragma unroll
            for (int j = 0; j < 4; ++j) vn[j] = ((const f32x4*)(p.x + (size_t)gw * DM) + lane)[64 * j];
        }
        for (int m = gw; m < MTOK; m += NGW) {
            f32x4 v[4]; float s = 0.f;
#pragma unroll
            for (int j = 0; j < 4; ++j) v[j] = vn[j];
            if (m + NGW < MTOK) {
#pragma unroll
                for (int j = 0; j < 4; ++j) vn[j] = ((const f32x4*)(p.x + (size_t)(m + NGW) * DM) + lane)[64 * j];
            }
#pragma unroll
            for (int j = 0; j < 4; ++j) s += (v[j][0] * v[j][0] + v[j][1] * v[j][1]) + (v[j][2] * v[j][2] + v[j][3] * v[j][3]);
            const float rstd = 1.0f / sqrtf(wave_sum(s) * (1.f / DM) + 1e-6f);
            unsigned long long* o8 = (unsigned long long*)((bf16_t*)(ws + WS_H) + (size_t)m * DM) + lane;
            float fa[8];
#pragma unroll
            for (int e = 0; e < 8; ++e) fa[e] = 0.f;
#pragma unroll
            for (int j = 0; j < 4; ++j) { v[j] = v[j] * rstd * gn[j];
                o8[64 * j] = (unsigned long long)pk2(v[j][0], v[j][1]) | ((unsigned long long)pk2(v[j][2], v[j][3]) << 32);
#pragma unroll
                for (int e = 0; e < 8; ++e) { const f32x4 w = wreg[e][j]; fa[e] += (v[j][0] * w[0] + v[j][1] * w[1]) + (v[j][2] * w[2] + v[j][3] * w[3]); } }
#pragma unroll
            for (int e = 0; e < 4; ++e) { const float a = fa[e], c = fa[e + 4]; const bool up = lane & 1; fa[e] = (up ? c : a) + __shfl_xor(up ? a : c, 1); }
#pragma unroll
            for (int e = 0; e < 2; ++e) { const float a = fa[e], c = fa[e + 2]; const bool up = lane & 2; fa[e] = (up ? c : a) + __shfl_xor(up ? a : c, 2); }
            { const float a = fa[0], c = fa[1]; const bool up = lane & 4; fa[0] = (up ? c : a) + __shfl_xor(up ? a : c, 4); }
            float z = fa[0];
            z += __shfl_xor(z, 8); z += __shfl_xor(z, 16); z += __shfl_xor(z, 32);
            if (lane < 8) { z += bfg;
                const float ls = fminf(z, 0.f) - log1pf(expf(-fabsf(z)));
                ((float*)(ws + WS_LOGF))[(size_t)m * 8 + fidx] = ls; }
        }
        };
        if ((bx >> 3) & 1) { partR(); __syncthreads(); partL(); } else { partL(); __syncthreads(); partR(); }
        __syncthreads();
    }
    SEAM(0);

    if (IN(1)) {
        for (int bh = bx; bh < BATCH * NH; bh += G) {
            const int b = bh >> 3, h = bh & 7;
            const float* lf = (const float*)(ws + WS_LOGF) + (size_t)b * SEQ * 8 + h;
            float v[16]; float s = 0.f;
#pragma unroll
            for (int e = 0; e < 16; ++e) { s += lf[(size_t)(tid * 16 + e) * 8]; v[e] = s; }
            float incl = s;
#pragma unroll
            for (int o = 1; o < 64; o <<= 1) { const float n = __shfl_up(incl, o); if (lane >= o) incl += n; }
            LAS float* wt = (LAS float*)lds;
            if (lane == 63) wt[wave] = incl;
            __syncthreads();
            float base = incl - s;
            for (int w = 0; w < wave; ++w) base += wt[w];
            float* co = (float*)(ws + WS_CUM) + (size_t)bh * SEQ + tid * 16;
#pragma unroll
            for (int e = 0; e < 16; ++e) co[e] = (base + v[e]) * LOG2E;
            __syncthreads();
        }
        pg8::Gemm g{(const bf16_t*)(ws + WS_H), (const bf16_t*)(ws + WS_WIN), DM, DM, DM, 0, 0, nullptr, nullptr, 0, 16};
        pg8::TileOrder S{MTOK / 256, NPROJ / 256, 1, G, bx, 1};
        EpiProj E{ws};
        pg8::gemm_phase(lds, g, S, E);
    }
    SEAM(1);

    if (IN(2)) {
        {
            pg8::Gemm g{(const bf16_t*)(ws + WS_U2) + 128, (const bf16_t*)(ws + WS_WEND), 1024, KX, 1024, (long)NCHK * KX, 256L * 1024, nullptr, nullptr, 0, 16};
            pg8::TileOrder S{NCHK / 256, 1, NG, G, G - 1 - bx, 0};
            EpiSsmE E{(float*)(ws + WS_E)};
            pg8::gemm_phase(lds, g, S, E);
        }
        __syncthreads();
        {
            unsigned* uctr = (unsigned*)(ws + WS_NRM) + 1024;
            LAS int* nxt = (LAS int*)(lds + 131072 + 256);
            for (;;) {
                if (tid == 0) *nxt = (int)atomicAdd(uctr, 1u);
                asm volatile("s_waitcnt lgkmcnt(0)\n\ts_barrier" ::: "memory");
                const int uidx = *nxt;
                asm volatile("s_waitcnt lgkmcnt(0)\n\ts_barrier" ::: "memory");
                if (uidx >= BATCH * NH * 32) break;
                const int bh = uidx & 63, qb = 31 - (uidx >> 6);
                att::attn_unit(bh >> 3, bh & 7, qb, ws, lds);
            }
        }
    }
    SEAM(2);

    if (IN(3)) {
        typedef float f32x2 __attribute__((ext_vector_type(2)));
        LAS f32x2* ex = (LAS f32x2*)lds;
        for (int idx = bx; idx < BATCH * NG; idx += G) {
            const int b = idx >> 5, g = idx & 31, pp = lane;
            const f32x2 L = ((const f32x2*)(ws + WS_LAM64))[g * 64 + pp];
            f32x2 L16 = L;
#pragma unroll
            for (int q = 0; q < 4; ++q) L16 = (f32x2){L16.x * L16.x - L16.y * L16.y, 2.f * L16.x * L16.y};
            const float* Eb = (const float*)(ws + WS_E) + ((size_t)(g * NCHK + b * 128 + 16 * wave) * 128 + 2 * pp);
            bf16_t* Ub = (bf16_t*)(ws + WS_U2) + ((size_t)(g * NCHK + b * 128 + 16 * wave) * KX + 2 * pp);
            f32x2 e[16];
#pragma unroll
            for (int j = 0; j < 16; ++j) e[j] = *(const f32x2*)(Eb + (size_t)j * 128);
            float sr = 0.f, si = 0.f;
#pragma unroll
            for (int j = 0; j < 16; ++j) { const float nr = L.x * sr - L.y * si + e[j].x, ni = L.x * si + L.y * sr + e[j].y; sr = nr; si = ni; }
            ex[wave * 64 + pp] = (f32x2){sr, si};
            __syncthreads();
            sr = 0.f; si = 0.f;
            for (int w = 0; w < wave; ++w) { const f32x2 en = ex[w * 64 + pp]; const float nr = L16.x * sr - L16.y * si + en.x, ni = L16.x * si + L16.y * sr + en.y; sr = nr; si = ni; }
#pragma unroll
            for (int j = 0; j < 16; ++j) {
                *(unsigned*)(Ub + (size_t)j * KX) = pk2(sr, si);
                const float nr = L.x * sr - L.y * si + e[j].x, ni = L.x * si + L.y * sr + e[j].y; sr = nr; si = ni;
            }
            __syncthreads();
        }
    }
    SEAM(3);

    if (IN(4)) {
        pg8::Gemm g{(const bf16_t*)(ws + WS_U2), (const bf16_t*)(ws + WS_TZ), KX, KX, KX, (long)NCHK * KX, 1024L * KX, nullptr, nullptr, 0, 16};
        pg8::SsmYOrder S{G, bx};
        EpiSsmY E{(bf16_t*)(ws + WS_YS)};
        pg8::gemm_phase(lds, g, S, E);
    }
    SEAM(4);

    if (IN(5)) {
        pg8::Gemm g{(const bf16_t*)(ws + WS_YS), (const bf16_t*)(ws + WS_WGLU), SW, 16, SW, 0, 0, nullptr, nullptr, 0, (long)MTOK * 16};
        pg8::TileOrder S{MTOK / 256, SW / 256, 1, G, bx, 1};
        EpiGlu E{(const bf16_t*)(ws + WS_YS), (const bf16_t*)(ws + WS_GS), p.b_glu, (bf16_t*)(ws + WS_YS2)};
        pg8::gemm_phase(lds, g, S, E);
    }
    SEAM(5);

    if (IN(6)) {
        pg8::Gemm g{(const bf16_t*)(ws + WS_YA), (const bf16_t*)(ws + WS_WA), 1024, 512, 512, 0, 0, (const bf16_t*)(ws + WS_YS2), (const bf16_t*)(ws + WS_WS), 8, 16};
        pg8::TileOrder S{MTOK / 256, DM / 256, 1, G, bx, 1};
        EpiMerge E{(const bf16_t*)(ws + WS_MIXA), (const bf16_t*)(ws + WS_MIXS), (bf16_t*)(ws + WS_MERGED)};
        pg8::gemm_phase(lds, g, S, E);
    }
    SEAM(6);

    if (IN(7)) {
        pg8::Gemm g{(const bf16_t*)(ws + WS_MERGED), (const bf16_t*)(ws + WS_WOUT), DM, DM, DM, 0, 0, nullptr, nullptr, 0, 16};
        pg8::TileOrder S{MTOK / 256, DM / 256, 1, G, bx, 1};
        EpiOut E{(bf16_t*)(ws + WS_PRE), (float*)(ws + WS_SUMSQ)};
        pg8::gemm_phase(lds, g, S, E);
    }

    SEAM(7);

    if (IN(8)) {
        const int gw = bx * 8 + wave, NGW = G * 8;
        f32x4 gn[4];
#pragma unroll
        for (int j = 0; j < 4; ++j) gn[j] = ((const f32x4*)p.norm_post)[lane + 64 * j];
        for (int m = gw; m < MTOK; m += NGW) {
            const float rstd = 1.0f / sqrtf(((const float*)(ws + WS_SUMSQ))[m] * (1.f / DM) + 1e-6f);
            const f32x4* xr = (const f32x4*)(p.x + (size_t)m * DM) + lane; f32x4* orow = (f32x4*)(p.out + (size_t)m * DM) + lane;
            const unsigned long long* pr = (const unsigned long long*)((const bf16_t*)(ws + WS_PRE) + (size_t)m * DM) + lane;
            f32x4 xv[4]; unsigned long long pv8[4];
#pragma unroll
            for (int j = 0; j < 4; ++j) { xv[j] = xr[64 * j]; pv8[j] = pr[64 * j]; }
#pragma unroll
            for (int j = 0; j < 4; ++j) { const unsigned lo32 = (unsigned)pv8[j], hi32 = (unsigned)(pv8[j] >> 32);
                const f32x4 pf = (f32x4){bf_lo(lo32), bf_hi(lo32), bf_lo(hi32), bf_hi(hi32)};
                orow[64 * j] = xv[j] + pf * rstd * gn[j]; }
        }
    }
#undef IN
#undef SEAM
}

extern "C" void kernel_launch(void* const* d_in, const int* in_sizes, int n_in, void* d_out, int out_size, void* d_ws, size_t ws_size, hipStream_t stream) {
    static int grid = 0;
    if (grid == 0) {
        if (n_in != 18 || out_size != MTOK * DM || ws_size < WS_END) { fprintf(stderr, "kernel_launch: unexpected shapes (n_in %d, out %d, ws %zu)\n", n_in, out_size, ws_size); grid = -1; return; }
        int dev = 0, cus = 0, per_cu = 0;
        hipGetDevice(&dev); hipDeviceGetAttribute(&cus, hipDeviceAttributeMultiprocessorCount, dev);
        if (hipFuncSetAttribute((const void*)fwd_megakernel, hipFuncAttributeMaxDynamicSharedMemorySize, LDS_BYTES) != hipSuccess) { fprintf(stderr, "kernel_launch: hipFuncSetAttribute failed\n"); grid = -1; return; }
        if (hipOccupancyMaxActiveBlocksPerMultiprocessor(&per_cu, (const void*)fwd_megakernel, 512, LDS_BYTES) != hipSuccess || per_cu < 1) { fprintf(stderr, "kernel_launch: occupancy query says %d\n", per_cu); per_cu = 1; }
        (void)hipGetLastError();
        grid = cus < 256 ? cus : 256;
    }
    if (grid < 0) return;
    Params p{};
    p.x = (const float*)d_in[0]; p.norm_pre = (const float*)d_in[1]; p.w_in = (const float*)d_in[2]; p.b_forget = (const float*)d_in[3];
    p.lam_re = (const float*)d_in[4]; p.lam_im = (const float*)d_in[5]; p.log_dt = (const float*)d_in[6]; p.b_re = (const float*)d_in[7]; p.b_im = (const float*)d_in[8];
    p.c_re = (const float*)d_in[9]; p.c_im = (const float*)d_in[10]; p.d_skip = (const float*)d_in[11]; p.w_glu = (const float*)d_in[12]; p.b_glu = (const float*)d_in[13];
    p.w_a = (const float*)d_in[14]; p.w_s = (const float*)d_in[15]; p.w_out = (const float*)d_in[16]; p.norm_post = (const float*)d_in[17];
    p.out = (float*)d_out; p.ws = (unsigned char*)d_ws;
#if MK_MULTI
    for (int ph = 0; ph < 9; ++ph) { p.ph_lo = ph; p.ph_hi = ph + 1; hipLaunchKernelGGL(fwd_megakernel, dim3(grid), dim3(512), LDS_BYTES, stream, p); }
#else
    p.ph_lo = 0; p.ph_hi = 9;
    void* args[] = {&p};
    hipError_t e = hipLaunchCooperativeKernel((const void*)fwd_megakernel, dim3(grid), dim3(512), args, LDS_BYTES, stream);
    if (e != hipSuccess) fprintf(stderr, "cooperative launch failed: %s (grid %d)\n", hipGetErrorString(e), grid);
#endif
}
```

```cpp
#include <hip/hip_runtime.h>
#include <hip/hip_cooperative_groups.h>
#include <hip/hip_bf16.h>
#include <cstdio>
#include <cstdint>
#include <cmath>
namespace cg = cooperative_groups;

#ifndef MK_MULTI
#define MK_MULTI 0
#endif

namespace pg8 {
#define PG8_LAS __attribute__((address_space(3)))
typedef unsigned short bf16_t;
typedef short bf16x8 __attribute__((ext_vector_type(8)));
typedef float f32x4 __attribute__((ext_vector_type(4)));
typedef unsigned u32x4 __attribute__((ext_vector_type(4)));
constexpr int BM = 256, BK = 64, HALF = 128, HTB = HALF * BK * 2, STAGE_BYTES = 8 * HTB, NXCD = 8, WGM = 8;

__host__ __device__ __forceinline__ int lds_byte(int r, int c) { const int st = (r >> 4) * 2 + (c >> 5), rr = r & 15, cc = c & 31, ob = rr * 64 + cc * 2; return st * 1024 + (ob ^ (((ob >> 9) & 1) << 5)); }
__host__ __device__ __forceinline__ void stage_rc(int b, int& R, int& C) { const int st = b / 1024, sb = b % 1024, swz = sb ^ (((sb >> 9) & 1) << 5); R = (st >> 1) * 16 + swz / 64; C = (st & 1) * 32 + (swz % 64) / 2; }
__host__ __device__ __forceinline__ int perm32(int rho) { const int n = rho >> 4, i = rho & 15; return 8 * (i >> 2) + 4 * n + (i & 3); }

struct Unit { int pm, pn, z; };
struct Gemm { const bf16_t* A; const bf16_t* Bt; int K, lda, ldb; long zsA, zsB; const bf16_t* A2; const bf16_t* Bt2; int ksplit; long cgA; };

__device__ __forceinline__ void swz_map(int L, int nM, int nN, int& pm, int& pn) {
    const int nwg = nM * nN; int wgid = L; { const int q = nwg / NXCD, r = nwg % NXCD, xcd = wgid % NXCD, off = wgid / NXCD; wgid = (xcd < r ? xcd * (q + 1) : r * (q + 1) + (xcd - r) * q) + off; }
    const int nig = WGM * nN, gid = wgid / nig, fm = gid * WGM, gsz = (nM - fm) < WGM ? (nM - fm) : WGM;
    pm = fm + ((wgid % nig) % gsz); pn = (wgid % nig) / gsz;
}
struct TileOrder {
    int nM, nN, nz, G, c, swz;
    __device__ __forceinline__ bool next(int i, Unit& u) const {
        const long L = (long)i * G + c; const int per = nM * nN; if (L >= (long)per * nz) return false;
        const int z = (int)(L / per), l = (int)(L % per); u.z = z;
        if (swz) swz_map(l, nM, nN, u.pm, u.pn); else { u.pm = l % nM; u.pn = l / nM; }
        return true;
    }
    __device__ __forceinline__ int nt(const Unit&, int K) const { return K / BK; }
};
struct SsmYOrder {
    int G, c;
    __device__ __forceinline__ bool next(int i, Unit& u) const {
        const long L = (long)i * G + c; if (L >= 32 * 16) return false;
        u.z = (int)(L >> 4); const int l = (int)(L & 15); u.pm = l & 3; u.pn = (i & 1) ? 3 - (l >> 2) : (l >> 2); return true;
    }
    __device__ __forceinline__ int nt(const Unit& u, int) const { return 6 + 4 * u.pn; }
};
struct PassOrder {
    int nM, nN, G, c;
    __device__ __forceinline__ bool next(int i, Unit& u) const {
        const long L = (long)(i >> 1) * G + c; if (L >= (long)nM * nN) return false;
        u.z = i & 1; swz_map((int)L, nM, nN, u.pm, u.pn); return true;
    }
    __device__ __forceinline__ int nt(const Unit&, int K) const { return K / BK; }
};

__device__ __forceinline__ unsigned cvt_pk_bf16(float lo, float hi) { unsigned r; asm volatile("v_cvt_pk_bf16_f32 %0, %1, %2" : "=v"(r) : "v"(lo), "v"(hi)); return r; }
__device__ __forceinline__ float bf_lo(unsigned w) { return __uint_as_float(w << 16); }
__device__ __forceinline__ float bf_hi(unsigned w) { return __uint_as_float(w & 0xffff0000u); }
__device__ __forceinline__ float sigm(float v) { return __builtin_amdgcn_rcpf(1.0f + __expf(-v)); }

template <class Epi, class Sched>
__device__ __forceinline__ void gemm_phase(PG8_LAS unsigned char* lds, const Gemm g, const Sched& S, const Epi& E) {
    const int tid = threadIdx.x, wid = __builtin_amdgcn_readfirstlane(tid >> 6), lane = tid & 63, wr = wid >> 2, wc = wid & 3, fr = lane & 15, fq = lane >> 4;
    unsigned voffA[2], voffB[2];
#pragma unroll
    for (int i = 0; i < 2; ++i) { int R, C; stage_rc(tid * 16 + i * 8192, R, C); const int Rb = (R & ~31) + perm32(R & 31);
        voffA[i] = (unsigned)(R * g.lda + (C & 15) + (long)(C >> 4) * g.cgA) * 2u; voffB[i] = (unsigned)(Rb * g.ldb + C) * 2u; }
    const size_t kstepA = (size_t)(4 * g.cgA * 2), kstepB = (size_t)(BK * 2);
    const size_t hstepA = (size_t)HALF * g.lda * 2, hstepB = (size_t)HALF * g.ldb * 2;
    const size_t tstepA = 2 * hstepA, tstepB = 2 * hstepB;
    const unsigned ldsw = (unsigned)wid * 1024u;
    const int aoff = lds_byte(wr * 64 + fr, fq * 8), boff = lds_byte(wc * 32 + fr, fq * 8);
#define PG8_SA(b, h) (((b) * 2 + (h)) * HTB)
#define PG8_SB(b, h) ((4 + (b) * 2 + (h)) * HTB)
#define PG8_STAGE(bufoff, gbase, voff) do { _Pragma("unroll") for (int _i = 0; _i < 2; ++_i) \
        __builtin_amdgcn_global_load_lds((const unsigned*)((const char*)(gbase) + (voff)[_i]), (PG8_LAS unsigned*)(lds + (bufoff) + ldsw + _i * 8192), 16, 0, 0); } while (0)
#define PG8_LDA(dst, b, h) do { _Pragma("unroll") for (int m = 0; m < 4; ++m) _Pragma("unroll") for (int k = 0; k < 2; ++k) dst[m][k] = *(const PG8_LAS bf16x8*)(lds + PG8_SA(b, h) + aoff + m * 2048 + k * 1024); } while (0)
#define PG8_LDB(dst, b, h) do { _Pragma("unroll") for (int n = 0; n < 2; ++n) _Pragma("unroll") for (int k = 0; k < 2; ++k) dst[n][k] = *(const PG8_LAS bf16x8*)(lds + PG8_SB(b, h) + boff + n * 2048 + k * 1024); } while (0)
#define PG8_MMA(ai, bj, At, Bt) do { __builtin_amdgcn_s_setprio(1); _Pragma("unroll") for (int m = 0; m < 4; ++m) _Pragma("unroll") for (int n = 0; n < 2; ++n) _Pragma("unroll") for (int k = 0; k < 2; ++k) \
        acc[ai][bj][m][n] = __builtin_amdgcn_mfma_f32_16x16x32_bf16(Bt[n][k], At[m][k], acc[ai][bj][m][n], 0, 0, 0); __builtin_amdgcn_s_setprio(0); } while (0)
#define PG8_WAIT_V(n) asm volatile("s_waitcnt vmcnt(" #n ")" ::: "memory")
#define PG8_WAIT_L(n) asm volatile("s_waitcnt lgkmcnt(" #n ")" ::: "memory")
#define PG8_BAR __builtin_amdgcn_s_barrier()
#define PG8_SCHED __builtin_amdgcn_sched_barrier(0)
    Unit cur, nxt; int ui = 0;
    if (!S.next(0, cur)) return;
    f32x4 acc[2][2][4][2];
#pragma unroll
    for (int a = 0; a < 2; ++a)
#pragma unroll
        for (int b = 0; b < 2; ++b)
#pragma unroll
            for (int m = 0; m < 4; ++m)
#pragma unroll
                for (int n = 0; n < 2; ++n) acc[a][b][m][n] = (f32x4){0.f, 0.f, 0.f, 0.f};
    bf16x8 At[4][2], B0[2][2], B1[2][2];
    const char* cA = (const char*)(g.A + (size_t)cur.z * g.zsA) + (size_t)cur.pm * tstepA; const char* cB = (const char*)(g.Bt + (size_t)cur.z * g.zsB) + (size_t)cur.pn * tstepB;
    PG8_STAGE(PG8_SB(0, 0), cB, voffB); PG8_STAGE(PG8_SB(0, 1), cB + hstepB, voffB); PG8_STAGE(PG8_SA(0, 0), cA, voffA); PG8_STAGE(PG8_SA(0, 1), cA + hstepA, voffA);
    if (wr == 1) PG8_BAR;
    PG8_WAIT_V(2); PG8_BAR;
    PG8_STAGE(PG8_SB(1, 0), cB + kstepB, voffB); PG8_STAGE(PG8_SA(1, 0), cA + kstepA, voffA); PG8_STAGE(PG8_SB(1, 1), cB + hstepB + kstepB, voffB);
    PG8_WAIT_V(6); PG8_BAR;
    for (;;) {
        const bool has_next = S.next(ui + 1, nxt);
        const int nt = S.nt(cur, g.K);
        const char* nA = has_next ? (const char*)(g.A + (size_t)nxt.z * g.zsA) + (size_t)nxt.pm * tstepA : cA; const char* nB = has_next ? (const char*)(g.Bt + (size_t)nxt.z * g.zsB) + (size_t)nxt.pn * tstepB : cB;
        const int ks = g.ksplit;
        const char* cA2 = ks ? (const char*)g.A2 + (size_t)cur.pm * tstepA - (size_t)ks * kstepA : cA; const char* cB2 = ks ? (const char*)g.Bt2 + (size_t)cur.pn * tstepB - (size_t)ks * kstepB : cB;
        for (int t = 0; t < nt; t += 2) {
            const bool last = (t == nt - 2);
            if constexpr (Epi::HAS_MID) { if (t == ks) E.mid(acc, cur, wr, wc, fr, fq); }
            const bool s1 = ks && (t + 1 >= ks), s2 = ks && (t + 2 >= ks);
            const char* a1 = (s1 ? cA2 : cA) + (size_t)(t + 1) * kstepA;
            const char* a2 = last ? nA : (s2 ? cA2 : cA) + (size_t)(t + 2) * kstepA; const char* b2 = last ? nB : (s2 ? cB2 : cB) + (size_t)(t + 2) * kstepB;
            const char* a3 = a2 + kstepA; const char* b3 = b2 + kstepB;
            PG8_LDB(B0, 0, 0); PG8_LDB(B1, 0, 1); PG8_SCHED; PG8_LDA(At, 0, 0); PG8_STAGE(PG8_SA(1, 1), a1 + hstepA, voffA);
            PG8_WAIT_V(8); PG8_WAIT_L(0); PG8_BAR; PG8_MMA(0, 0, At, B0); PG8_MMA(0, 1, At, B1); PG8_BAR; PG8_SCHED;
            PG8_LDA(At, 0, 1); PG8_STAGE(PG8_SB(0, 0), b2, voffB); PG8_STAGE(PG8_SB(0, 1), b2 + hstepB, voffB); PG8_STAGE(PG8_SA(0, 0), a2, voffA);
            PG8_WAIT_V(8); PG8_WAIT_L(0); PG8_BAR; PG8_MMA(1, 0, At, B0); PG8_MMA(1, 1, At, B1); PG8_BAR; PG8_SCHED;
            PG8_LDB(B0, 1, 0); PG8_LDB(B1, 1, 1); PG8_SCHED; PG8_LDA(At, 1, 0); PG8_STAGE(PG8_SA(0, 1), a2 + hstepA, voffA);
            PG8_WAIT_V(8); PG8_WAIT_L(0); PG8_BAR; PG8_MMA(0, 0, At, B0); PG8_MMA(0, 1, At, B1); PG8_BAR; PG8_SCHED;
            PG8_LDA(At, 1, 1); PG8_STAGE(PG8_SB(1, 0), b3, voffB); PG8_STAGE(PG8_SB(1, 1), b3 + hstepB, voffB); PG8_STAGE(PG8_SA(1, 0), a3, voffA);
            PG8_WAIT_V(8); PG8_WAIT_L(0); PG8_BAR; PG8_MMA(1, 0, At, B0); PG8_MMA(1, 1, At, B1); PG8_BAR; PG8_SCHED;
        }
        if (wr == 0) PG8_BAR;
        E(acc, cur, wr, wc, fr, fq);
        if (!has_next) break;
#pragma unroll
        for (int a = 0; a < 2; ++a)
#pragma unroll
            for (int b = 0; b < 2; ++b)
#pragma unroll
                for (int m = 0; m < 4; ++m)
#pragma unroll
                    for (int n = 0; n < 2; ++n) acc[a][b][m][n] = (f32x4){0.f, 0.f, 0.f, 0.f};
        cur = nxt; cA = nA; cB = nB; ++ui;
        if (wr == 1) PG8_BAR;
    }
    PG8_WAIT_V(0);
    PG8_BAR;
#undef PG8_SA
#undef PG8_SB
#undef PG8_STAGE
#undef PG8_LDA
#undef PG8_LDB
#undef PG8_MMA
#undef PG8_WAIT_V
#undef PG8_WAIT_L
#undef PG8_BAR
#undef PG8_SCHED
}
}

using pg8::bf16_t; using pg8::f32x4; using pg8::u32x4; using pg8::Unit; using pg8::cvt_pk_bf16; using pg8::bf_lo; using pg8::bf_hi; using pg8::sigm;
#define LAS __attribute__((address_space(3)))

constexpr int BATCH = 8, SEQ = 8192, DM = 1024, MTOK = BATCH * SEQ;
constexpr int NH = 8, HD = 64, AW = 512, SW = 512, NG = 32, GC = 16, NP = 64;
constexpr int INC = 5640;
constexpr int NPROJ = 5120;
constexpr int CH = 64, NCHK = MTOK / CH;
constexpr int KX = 1152;
constexpr float C2 = 0.125f * 1.4426950408889634f;
constexpr float LOG2E = 1.4426950408889634f;
constexpr float SKIP_LOG2 = 40.0f;

constexpr size_t MiB = 1u << 20;
constexpr size_t WS_SUMSQ = 0;
constexpr size_t WS_NRM = 512 * 1024;
constexpr size_t WS_LAM64 = 520 * 1024;
constexpr size_t WS_CNT = 576 * 1024;
constexpr size_t WS_BAR = 640 * 1024;
constexpr size_t WS_WIN = 1 * MiB;
constexpr size_t WS_WGLU = 11 * MiB;
constexpr size_t WS_WA = 12 * MiB;
constexpr size_t WS_WS = 13 * MiB;
constexpr size_t WS_WOUT = 14 * MiB;
constexpr size_t WS_LOGF = 16 * MiB;
constexpr size_t WS_CUM = 18 * MiB;
constexpr size_t WS_WEND = 20 * MiB;
constexpr size_t WS_E = 36 * MiB;
constexpr size_t WS_TZ = 52 * MiB;
constexpr size_t WS_U2 = 124 * MiB;
constexpr size_t WS_H = 196 * MiB;
constexpr size_t WS_YA = WS_H, WS_YS = WS_H + 64 * MiB;
constexpr size_t WS_Q = 324 * MiB, WS_K = 388 * MiB, WS_V = 452 * MiB, WS_GA = 516 * MiB, WS_GS = 580 * MiB;
constexpr size_t WS_MERGED = WS_Q;
constexpr size_t WS_MIXA = 644 * MiB, WS_MIXS = 772 * MiB;
constexpr size_t WS_PRE = WS_MIXA;
constexpr size_t WS_YS2 = 900 * MiB;
constexpr size_t WS_END = 964 * MiB;

constexpr int LDS_BYTES = 147456;

struct Params {
    const float *x, *norm_pre, *w_in, *b_forget, *lam_re, *lam_im, *log_dt, *b_re, *b_im, *c_re, *c_im, *d_skip, *w_glu, *b_glu, *w_a, *w_s, *w_out, *norm_post;
    float* out; unsigned char* ws; int ph_lo, ph_hi;
};

#define EPI_LOOP_BEGIN \
    _Pragma("unroll") for (int ai = 0; ai < 2; ++ai) _Pragma("unroll") for (int m = 0; m < 4; ++m) { const int row = u.pm * 256 + ai * 128 + wr * 64 + m * 16 + fr; \
    _Pragma("unroll") for (int bj = 0; bj < 2; ++bj) { const int ct = bj * 128 + wc * 32 + 8 * fq; f32x4 v0 = acc[ai][bj][m][0], v1 = acc[ai][bj][m][1];
#define EPI_LOOP_END } }
__device__ __forceinline__ u32x4 pack8(f32x4 a, f32x4 b) { u32x4 w; w.x = cvt_pk_bf16(a[0], a[1]); w.y = cvt_pk_bf16(a[2], a[3]); w.z = cvt_pk_bf16(b[0], b[1]); w.w = cvt_pk_bf16(b[2], b[3]); return w; }
__device__ __forceinline__ void unpack8(u32x4 w, f32x4& a, f32x4& b) { a = (f32x4){bf_lo(w.x), bf_hi(w.x), bf_lo(w.y), bf_hi(w.y)}; b = (f32x4){bf_lo(w.z), bf_hi(w.z), bf_lo(w.w), bf_hi(w.w)}; }

struct EpiProj {
    static constexpr bool HAS_MID = false;
    unsigned char* ws;
    __device__ __forceinline__ void operator()(const f32x4 (&acc)[2][2][4][2], const Unit& u, int wr, int wc, int fr, int fq) const {
        const int pn = u.pn;
        int act = 0, pitch = 512, cb = (pn & 1) * 256; size_t off; float sc = 1.f;
        if (pn < 2) { off = WS_Q; sc = C2; } else if (pn < 4) off = WS_K; else if (pn < 6) off = WS_V; else if (pn < 8) { off = WS_GA; act = 1; }
        else if (pn < 10) { off = WS_U2; act = 3; } else if (pn < 12) { off = WS_GS; act = 1; }
        else {
            bf16_t* RA = (bf16_t*)(ws + WS_MIXA); bf16_t* SS = (bf16_t*)(ws + WS_MIXS);
#pragma unroll
            for (int ai = 0; ai < 2; ++ai)
#pragma unroll
                for (int m = 0; m < 4; ++m) { const int row = u.pm * 256 + ai * 128 + wr * 64 + m * 16 + fr; const size_t o = (size_t)row * DM + (pn - 12) * 128 + wc * 32 + 8 * fq;
                    f32x4 r0, r1, s0, s1;
#pragma unroll
                    for (int e = 0; e < 4; ++e) {
                        const float ea0 = __expf(-fmaxf(acc[ai][0][m][0][e], -30.f)), ea1 = __expf(-fmaxf(acc[ai][0][m][1][e], -30.f));
                        const float es0 = __expf(-fmaxf(acc[ai][1][m][0][e], -30.f)), es1 = __expf(-fmaxf(acc[ai][1][m][1][e], -30.f));
                        r0[e] = (1.f + es0) * __builtin_amdgcn_rcpf(1.f + ea0); r1[e] = (1.f + es1) * __builtin_amdgcn_rcpf(1.f + ea1);
                        s0[e] = __builtin_amdgcn_rcpf(1.f + es0); s1[e] = __builtin_amdgcn_rcpf(1.f + es1); }
                    *(u32x4*)(RA + o) = pack8(r0, r1); *(u32x4*)(SS + o) = pack8(s0, s1); }
            return;
        }
        bf16_t* base = (bf16_t*)(ws + off);
        float mx0 = 0.f, mx1 = 0.f;
        EPI_LOOP_BEGIN
            v0 = v0 * sc; v1 = v1 * sc;
            if (act == 1) {
#pragma unroll
                for (int e = 0; e < 4; ++e) { v0[e] = v0[e] * sigm(v0[e]); v1[e] = v1[e] * sigm(v1[e]); }
            } else if (act == 2) {
#pragma unroll
                for (int e = 0; e < 4; ++e) { v0[e] = sigm(fmaxf(v0[e], -30.f)); v1[e] = sigm(fmaxf(v1[e], -30.f)); }
            }
            const u32x4 w = pack8(v0, v1);
            if (act == 3) { const int cu = cb + ct, gg = cu >> 4, c0 = cu & 15; *(u32x4*)(base + ((size_t)(gg * NCHK + (row >> 6)) * KX + 128 + (row & 63) * 16 + c0)) = w; }
            else *(u32x4*)(base + (size_t)row * pitch + cb + ct) = w;
            if (pn < 4) {
                float s = (v0[0] * v0[0] + v0[1] * v0[1]) + (v0[2] * v0[2] + v0[3] * v0[3]) + (v1[0] * v1[0] + v1[1] * v1[1]) + (v1[2] * v1[2] + v1[3] * v1[3]);
                s += __shfl_xor(s, 16); s += __shfl_xor(s, 32);
                if (bj == 0) mx0 = fmaxf(mx0, s); else mx1 = fmaxf(mx1, s);
            }
        EPI_LOOP_END
        if (pn < 4) {
#pragma unroll
            for (int o = 1; o < 16; o <<= 1) { mx0 = fmaxf(mx0, __shfl_xor(mx0, o)); mx1 = fmaxf(mx1, __shfl_xor(mx1, o)); }
            if ((threadIdx.x & 63) == 0) {
                unsigned* nrm = (unsigned*)(ws + WS_NRM); const int b = u.pm >> 5, which = (pn >> 1) * 2 + (wc & 1);
                const int h0 = (pn & 1) * 4 + (wc >> 1), h1 = h0 + 2;
                atomicMax(nrm + (b * 8 + h0) * 4 + which, __float_as_uint(mx0 * 1.02f));
                atomicMax(nrm + (b * 8 + h1) * 4 + which, __float_as_uint(mx1 * 1.02f));
            }
        }
    }
};
struct EpiSsmE {
    static constexpr bool HAS_MID = false;
    float* E;
    __device__ __forceinline__ void operator()(const f32x4 (&acc)[2][2][4][2], const Unit& u, int wr, int wc, int fr, int fq) const {
        EPI_LOOP_BEGIN
            if (bj == 0) { float* p = E + ((size_t)(u.z * NCHK + row) * 128 + ct); *(f32x4*)p = v0; *(f32x4*)(p + 4) = v1; }
        EPI_LOOP_END
    }
};
__device__ __forceinline__ float gelu_t(float x) { const float y = 0.7978845608028654f * (x + 0.044715f * x * x * x); return x * sigm(2.0f * y); }
struct EpiSsmY {
    static constexpr bool HAS_MID = false;
    bf16_t* YS;
    __device__ __forceinline__ void operator()(const f32x4 (&acc)[2][2][4][2], const Unit& u, int wr, int wc, int fr, int fq) const {
        EPI_LOOP_BEGIN
#pragma unroll
            for (int e = 0; e < 4; ++e) { v0[e] = gelu_t(v0[e]); v1[e] = gelu_t(v1[e]); }
            const int j = u.pn * 256 + ct, t = j >> 4, c0 = j & 15;
            *(u32x4*)(YS + (((size_t)u.z * MTOK + row * CH + t) * 16 + c0)) = pack8(v0, v1);
        EPI_LOOP_END
    }
};
struct EpiGlu {
    static constexpr bool HAS_MID = false;
    const bf16_t* YS; const bf16_t* GS; const float* bias; bf16_t* O;
    __device__ __forceinline__ void operator()(const f32x4 (&acc)[2][2][4][2], const Unit& u, int wr, int wc, int fr, int fq) const {
        EPI_LOOP_BEGIN
            const int col = u.pn * 256 + ct; const size_t o = (size_t)row * SW + col;
            const f32x4 b0 = *(const f32x4*)(bias + col), b1 = *(const f32x4*)(bias + col + 4);
            f32x4 y0, y1, g0, g1; unpack8(*(const u32x4*)(YS + (((size_t)(col >> 4) * MTOK + row) * 16 + (col & 15))), y0, y1); unpack8(*(const u32x4*)(GS + o), g0, g1);
#pragma unroll
            for (int e = 0; e < 4; ++e) { v0[e] = y0[e] * sigm(v0[e] + b0[e]) * g0[e]; v1[e] = y1[e] * sigm(v1[e] + b1[e]) * g1[e]; }
            *(u32x4*)(O + o) = pack8(v0, v1);
        EPI_LOOP_END
    }
};
struct EpiMerge {
    static constexpr bool HAS_MID = true;
    const bf16_t* MA; const bf16_t* MS; bf16_t* O;
    __device__ __forceinline__ void mid(f32x4 (&acc)[2][2][4][2], const Unit& u, int wr, int wc, int fr, int fq) const {
        __builtin_amdgcn_sched_barrier(0);
        unsigned o0 = (unsigned)((u.pm * 256 + wr * 64 + fr) * DM + u.pn * 256 + wc * 32 + 8 * fq);
        asm volatile("" : "+v"(o0));
#pragma unroll
        for (int ai = 0; ai < 2; ++ai) { u32x4 rr[2][4];
#pragma unroll
            for (int bj = 0; bj < 2; ++bj)
#pragma unroll
                for (int m = 0; m < 4; ++m) rr[bj][m] = *(const u32x4*)(MA + (o0 + (unsigned)((ai * 128 + m * 16) * DM + bj * 128)));
#pragma unroll
            for (int bj = 0; bj < 2; ++bj)
#pragma unroll
                for (int m = 0; m < 4; ++m) { f32x4 a0, a1; unpack8(rr[bj][m], a0, a1); acc[ai][bj][m][0] *= a0; acc[ai][bj][m][1] *= a1; }
            __builtin_amdgcn_sched_barrier(0); }
    }
    __device__ __forceinline__ void operator()(const f32x4 (&acc)[2][2][4][2], const Unit& u, int wr, int wc, int fr, int fq) const {
        unsigned o0 = (unsigned)((u.pm * 256 + wr * 64 + fr) * DM + u.pn * 256 + wc * 32 + 8 * fq);
#pragma unroll
        for (int ai = 0; ai < 2; ++ai) { u32x4 gg[2][4];
#pragma unroll
            for (int bj = 0; bj < 2; ++bj)
#pragma unroll
                for (int m = 0; m < 4; ++m) gg[bj][m] = *(const u32x4*)(MS + (o0 + (unsigned)((ai * 128 + m * 16) * DM + bj * 128)));
#pragma unroll
            for (int bj = 0; bj < 2; ++bj)
#pragma unroll
                for (int m = 0; m < 4; ++m) { f32x4 s0, s1; unpack8(gg[bj][m], s0, s1);
                    *(u32x4*)(O + (o0 + (unsigned)((ai * 128 + m * 16) * DM + bj * 128))) = pack8(acc[ai][bj][m][0] * s0, acc[ai][bj][m][1] * s1); }
            __builtin_amdgcn_sched_barrier(0); }
    }
};
struct EpiOut {
    static constexpr bool HAS_MID = false;
    bf16_t* pre; float* sumsq;
    __device__ __forceinline__ void operator()(const f32x4 (&acc)[2][2][4][2], const Unit& u, int wr, int wc, int fr, int fq) const {
#pragma unroll
        for (int ai = 0; ai < 2; ++ai)
#pragma unroll
            for (int m = 0; m < 4; ++m) { const int row = u.pm * 256 + ai * 128 + wr * 64 + m * 16 + fr; float s = 0.f;
#pragma unroll
                for (int bj = 0; bj < 2; ++bj) { const f32x4 v0 = acc[ai][bj][m][0], v1 = acc[ai][bj][m][1];
                    *(u32x4*)(pre + (size_t)row * DM + u.pn * 256 + bj * 128 + wc * 32 + 8 * fq) = pack8(v0, v1);
                    s += (v0[0] * v0[0] + v0[1] * v0[1]) + (v0[2] * v0[2] + v0[3] * v0[3]) + (v1[0] * v1[0] + v1[1] * v1[1]) + (v1[2] * v1[2] + v1[3] * v1[3]); }
                s += __shfl_xor(s, 16); s += __shfl_xor(s, 32);
                if (fq == 0) atomicAdd(sumsq + row, s); }
    }
};

namespace att {
typedef short bf16x8 __attribute__((ext_vector_type(8)));
typedef short s16x4 __attribute__((ext_vector_type(4)));
typedef float f32x16 __attribute__((ext_vector_type(16)));
constexpr int SLOTB = 8192;
constexpr int L_K = 0, L_V = 2 * SLOTB, L_B = 5 * SLOTB, L_WS = L_B + 512,
                         L_CNT = L_WS + 2048, L_OST = L_CNT + 128;
static_assert(L_OST + 8 * 8192 <= 131072, "attention LDS");
__device__ __forceinline__ int crow(int r, int hi) { return (r & 3) + 8 * (r >> 2) + 4 * hi; }
typedef float f32x2_t __attribute__((ext_vector_type(2))); typedef __bf16 bf16x2_t __attribute__((ext_vector_type(2)));
__device__ __forceinline__ unsigned cvtpk_s(float lo, float hi) { f32x2_t v = {lo, hi}; bf16x2_t b = __builtin_convertvector(v, bf16x2_t); return __builtin_bit_cast(unsigned, b); }
__device__ __forceinline__ float rowmax(const f32x16& p0, const f32x16& p1) {
    float a = fmaxf(p0[0], p1[0]);
#pragma unroll
    for (int r = 1; r < 16; ++r) a = fmaxf(a, fmaxf(p0[r], p1[r]));
    auto rr = __builtin_amdgcn_permlane32_swap(__float_as_uint(a), __float_as_uint(a), false, false);
    return fmaxf(__uint_as_float(rr[0]), __uint_as_float(rr[1]));
}
__device__ __forceinline__ void pv(f32x16* o, int vb, bf16x8 pa0, bf16x8 pa1, bf16x8 pa2, bf16x8 pa3) {
#pragma unroll
    for (int d0 = 0; d0 < 2; ++d0) { s16x4 lo[4], hi[4];
#pragma unroll
        for (int ks = 0; ks < 4; ++ks) {
            asm volatile("ds_read_b64_tr_b16 %0,%1 offset:%c2" : "=&v"(lo[ks]) : "v"(vb), "i"(d0 * 4096 + ks * 1024) : "memory");
            asm volatile("ds_read_b64_tr_b16 %0,%1 offset:%c2" : "=&v"(hi[ks]) : "v"(vb), "i"(d0 * 4096 + ks * 1024 + 512) : "memory"); }
        asm volatile("s_waitcnt lgkmcnt(0)" ::: "memory"); __builtin_amdgcn_sched_barrier(0);
#define PK(k) (bf16x8){lo[k][0], lo[k][1], lo[k][2], lo[k][3], hi[k][0], hi[k][1], hi[k][2], hi[k][3]}
        o[d0] = __builtin_amdgcn_mfma_f32_32x32x16_bf16(pa0, PK(0), o[d0], 0, 0, 0);
        o[d0] = __builtin_amdgcn_mfma_f32_32x32x16_bf16(pa1, PK(1), o[d0], 0, 0, 0);
        o[d0] = __builtin_amdgcn_mfma_f32_32x32x16_bf16(pa2, PK(2), o[d0], 0, 0, 0);
        o[d0] = __builtin_amdgcn_mfma_f32_32x32x16_bf16(pa3, PK(3), o[d0], 0, 0, 0);
#undef PK
    }
}
__device__ __forceinline__ void attn_unit(int b, int h, int qb, unsigned char* ws, LAS unsigned char* shm) {
    const int tid = threadIdx.x, lane = tid & 63, r32 = lane & 31, hi = lane >> 5; const int wid = __builtin_amdgcn_readfirstlane(tid >> 6);
    const long rowbase = (long)b * SEQ; const int q0 = qb * 256;
    const bf16_t* Qw = (const bf16_t*)(ws + WS_Q) + (rowbase + q0 + wid * 32) * AW + h * HD;
    const bf16_t* Kh = (const bf16_t*)(ws + WS_K) + rowbase * AW + h * HD; const bf16_t* Vh = (const bf16_t*)(ws + WS_V) + rowbase * AW + h * HD;
    const float* cum = (const float*)(ws + WS_CUM) + (size_t)(b * NH + h) * SEQ;
    const unsigned lds0 = (unsigned)(uintptr_t)shm;
    LAS float* wsf = (LAS float*)(shm + L_WS) + wid * 64;
    LAS int* cnt = (LAS int*)(shm + L_CNT);
    const float cref = cum[q0];
    const unsigned* nr = (const unsigned*)(ws + WS_NRM) + (b * NH + h) * 4;
    const float qn2 = __uint_as_float(nr[0]) + __uint_as_float(nr[1]), kn2 = __uint_as_float(nr[2]) + __uint_as_float(nr[3]);
    const float X = SKIP_LOG2 + 2.0f * (sqrtf(qn2 * kn2) * 1.01f + 0.01f);
    const float Sb = sqrtf(qn2 * kn2) * 1.01f + 0.01f;
    float bend = 0.f; if (tid < 4 * qb) bend = cref - cum[64 * tid + 63];
    int pred = (tid < 4 * qb && bend < -X) ? 1 : 0;
    { const unsigned long long bal = __ballot(pred); if (lane == 0) cnt[wid] = __popcll(bal); }
    __syncthreads();
    int tile_lo = 0;
#pragma unroll
    for (int w = 0; w < 8; ++w) tile_lo += cnt[w];
    const int NT = 4 * qb + 4;
    bf16x8 qr[4];
#pragma unroll
    for (int d0 = 0; d0 < 4; ++d0) qr[d0] = *(const bf16x8*)(Qw + (long)r32 * AW + d0 * 16 + hi * 8);
    const bf16_t* ksrc = Kh + (long)lane * AW + wid * 8;
    const bf16_t* vsrc = Vh + (long)(16 * (wid & 3) + (lane >> 2)) * AW + (wid >> 2) * 32 + (lane & 3) * 8;
    const int koff = wid * 1024 + lane * 16;
    const int vb0 = (int)(lds0 + L_V) + ((lane >> 4) & 1) * 32 + (lane & 3) * 8 + (4 * hi + ((lane & 15) >> 2)) * 64;
    int t = NT - 1;
    u32x4 kA = *(const u32x4*)(ksrc + (long)t * 64 * AW), vA = *(const u32x4*)(vsrc + (long)t * 64 * AW);
    float bA = (tid < 64) ? (cref - cum[64 * t + tid]) : 0.f;
    u32x4 kB = kA, vB = vA; float bB = 0.f;
    if (t - 1 >= tile_lo) { kB = *(const u32x4*)(ksrc + (long)(t - 1) * 64 * AW); vB = *(const u32x4*)(vsrc + (long)(t - 1) * 64 * AW); bB = (tid < 64) ? (cref - cum[64 * (t - 1) + tid]) : 0.f; }
    float mhat = -1e30f, l_reg = 0.f; f32x16 o[2]; o[0] = f32x16{}; o[1] = f32x16{};
    const int qrel = wid * 32 + r32;
    int cur = 0, vcur = 0, vprev = 2;
    u32x4 pw0 = (u32x4){0u, 0u, 0u, 0u}, pw1 = pw0, pw2 = pw0, pw3 = pw0;
#define ATT_STEP(KR, VR, BR) do { \
        *(LAS u32x4*)(shm + L_K + cur * SLOTB + koff) = KR; *(LAS u32x4*)(shm + L_V + vcur * SLOTB + koff) = VR; \
        if (tid < 64) *(LAS float*)(shm + L_B + cur * 256 + tid * 4) = BR; \
        asm volatile("s_waitcnt lgkmcnt(0)\n\ts_barrier" ::: "memory");     \
        if (t - 2 >= tile_lo) { KR = *(const u32x4*)(ksrc + (long)(t - 2) * 64 * AW); VR = *(const u32x4*)(vsrc + (long)(t - 2) * 64 * AW); BR = (tid < 64) ? (cref - cum[64 * (t - 2) + tid]) : 0.f; } \
        att_tile(); \
    } while (0)
    auto att_tile = [&]() __attribute__((always_inline)) {
        const int jb = t - (NT - 4);
        if (jb <= (wid >> 1)) {
            f32x16 p0, p1;
            { const LAS float* bb = (const LAS float*)(shm + L_B + cur * 256);
#pragma unroll
              for (int g4 = 0; g4 < 4; ++g4) { const f32x4 a = *(const LAS f32x4*)(bb + 8 * g4 + 4 * hi), c = *(const LAS f32x4*)(bb + 32 + 8 * g4 + 4 * hi);
#pragma unroll
                  for (int e = 0; e < 4; ++e) { p0[4 * g4 + e] = a[e]; p1[4 * g4 + e] = c[e]; } } }
            { const LAS unsigned char* kb = shm + L_K + cur * SLOTB + hi * 1024 + r32 * 16;
              __builtin_amdgcn_s_setprio(1);
#pragma unroll
              for (int d0 = 0; d0 < 4; ++d0) { const bf16x8 b0 = *(const LAS bf16x8*)(kb + d0 * 2048), b1 = *(const LAS bf16x8*)(kb + d0 * 2048 + 512);
                  p0 = __builtin_amdgcn_mfma_f32_32x32x16_bf16(b0, qr[d0], p0, 0, 0, 0); p1 = __builtin_amdgcn_mfma_f32_32x32x16_bf16(b1, qr[d0], p1, 0, 0, 0); } }
            pv(o, vb0 + vprev * SLOTB, __builtin_bit_cast(bf16x8, pw0), __builtin_bit_cast(bf16x8, pw1), __builtin_bit_cast(bf16x8, pw2), __builtin_bit_cast(bf16x8, pw3));
            __builtin_amdgcn_s_setprio(0);
            if (jb >= 0) { const int kb0 = 64 * jb + 4 * hi;
#pragma unroll
                for (int r = 0; r < 16; ++r) { const int kv = kb0 + (r & 3) + 8 * (r >> 2); if (kv > qrel) p0[r] = -INFINITY; if (kv + 32 > qrel) p1[r] = -INFINITY; } }
            const float rm = rowmax(p0, p1);
            const float mnew = fmaxf(mhat, rm);
            if (__any(mnew > mhat)) {
                const float alpha = __builtin_amdgcn_exp2f(mhat - mnew); l_reg *= alpha; mhat = mnew;
                if (hi == 0) wsf[r32] = alpha;
                asm volatile("s_waitcnt lgkmcnt(0)" ::: "memory");
#pragma unroll
                for (int r = 0; r < 16; ++r) { const float f = wsf[crow(r, hi)]; o[0][r] *= f; o[1][r] *= f; }
            }
            float sacc = 0.f;
#pragma unroll
            for (int r = 0; r < 16; ++r) { p0[r] = __builtin_amdgcn_exp2f(p0[r] - mhat); p1[r] = __builtin_amdgcn_exp2f(p1[r] - mhat); sacc += p0[r] + p1[r]; }
            l_reg += sacc;
            pw0 = (u32x4){cvtpk_s(p0[0], p0[1]), cvtpk_s(p0[2], p0[3]), cvtpk_s(p0[4], p0[5]), cvtpk_s(p0[6], p0[7])};
            pw1 = (u32x4){cvtpk_s(p0[8], p0[9]), cvtpk_s(p0[10], p0[11]), cvtpk_s(p0[12], p0[13]), cvtpk_s(p0[14], p0[15])};
            pw2 = (u32x4){cvtpk_s(p1[0], p1[1]), cvtpk_s(p1[2], p1[3]), cvtpk_s(p1[4], p1[5]), cvtpk_s(p1[6], p1[7])};
            pw3 = (u32x4){cvtpk_s(p1[8], p1[9]), cvtpk_s(p1[10], p1[11]), cvtpk_s(p1[12], p1[13]), cvtpk_s(p1[14], p1[15])};
        }
        cur ^= 1; vprev = vcur; vcur = (vcur == 2) ? 0 : vcur + 1;
        if (jb == 0 && tile_lo < NT - 4) {
            float mm = mhat;
#pragma unroll
            for (int o2 = 1; o2 < 64; o2 <<= 1) mm = fminf(mm, __shfl_xor(mm, o2));
            LAS float* mw = (LAS float*)(shm + L_CNT) + 8;
            if (lane == 0) mw[wid] = mm;
            __syncthreads();
            float mmin = mw[0];
#pragma unroll
            for (int w = 1; w < 8; ++w) mmin = fminf(mmin, mw[w]);
            const float X2 = SKIP_LOG2 + Sb - mmin;
            const int pred2 = (tid < 4 * qb && bend < -X2) ? 1 : 0;
            { const unsigned long long bal = __ballot(pred2); if (lane == 0) cnt[wid] = __popcll(bal); }
            __syncthreads();
            int tl2 = 0;
#pragma unroll
            for (int w = 0; w < 8; ++w) tl2 += cnt[w];
            tile_lo = tl2 > tile_lo ? tl2 : tile_lo;
        }
    };
    for (;;) {
        ATT_STEP(kA, vA, bA); --t; if (t < tile_lo) break;
        ATT_STEP(kB, vB, bB); --t; if (t < tile_lo) break;
    }
#undef ATT_STEP
    pv(o, vb0 + vprev * SLOTB, __builtin_bit_cast(bf16x8, pw0), __builtin_bit_cast(bf16x8, pw1), __builtin_bit_cast(bf16x8, pw2), __builtin_bit_cast(bf16x8, pw3));
    { auto rr = __builtin_amdgcn_permlane32_swap(__float_as_uint(l_reg), __float_as_uint(l_reg), false, false); l_reg = __uint_as_float(rr[0]) + __uint_as_float(rr[1]); }
    if (hi == 0) wsf[32 + r32] = l_reg;
    asm volatile("s_waitcnt lgkmcnt(0)" ::: "memory");
    LAS float* stg = (LAS float*)(shm + L_OST) + wid * 2048;
#pragma unroll
    for (int r = 0; r < 16; ++r) { const int orow = crow(r, hi); const float rl = __builtin_amdgcn_rcpf(wsf[32 + orow]);
        stg[orow * 64 + r32] = o[0][r] * rl; stg[orow * 64 + 32 + r32] = o[1][r] * rl; }
    asm volatile("s_waitcnt lgkmcnt(0)" ::: "memory");
    const bf16_t* GAw = (const bf16_t*)(ws + WS_GA) + (rowbase + q0 + wid * 32) * AW + h * HD;
    bf16_t* Ow = (bf16_t*)(ws + WS_YA) + (rowbase + q0 + wid * 32) * AW + h * HD;
#pragma unroll
    for (int i = 0; i < 4; ++i) { const int row = i * 8 + (lane >> 3), ch = lane & 7;
        f32x4 a = *(const LAS f32x4*)(stg + row * 64 + ch * 8), c = *(const LAS f32x4*)(stg + row * 64 + ch * 8 + 4);
        f32x4 g0, g1; unpack8(*(const u32x4*)(GAw + (long)row * AW + ch * 8), g0, g1);
        *(u32x4*)(Ow + (long)row * AW + ch * 8) = pack8(a * g0, c * g1); }
    __syncthreads();
}
}

__device__ __forceinline__ unsigned f2bf(float f) { unsigned u = __builtin_bit_cast(unsigned, f); return (u + 0x7fffu + ((u >> 16) & 1u)) >> 16; }
__device__ __forceinline__ unsigned pk2(float lo, float hi) { return f2bf(lo) | (f2bf(hi) << 16); }
__device__ __forceinline__ float wave_sum(float v) {
#pragma unroll
    for (int o = 1; o < 64; o <<= 1) v += __shfl_xor(v, o);
    return v;
}
__device__ __forceinline__ void transpose_item(const float* W, int K, int ldw, int N, int col_shift_from, bf16_t* WT, LAS float* scr, int item, int lane) {
    const int nblk = N / 32, kb = item / nblk, nb = item % nblk, k0 = 64 * kb, n0 = 32 * nb;
    int sc0 = n0;
    if (col_shift_from >= 0) { if (n0 >= 3072) { const int T = (n0 - 3072) >> 8, j = (n0 - 3072) & 255; sc0 = (j < 128) ? 3080 + T * 128 + j : 4104 + T * 128 + (j - 128); } else if (n0 >= 1536) sc0 = n0 + 8; }
#pragma unroll 8
    for (int i = 0; i < 32; ++i) { const int kk = 2 * i + (lane >> 5); scr[kk * 33 + (lane & 31)] = W[(size_t)(k0 + kk) * ldw + sc0 + (lane & 31)]; }
    asm volatile("s_waitcnt lgkmcnt(0)" ::: "memory");
    const int c = lane & 7;
#pragma unroll
    for (int j = 0; j < 4; ++j) { const int n = (lane >> 3) + 8 * j; const LAS float* s = scr + (8 * c) * 33 + n;
        u32x4 o; o.x = pk2(s[0 * 33], s[1 * 33]); o.y = pk2(s[2 * 33], s[3 * 33]); o.z = pk2(s[4 * 33], s[5 * 33]); o.w = pk2(s[6 * 33], s[7 * 33]);
        *(u32x4*)(WT + (size_t)(n0 + n) * K + k0 + 8 * c) = o; }
    asm volatile("s_waitcnt lgkmcnt(0)" ::: "memory");
}
__device__ __forceinline__ void sincos_d(double x, double& s, double& c) {
    const double k = rint(x * 0.63661977236758134308);
    const double r = (x - k * 1.57079632679489655800) - k * 6.123233995736766035869e-17;
    const double r2 = r * r;
    const double sp = r * (1.0 + r2 * (-1.0 / 6 + r2 * (1.0 / 120 + r2 * (-1.0 / 5040 + r2 * (1.0 / 362880 + r2 * (-1.0 / 39916800 + r2 * (1.0 / 6227020800.0)))))));
    const double cp = 1.0 + r2 * (-0.5 + r2 * (1.0 / 24 + r2 * (-1.0 / 720 + r2 * (1.0 / 40320 + r2 * (-1.0 / 3628800 + r2 * (1.0 / 479001600.0 + r2 * (-1.0 / 87178291200.0)))))));
    const int q = ((int)k) & 3;
    s = (q == 0) ? sp : (q == 1) ? cp : (q == 2) ? -sp : -cp;
    c = (q == 0) ? cp : (q == 1) ? -sp : (q == 2) ? -cp : sp;
}
__device__ __forceinline__ double exp_d(double x) {
    const double n = rint(x * 1.44269504088896340736);
    const double r = (x - n * 0.693147180369123816490) - n * 1.90821492927058770002e-10;
    double p = 1.0 / 6227020800.0;
    p = p * r + 1.0 / 479001600.0; p = p * r + 1.0 / 39916800.0; p = p * r + 1.0 / 3628800.0; p = p * r + 1.0 / 362880.0; p = p * r + 1.0 / 40320.0;
    p = p * r + 1.0 / 5040.0; p = p * r + 1.0 / 720.0; p = p * r + 1.0 / 120.0; p = p * r + 1.0 / 24.0; p = p * r + 1.0 / 6.0; p = p * r + 0.5; p = p * r + 1.0; p = p * r + 1.0;
    const long long bits = ((long long)((int)n + 1023)) << 52;
    return p * __builtin_bit_cast(double, bits);
}

__device__ __forceinline__ void ssm_ops_item(const Params& p, int g, int c, LAS unsigned char* lds) {
    typedef float f32x2 __attribute__((ext_vector_type(2)));
    LAS f32x2* P = (LAS f32x2*)lds;
    LAS f32x2* Bb = (LAS f32x2*)(lds + 33280);
    LAS f32x2* Cc = (LAS f32x2*)(lds + 41472);
    LAS float* Km = (LAS float*)(lds + 41984);
    const int tid = threadIdx.x;
    if (tid < 64) {
        const int pp = tid;
        const double dt = exp_d((double)p.log_dt[g]); const double lr = (double)p.lam_re[g * 64 + pp], li = (double)p.lam_im[g * 64 + pp];
        const double mag = exp_d(lr * dt); double sn, cs; sincos_d(li * dt, sn, cs);
        const double abr = mag * cs, abi = mag * sn, den = lr * lr + li * li, nre = abr - 1.0;
        const double fre = (nre * lr + abi * li) / den, fim = (abi * lr - nre * li) / den;
        double pr = 1.0, pi = 0.0;
        for (int j = 0; j <= 64; ++j) { P[j * 64 + pp] = (f32x2){(float)pr, (float)pi}; const double nr = pr * abr - pi * abi, ni = pr * abi + pi * abr; pr = nr; pi = ni; }
        if (c == 0) ((f32x2*)(p.ws + WS_LAM64))[g * 64 + pp] = P[64 * 64 + pp];
        for (int q = 0; q < 16; ++q) { const double br = (double)p.b_re[(g * 64 + pp) * 16 + q], bi = (double)p.b_im[(g * 64 + pp) * 16 + q];
            Bb[pp * 16 + q] = (f32x2){(float)(fre * br - fim * bi), (float)(fre * bi + fim * br)}; }
        Cc[pp] = (f32x2){p.c_re[(g * 16 + c) * 64 + pp], p.c_im[(g * 16 + c) * 64 + pp]};
    }
    __syncthreads();
    {
        const int j = tid >> 3, q0 = (tid & 7) * 2;
        float k0 = 0.f, k1 = 0.f;
        for (int pp = 0; pp < 64; ++pp) {
            const f32x2 cc = Cc[pp], gg = P[j * 64 + pp], b0 = Bb[pp * 16 + q0], b1 = Bb[pp * 16 + q0 + 1];
            const float clr = cc.x * gg.x - cc.y * gg.y, cli = cc.x * gg.y + cc.y * gg.x;
            k0 += clr * b0.x - cli * b0.y; k1 += clr * b1.x - cli * b1.y;
        }
        if (j == 0) { const float d = p.d_skip[g * 16 + c]; if (q0 == c) k0 += d; if (q0 + 1 == c) k1 += d; }
        Km[j * 16 + q0] = k0; Km[j * 16 + q0 + 1] = k1;
    }
    __syncthreads();
    {
        bf16_t* TZ = (bf16_t*)(p.ws + WS_TZ) + (size_t)g * 1024 * KX;
        for (int idx = tid; idx < 64 * 144; idx += 512) {
            const int t = idx / 144, i = idx % 144, col = 8 * i;
            float v[8];
            if (col >= 128) { const int s = (col - 128) >> 4, chh = (col >> 3) & 1;
                if (s <= t) { const LAS float* k = Km + (t - s) * 16 + chh * 8;
#pragma unroll
                    for (int e = 0; e < 8; ++e) v[e] = k[e]; }
                else {
#pragma unroll
                    for (int e = 0; e < 8; ++e) v[e] = 0.f; }
            } else { const int p0 = col >> 1;
#pragma unroll
                for (int e = 0; e < 4; ++e) { const f32x2 cc = Cc[p0 + e], gg = P[(t + 1) * 64 + p0 + e]; v[2 * e] = cc.x * gg.x - cc.y * gg.y; v[2 * e + 1] = -(cc.x * gg.y + cc.y * gg.x); } }
            u32x4 w; w.x = pk2(v[0], v[1]); w.y = pk2(v[2], v[3]); w.z = pk2(v[4], v[5]); w.w = pk2(v[6], v[7]);
            *(u32x4*)(TZ + (size_t)(t * 16 + c) * KX + col) = w;
        }
        bf16_t* WE = (bf16_t*)(p.ws + WS_WEND) + (size_t)g * 256 * 1024;
        for (int idx = tid; idx < 16 * 128; idx += 512) {
            const int rl = idx >> 7, i = idx & 127, s = i >> 1, chh = i & 1;
            const int row = (rl < 8) ? (8 * c + rl) : (128 + 8 * c + (rl - 8));
            float v[8];
            if (rl < 8) { const int pp = row >> 1, ri = row & 1; const f32x2 gg = P[(63 - s) * 64 + pp];
#pragma unroll
                for (int e = 0; e < 8; ++e) { const f32x2 bb = Bb[pp * 16 + chh * 8 + e]; v[e] = ri ? (gg.x * bb.y + gg.y * bb.x) : (gg.x * bb.x - gg.y * bb.y); } }
            else {
#pragma unroll
                for (int e = 0; e < 8; ++e) v[e] = 0.f; }
            u32x4 w; w.x = pk2(v[0], v[1]); w.y = pk2(v[2], v[3]); w.z = pk2(v[4], v[5]); w.w = pk2(v[6], v[7]);
            *(u32x4*)(WE + (size_t)row * 1024 + 8 * i) = w;
        }
    }
    __syncthreads();
}

#define XB_TMO      128
#define XB_XCNT(j)  (256  + 64 * (j))
#define XB_XSUB(j)  (1280 + 64 * (j))
#define XB_XGEN(j)  (2304 + 64 * (j))
#define XB_TOP      3328
#define XB_TOPGEN   3392
#define XCD_BAR_WORDS 3456
#define XB_SPIN_CAP (1u << 18)
__device__ __forceinline__ unsigned xb_ld(unsigned* p)              { return __hip_atomic_load(p, __ATOMIC_RELAXED, __HIP_MEMORY_SCOPE_AGENT); }
__device__ __forceinline__ unsigned xb_add(unsigned* p, unsigned v) { return __hip_atomic_fetch_add(p, v, __ATOMIC_RELAXED, __HIP_MEMORY_SCOPE_AGENT); }
__device__ __forceinline__ unsigned xb_xcc_id() { return (unsigned)__builtin_amdgcn_s_getreg((3 << 11) | 20) & 0xFu; }
#define XB_SPIN(cond, bar) do { unsigned _sp = 0; while (cond) { __builtin_amdgcn_s_sleep(1); \
    if ((++_sp & 255u) == 0u) { if (xb_ld(&(bar)[XB_TMO])) break; if (_sp > XB_SPIN_CAP) { atomicAdd(&(bar)[XB_TMO], 1u); break; } } } } while (0)
struct XcdBarrier { unsigned* bar; unsigned x; volatile LAS unsigned* st; };
__device__ __forceinline__ XcdBarrier xcd_barrier_post(unsigned* bar, volatile LAS unsigned* st) {
    XcdBarrier b; b.bar = bar; b.x = xb_xcc_id(); b.st = st;
    if (threadIdx.x == 0) (void)xb_add(&bar[XB_XCNT(b.x)], 1u);
    return b;
}
__device__ __forceinline__ void xcd_barrier_complete(unsigned* bar, unsigned x, unsigned& nloc, unsigned& nx) {
    const unsigned G = gridDim.x * gridDim.y * gridDim.z;
    unsigned sum, cnt, mine, sp = 0u;
    for (;;) {
        sum = 0u; cnt = 0u; mine = 0u;
#pragma unroll
        for (unsigned j = 0; j < 16; ++j) { const unsigned c = xb_ld(&bar[XB_XCNT(j)]); sum += c; cnt += (c > 0u) ? 1u : 0u; mine = (j == x) ? c : mine; }
        if (sum == G) break;
        __builtin_amdgcn_s_sleep(1);
        if ((++sp & 255u) == 0u) { if (xb_ld(&bar[XB_TMO])) break; if (sp > XB_SPIN_CAP) { atomicAdd(&bar[XB_TMO], 1u); break; } }
    }
    nloc = mine > 0u ? mine : 1u; nx = cnt > 0u ? cnt : 1u;
}
__device__ __forceinline__ void xcd_barrier(const XcdBarrier& b) {
    asm volatile("s_waitcnt vmcnt(0)" ::: "memory");
    __syncthreads();
    if (threadIdx.x == 0) {
        unsigned* bar = b.bar;
        __builtin_amdgcn_s_waitcnt(0);
        unsigned nloc = b.st[0], nx = b.st[1];
        if (nloc == 0u) { xcd_barrier_complete(bar, b.x, nloc, nx); b.st[0] = nloc; b.st[1] = nx; }
        const unsigned old = xb_add(&bar[XB_XSUB(b.x)], 1u);
        const unsigned gen = old / nloc;
        if (old + 1u == (gen + 1u) * nloc) {
            __builtin_amdgcn_fence(__ATOMIC_RELEASE, "agent");
            asm volatile("s_waitcnt vmcnt(0)" ::: "memory");
            const unsigned og = xb_add(&bar[XB_TOP], 1u);
            const unsigned tg = og / nx;
            if (og + 1u == (tg + 1u) * nx) xb_add(&bar[XB_TOPGEN], 1u);
            else XB_SPIN(xb_ld(&bar[XB_TOPGEN]) == tg, bar);
            __builtin_amdgcn_fence(__ATOMIC_ACQUIRE, "agent");
            xb_add(&bar[XB_XGEN(b.x)], 1u);
            asm volatile("s_waitcnt vmcnt(0)" ::: "memory");
        } else {
            XB_SPIN(xb_ld(&bar[XB_XGEN(b.x)]) == gen, bar);
            __builtin_amdgcn_fence(__ATOMIC_ACQUIRE, "agent");
            asm volatile("s_waitcnt vmcnt(0)" ::: "memory");
        }
    }
    __syncthreads();
}

__global__ void __launch_bounds__(512) fwd_megakernel(Params p) {
    extern __shared__ __attribute__((aligned(16))) unsigned char lds_raw[];
    LAS unsigned char* lds = (LAS unsigned char*)lds_raw;
    cg::grid_group grid = cg::this_grid();
    const int tid = threadIdx.x, lane = tid & 63, wave = __builtin_amdgcn_readfirstlane(tid >> 6);
    const int G = gridDim.x, bx = blockIdx.x;
    unsigned char* ws = p.ws;
    const int lo = p.ph_lo, hi = p.ph_hi;
#define IN(k) (lo <= (k) && (k) < hi)
    volatile LAS unsigned* bst = (volatile LAS unsigned*)(lds + 131072 + 128);
    if (tid == 0) { bst[0] = 0u; bst[1] = 0u; }
    __syncthreads();
    XcdBarrier xbar; xbar.bar = (unsigned*)(ws + WS_BAR); xbar.x = 0; xbar.st = bst;
#define SEAM(k) do { if (IN(k) && IN((k) + 1)) { if ((k) == 0) { grid.sync(); xbar = xcd_barrier_post((unsigned*)(ws + WS_BAR), bst); } else xcd_barrier(xbar); } } while (0)

    if (IN(0)) {
        for (int i = bx * 512 + tid; i < MTOK; i += G * 512) ((float*)(ws + WS_SUMSQ))[i] = 0.f;
        if (bx == 0) for (int i = tid; i < 2048; i += 512) ((unsigned*)(ws + WS_NRM))[i] = 0u;
        if (bx == 1 || G == 1) for (int i = tid; i < 256 * 64; i += 512) ((unsigned*)(ws + WS_CNT))[i] = 0u;
        if (bx == 2 || G < 3) for (int i = tid; i < XCD_BAR_WORDS; i += 512) ((unsigned*)(ws + WS_BAR))[i] = 0u;
        const int gw = bx * 8 + wave, NGW = G * 8;
        auto partL = [&]() __attribute__((always_inline)) {
        for (int it = bx; it < NG * 16; it += G) ssm_ops_item(p, it >> 4, it & 15, lds);
        LAS float* scr = (LAS float*)(lds + wave * 8704);
        constexpr int I_IN = 16 * (NPROJ / 32), I_GLU = 8 * 16, I_A = 8 * 32, I_S = 8 * 32, I_O = 16 * 32, NIT = I_IN + I_GLU + I_A + I_S + I_O;
        for (int it = gw; it < NIT; it += NGW) {
            int r = it;
            if (r < I_IN) { transpose_item(p.w_in, DM, INC, NPROJ, 0, (bf16_t*)(ws + WS_WIN), scr, r, lane); continue; } r -= I_IN;
            if (r < I_GLU) { transpose_item(p.w_glu, SW, SW, SW, -1, (bf16_t*)(ws + WS_WGLU), scr, r, lane); continue; } r -= I_GLU;
            if (r < I_A) { transpose_item(p.w_a, AW, DM, DM, -1, (bf16_t*)(ws + WS_WA), scr, r, lane); continue; } r -= I_A;
            if (r < I_S) { transpose_item(p.w_s, SW, DM, DM, -1, (bf16_t*)(ws + WS_WS), scr, r, lane); continue; } r -= I_S;
            transpose_item(p.w_out, DM, DM, DM, -1, (bf16_t*)(ws + WS_WOUT), scr, r, lane);
        }
        };
        auto partR = [&]() __attribute__((always_inline)) {
        LAS float* wf = (LAS float*)(lds + 73728);
        for (int i = tid; i < 8192; i += 512) { const int k = i >> 3, j = i & 7; wf[j * 1024 + k] = p.w_in[(size_t)k * INC + 1536 + j]; }
        __syncthreads();
        f32x4 gn[4];
#pragma unroll
        for (int j = 0; j < 4; ++j) gn[j] = ((const f32x4*)p.norm_pre)[lane + 64 * j];
        f32x4 wreg[8][4];
#pragma unroll
        for (int e = 0; e < 8; ++e)
#pragma unroll
            for (int j = 0; j < 4; ++j) wreg[e][j] = *(const LAS f32x4*)(wf + e * 1024 + 4 * lane + 256 * j);
        const int fidx = ((lane & 1) << 2) | (lane & 2) | ((lane & 4) >> 2);
        const float bfg = p.b_forget[fidx];
        f32x4 vn[4];
        if (gw < MTOK) {
#pragma unroll
            for (int j = 0; j < 4; ++j) vn[j] = ((const f32x4*)(p.x + (size_t)gw * DM) + lane)[64 * j];
        }
        for (int m = gw; m < MTOK; m += NGW) {
            f32x4 v[4]; float s = 0.f;
#pragma unroll
            for (int j = 0; j < 4; ++j) v[j] = vn[j];
            if (m + NGW < MTOK) {
#pragma unroll
                for (int j = 0; j < 4; ++j) vn[j] = ((const f32x4*)(p.x + (size_t)(m + NGW) * DM) + lane)[64 * j];
            }
#pragma unroll
            for (int j = 0; j < 4; ++j) s += (v[j][0] * v[j][0] + v[j][1] * v[j][1]) + (v[j][2] * v[j][2] + v[j][3] * v[j][3]);
            const float rstd = 1.0f / sqrtf(wave_sum(s) * (1.f / DM) + 1e-6f);
            unsigned long long* o8 = (unsigned long long*)((bf16_t*)(ws + WS_H) + (size_t)m * DM) + lane;
            float fa[8];
#pragma unroll
            for (int e = 0; e < 8; ++e) fa[e] = 0.f;
#pragma unroll
            for (int j = 0; j < 4; ++j) { v[j] = v[j] * rstd * gn[j];
                o8[64 * j] = (unsigned long long)pk2(v[j][0], v[j][1]) | ((unsigned long long)pk2(v[j][2], v[j][3]) << 32);
#pragma unroll
                for (int e = 0; e < 8; ++e) { const f32x4 w = wreg[e][j]; fa[e] += (v[j][0] * w[0] + v[j][1] * w[1]) + (v[j][2] * w[2] + v[j][3] * w[3]); } }
#pragma unroll
            for (int e = 0; e < 4; ++e) { const float a = fa[e], c = fa[e + 4]; const bool up = lane & 1; fa[e] = (up ? c : a) + __shfl_xor(up ? a : c, 1); }
#pragma unroll
            for (int e = 0; e < 2; ++e) { const float a = fa[e], c = fa[e + 2]; const bool up = lane & 2; fa[e] = (up ? c : a) + __shfl_xor(up ? a : c, 2); }
            { const float a = fa[0], c = fa[1]; const bool up = lane & 4; fa[0] = (up ? c : a) + __shfl_xor(up ? a : c, 4); }
            float z = fa[0];
            z += __shfl_xor(z, 8); z += __shfl_xor(z, 16); z += __shfl_xor(z, 32);
            if (lane < 8) { z += bfg;
                const float ls = fminf(z, 0.f) - log1pf(expf(-fabsf(z)));
                ((float*)(ws + WS_LOGF))[(size_t)m * 8 + fidx] = ls; }
        }
        };
        if ((bx >> 3) & 1) { partR(); __syncthreads(); partL(); } else { partL(); __syncthreads(); partR(); }
        __syncthreads();
    }
    SEAM(0);

    if (IN(1)) {
        for (int bh = bx; bh < BATCH * NH; bh += G) {
            const int b = bh >> 3, h = bh & 7;
            const float* lf = (const float*)(ws + WS_LOGF) + (size_t)b * SEQ * 8 + h;
            float v[16]; float s = 0.f;
#pragma unroll
            for (int e = 0; e < 16; ++e) { s += lf[(size_t)(tid * 16 + e) * 8]; v[e] = s; }
            float incl = s;
#pragma unroll
            for (int o = 1; o < 64; o <<= 1) { const float n = __shfl_up(incl, o); if (lane >= o) incl += n; }
            LAS float* wt = (LAS float*)lds;
            if (lane == 63) wt[wave] = incl;
            __syncthreads();
            float base = incl - s;
            for (int w = 0; w < wave; ++w) base += wt[w];
            float* co = (float*)(ws + WS_CUM) + (size_t)bh * SEQ + tid * 16;
#pragma unroll
            for (int e = 0; e < 16; ++e) co[e] = (base + v[e]) * LOG2E;
            __syncthreads();
        }
        pg8::Gemm g{(const bf16_t*)(ws + WS_H), (const bf16_t*)(ws + WS_WIN), DM, DM, DM, 0, 0, nullptr, nullptr, 0, 16};
        pg8::TileOrder S{MTOK / 256, NPROJ / 256, 1, G, bx, 1};
        EpiProj E{ws};
        pg8::gemm_phase(lds, g, S, E);
    }
    SEAM(1);

    if (IN(2)) {
        {
            pg8::Gemm g{(const bf16_t*)(ws + WS_U2) + 128, (const bf16_t*)(ws + WS_WEND), 1024, KX, 1024, (long)NCHK * KX, 256L * 1024, nullptr, nullptr, 0, 16};
            pg8::TileOrder S{NCHK / 256, 1, NG, G, G - 1 - bx, 0};
            EpiSsmE E{(float*)(ws + WS_E)};
            pg8::gemm_phase(lds, g, S, E);
        }
        __syncthreads();
        {
            unsigned* uctr = (unsigned*)(ws + WS_NRM) + 1024;
            LAS int* nxt = (LAS int*)(lds + 131072 + 256);
            for (;;) {
                if (tid == 0) *nxt = (int)atomicAdd(uctr, 1u);
                __syncthreads();
                const int uidx = *nxt;
                __syncthreads();
                if (uidx >= BATCH * NH * 32) break;
                const int bh = uidx & 63, qb = 31 - (uidx >> 6);
                att::attn_unit(bh >> 3, bh & 7, qb, ws, lds);
            }
        }
    }
    SEAM(2);

    if (IN(3)) {
        typedef float f32x2 __attribute__((ext_vector_type(2)));
        LAS f32x2* ex = (LAS f32x2*)lds;
        for (int idx = bx; idx < BATCH * NG; idx += G) {
            const int b = idx >> 5, g = idx & 31, pp = lane;
            const f32x2 L = ((const f32x2*)(ws + WS_LAM64))[g * 64 + pp];
            f32x2 L16 = L;
#pragma unroll
            for (int q = 0; q < 4; ++q) L16 = (f32x2){L16.x * L16.x - L16.y * L16.y, 2.f * L16.x * L16.y};
            const float* Eb = (const float*)(ws + WS_E) + ((size_t)(g * NCHK + b * 128 + 16 * wave) * 128 + 2 * pp);
            bf16_t* Ub = (bf16_t*)(ws + WS_U2) + ((size_t)(g * NCHK + b * 128 + 16 * wave) * KX + 2 * pp);
            f32x2 e[16];
#pragma unroll
            for (int j = 0; j < 16; ++j) e[j] = *(const f32x2*)(Eb + (size_t)j * 128);
            float sr = 0.f, si = 0.f;
#pragma unroll
            for (int j = 0; j < 16; ++j) { const float nr = L.x * sr - L.y * si + e[j].x, ni = L.x * si + L.y * sr + e[j].y; sr = nr; si = ni; }
            ex[wave * 64 + pp] = (f32x2){sr, si};
            __syncthreads();
            sr = 0.f; si = 0.f;
            for (int w = 0; w < wave; ++w) { const f32x2 en = ex[w * 64 + pp]; const float nr = L16.x * sr - L16.y * si + en.x, ni = L16.x * si + L16.y * sr + en.y; sr = nr; si = ni; }
#pragma unroll
            for (int j = 0; j < 16; ++j) {
                *(unsigned*)(Ub + (size_t)j * KX) = pk2(sr, si);
                const float nr = L.x * sr - L.y * si + e[j].x, ni = L.x * si + L.y * sr + e[j].y; sr = nr; si = ni;
            }
            __syncthreads();
        }
    }
    SEAM(3);

    if (IN(4)) {
        pg8::Gemm g{(const bf16_t*)(ws + WS_U2), (const bf16_t*)(ws + WS_TZ), KX, KX, KX, (long)NCHK * KX, 1024L * KX, nullptr, nullptr, 0, 16};
        pg8::SsmYOrder S{G, bx};
        EpiSsmY E{(bf16_t*)(ws + WS_YS)};
        pg8::gemm_phase(lds, g, S, E);
    }
    SEAM(4);

    if (IN(5)) {
        pg8::Gemm g{(const bf16_t*)(ws + WS_YS), (const bf16_t*)(ws + WS_WGLU), SW, 16, SW, 0, 0, nullptr, nullptr, 0, (long)MTOK * 16};
        pg8::TileOrder S{MTOK / 256, SW / 256, 1, G, bx, 1};
        EpiGlu E{(const bf16_t*)(ws + WS_YS), (const bf16_t*)(ws + WS_GS), p.b_glu, (bf16_t*)(ws + WS_YS2)};
        pg8::gemm_phase(lds, g, S, E);
    }
    SEAM(5);

    if (IN(6)) {
        pg8::Gemm g{(const bf16_t*)(ws + WS_YA), (const bf16_t*)(ws + WS_WA), 1024, 512, 512, 0, 0, (const bf16_t*)(ws + WS_YS2), (const bf16_t*)(ws + WS_WS), 8, 16};
        pg8::TileOrder S{MTOK / 256, DM / 256, 1, G, bx, 1};
        EpiMerge E{(const bf16_t*)(ws + WS_MIXA), (const bf16_t*)(ws + WS_MIXS), (bf16_t*)(ws + WS_MERGED)};
        pg8::gemm_phase(lds, g, S, E);
    }
    SEAM(6);

    if (IN(7)) {
        pg8::Gemm g{(const bf16_t*)(ws + WS_MERGED), (const bf16_t*)(ws + WS_WOUT), DM, DM, DM, 0, 0, nullptr, nullptr, 0, 16};
        pg8::TileOrder S{MTOK / 256, DM / 256, 1, G, bx, 1};
        EpiOut E{(bf16_t*)(ws + WS_PRE), (float*)(ws + WS_SUMSQ)};
        pg8::gemm_phase(lds, g, S, E);
    }

    SEAM(7);

    if (IN(8)) {
        const int gw = bx * 8 + wave, NGW = G * 8;
        f32x4 gn[4];
#pragma unroll
        for (int j = 0; j < 4; ++j) gn[j] = ((const f32x4*)p.norm_post)[lane + 64 * j];
        for (int m = gw; m < MTOK; m += NGW) {
            const float rstd = 1.0f / sqrtf(((const float*)(ws + WS_SUMSQ))[m] * (1.f / DM) + 1e-6f);
            const f32x4* xr = (const f32x4*)(p.x + (size_t)m * DM) + lane; f32x4* orow = (f32x4*)(p.out + (size_t)m * DM) + lane;
            const unsigned long long* pr = (const unsigned long long*)((const bf16_t*)(ws + WS_PRE) + (size_t)m * DM) + lane;
            f32x4 xv[4]; unsigned long long pv8[4];
#pragma unroll
            for (int j = 0; j < 4; ++j) { xv[j] = xr[64 * j]; pv8[j] = pr[64 * j]; }
#pragma unroll
            for (int j = 0; j < 4; ++j) { const unsigned lo32 = (unsigned)pv8[j], hi32 = (unsigned)(pv8[j] >> 32);
                const f32x4 pf = (f32x4){bf_lo(lo32), bf_hi(lo32), bf_lo(hi32), bf_hi(hi32)};
                orow[64 * j] = xv[j] + pf * rstd * gn[j]; }
        }
    }
#undef IN
#undef SEAM
}

extern "C" void kernel_launch(void* const* d_in, const int* in_sizes, int n_in, void* d_out, int out_size, void* d_ws, size_t ws_size, hipStream_t stream) {
    static int grid = 0;
    if (grid == 0) {
        if (n_in != 18 || out_size != MTOK * DM || ws_size < WS_END) { fprintf(stderr, "kernel_launch: unexpected shapes (n_in %d, out %d, ws %zu)\n", n_in, out_size, ws_size); grid = -1; return; }
        int dev = 0, cus = 0, per_cu = 0;
        hipGetDevice(&dev); hipDeviceGetAttribute(&cus, hipDeviceAttributeMultiprocessorCount, dev);
        if (hipFuncSetAttribute((const void*)fwd_megakernel, hipFuncAttributeMaxDynamicSharedMemorySize, LDS_BYTES) != hipSuccess) { fprintf(stderr, "kernel_launch: hipFuncSetAttribute failed\n"); grid = -1; return; }
        if (hipOccupancyMaxActiveBlocksPerMultiprocessor(&per_cu, (const void*)fwd_megakernel, 512, LDS_BYTES) != hipSuccess || per_cu < 1) { fprintf(stderr, "kernel_launch: occupancy query says %d\n", per_cu); per_cu = 1; }
        (void)hipGetLastError();
        grid = cus < 256 ? cus : 256;
    }
    if (grid < 0) return;
    Params p{};
    p.x = (const float*)d_in[0]; p.norm_pre = (const float*)d_in[1]; p.w_in = (const float*)d_in[2]; p.b_forget = (const float*)d_in[3];
    p.lam_re = (const float*)d_in[4]; p.lam_im = (const float*)d_in[5]; p.log_dt = (const float*)d_in[6]; p.b_re = (const float*)d_in[7]; p.b_im = (const float*)d_in[8];
    p.c_re = (const float*)d_in[9]; p.c_im = (const float*)d_in[10]; p.d_skip = (const float*)d_in[11]; p.w_glu = (const float*)d_in[12]; p.b_glu = (const float*)d_in[13];
    p.w_a = (const float*)d_in[14]; p.w_s = (const float*)d_in[15]; p.w_out = (const float*)d_in[16]; p.norm_post = (const float*)d_in[17];
    p.out = (float*)d_out; p.ws = (unsigned char*)d_ws;
#if MK_MULTI
    for (int ph = 0; ph < 9; ++ph) { p.ph_lo = ph; p.ph_hi = ph + 1; hipLaunchKernelGGL(fwd_megakernel, dim3(grid), dim3(512), LDS_BYTES, stream, p); }
#else
    p.ph_lo = 0; p.ph_hi = 9;
    void* args[] = {&p};
    hipError_t e = hipLaunchCooperativeKernel((const void*)fwd_megakernel, dim3(grid), dim3(512), args, LDS_BYTES, stream);
    if (e != hipSuccess) fprintf(stderr, "cooperative launch failed: %s (grid %d)\n", hipGetErrorString(e), grid);
#endif
}
```

```cpp
#include <hip/hip_runtime.h>
#include <hip/hip_cooperative_groups.h>
#include <hip/hip_bf16.h>
#include <cstdio>
#include <cstdint>
#include <cmath>
namespace cg = cooperative_groups;

#ifndef MK_MULTI
#define MK_MULTI 0
#endif

namespace pg8 {
#define PG8_LAS __attribute__((address_space(3)))
typedef unsigned short bf16_t;
typedef short bf16x8 __attribute__((ext_vector_type(8)));
typedef float f32x4 __attribute__((ext_vector_type(4)));
typedef unsigned u32x4 __attribute__((ext_vector_type(4)));
constexpr int BM = 256, BK = 64, HALF = 128, HTB = HALF * BK * 2, STAGE_BYTES = 8 * HTB, NXCD = 8, WGM = 4;

__host__ __device__ __forceinline__ int lds_byte(int r, int c) { const int st = (r >> 4) * 2 + (c >> 5), rr = r & 15, cc = c & 31, ob = rr * 64 + cc * 2; return st * 1024 + (ob ^ (((ob >> 9) & 1) << 5)); }
__host__ __device__ __forceinline__ void stage_rc(int b, int& R, int& C) { const int st = b / 1024, sb = b % 1024, swz = sb ^ (((sb >> 9) & 1) << 5); R = (st >> 1) * 16 + swz / 64; C = (st & 1) * 32 + (swz % 64) / 2; }
__host__ __device__ __forceinline__ int perm32(int rho) { const int n = rho >> 4, i = rho & 15; return 8 * (i >> 2) + 4 * n + (i & 3); }

struct Unit { int pm, pn, z; };
struct Gemm { const bf16_t* A; const bf16_t* Bt; int K, lda, ldb; long zsA, zsB; const bf16_t* A2; const bf16_t* Bt2; int ksplit; long cgA; };

__device__ __forceinline__ void swz_map(int L, int nM, int nN, int& pm, int& pn) {
    const int nwg = nM * nN; int wgid = L; { const int q = nwg / NXCD, r = nwg % NXCD, xcd = wgid % NXCD, off = wgid / NXCD; wgid = (xcd < r ? xcd * (q + 1) : r * (q + 1) + (xcd - r) * q) + off; }
    const int nig = WGM * nN, gid = wgid / nig, fm = gid * WGM, gsz = (nM - fm) < WGM ? (nM - fm) : WGM;
    pm = fm + ((wgid % nig) % gsz); pn = (wgid % nig) / gsz;
}
struct TileOrder {
    int nM, nN, nz, G, c, swz;
    __device__ __forceinline__ bool next(int i, Unit& u) const {
        const long L = (long)i * G + c; const int per = nM * nN; if (L >= (long)per * nz) return false;
        const int z = (int)(L / per), l = (int)(L % per); u.z = z;
        if (swz) swz_map(l, nM, nN, u.pm, u.pn); else { u.pm = l % nM; u.pn = l / nM; }
        return true;
    }
    __device__ __forceinline__ int nt(const Unit&, int K) const { return K / BK; }
};
struct SsmYOrder {
    int G, c;
    __device__ __forceinline__ bool next(int i, Unit& u) const {
        const long L = (long)i * G + c; if (L >= 32 * 16) return false;
        u.z = (int)(L >> 4); const int l = (int)(L & 15); u.pm = l & 3; u.pn = (i & 1) ? 3 - (l >> 2) : (l >> 2); return true;
    }
    __device__ __forceinline__ int nt(const Unit& u, int) const { return 6 + 4 * u.pn; }
};
struct PassOrder {
    int nM, nN, G, c;
    __device__ __forceinline__ bool next(int i, Unit& u) const {
        const long L = (long)(i >> 1) * G + c; if (L >= (long)nM * nN) return false;
        u.z = i & 1; swz_map((int)L, nM, nN, u.pm, u.pn); return true;
    }
    __device__ __forceinline__ int nt(const Unit&, int K) const { return K / BK; }
};

__device__ __forceinline__ unsigned cvt_pk_bf16(float lo, float hi) { unsigned r; asm volatile("v_cvt_pk_bf16_f32 %0, %1, %2" : "=v"(r) : "v"(lo), "v"(hi)); return r; }
__device__ __forceinline__ float bf_lo(unsigned w) { return __uint_as_float(w << 16); }
__device__ __forceinline__ float bf_hi(unsigned w) { return __uint_as_float(w & 0xffff0000u); }
__device__ __forceinline__ float sigm(float v) { return __builtin_amdgcn_rcpf(1.0f + __expf(-v)); }

template <class Epi, class Sched>
__device__ __forceinline__ void gemm_phase(PG8_LAS unsigned char* lds, const Gemm g, const Sched& S, const Epi& E) {
    const int tid = threadIdx.x, wid = __builtin_amdgcn_readfirstlane(tid >> 6), lane = tid & 63, wr = wid >> 2, wc = wid & 3, fr = lane & 15, fq = lane >> 4;
    unsigned voffA[2], voffB[2];
#pragma unroll
    for (int i = 0; i < 2; ++i) { int R, C; stage_rc(tid * 16 + i * 8192, R, C); const int Rb = (R & ~31) + perm32(R & 31);
        voffA[i] = (unsigned)(R * g.lda + (C & 15) + (long)(C >> 4) * g.cgA) * 2u; voffB[i] = (unsigned)(Rb * g.ldb + C) * 2u; }
    const size_t kstepA = (size_t)(4 * g.cgA * 2), kstepB = (size_t)(BK * 2);
    const size_t hstepA = (size_t)HALF * g.lda * 2, hstepB = (size_t)HALF * g.ldb * 2;
    const size_t tstepA = 2 * hstepA, tstepB = 2 * hstepB;
    const unsigned ldsw = (unsigned)wid * 1024u;
    const int aoff = lds_byte(wr * 64 + fr, fq * 8), boff = lds_byte(wc * 32 + fr, fq * 8);
#define PG8_SA(b, h) (((b) * 2 + (h)) * HTB)
#define PG8_SB(b, h) ((4 + (b) * 2 + (h)) * HTB)
#define PG8_STAGE(bufoff, gbase, voff) do { _Pragma("unroll") for (int _i = 0; _i < 2; ++_i) \
        __builtin_amdgcn_global_load_lds((const unsigned*)((const char*)(gbase) + (voff)[_i]), (PG8_LAS unsigned*)(lds + (bufoff) + ldsw + _i * 8192), 16, 0, 0); } while (0)
#define PG8_LDA(dst, b, h) do { _Pragma("unroll") for (int m = 0; m < 4; ++m) _Pragma("unroll") for (int k = 0; k < 2; ++k) dst[m][k] = *(const PG8_LAS bf16x8*)(lds + PG8_SA(b, h) + aoff + m * 2048 + k * 1024); } while (0)
#define PG8_LDB(dst, b, h) do { _Pragma("unroll") for (int n = 0; n < 2; ++n) _Pragma("unroll") for (int k = 0; k < 2; ++k) dst[n][k] = *(const PG8_LAS bf16x8*)(lds + PG8_SB(b, h) + boff + n * 2048 + k * 1024); } while (0)
#define PG8_MMA(ai, bj, At, Bt) do { __builtin_amdgcn_s_setprio(1); _Pragma("unroll") for (int m = 0; m < 4; ++m) _Pragma("unroll") for (int n = 0; n < 2; ++n) _Pragma("unroll") for (int k = 0; k < 2; ++k) \
        acc[ai][bj][m][n] = __builtin_amdgcn_mfma_f32_16x16x32_bf16(Bt[n][k], At[m][k], acc[ai][bj][m][n], 0, 0, 0); __builtin_amdgcn_s_setprio(0); } while (0)
#define PG8_WAIT_V(n) asm volatile("s_waitcnt vmcnt(" #n ")" ::: "memory")
#define PG8_WAIT_L(n) asm volatile("s_waitcnt lgkmcnt(" #n ")" ::: "memory")
#define PG8_BAR __builtin_amdgcn_s_barrier()
#define PG8_SCHED __builtin_amdgcn_sched_barrier(0)
    Unit cur, nxt; int ui = 0;
    if (!S.next(0, cur)) return;
    f32x4 acc[2][2][4][2];
#pragma unroll
    for (int a = 0; a < 2; ++a)
#pragma unroll
        for (int b = 0; b < 2; ++b)
#pragma unroll
            for (int m = 0; m < 4; ++m)
#pragma unroll
                for (int n = 0; n < 2; ++n) acc[a][b][m][n] = (f32x4){0.f, 0.f, 0.f, 0.f};
    bf16x8 At[4][2], B0[2][2], B1[2][2];
    const char* cA = (const char*)(g.A + (size_t)cur.z * g.zsA) + (size_t)cur.pm * tstepA; const char* cB = (const char*)(g.Bt + (size_t)cur.z * g.zsB) + (size_t)cur.pn * tstepB;
    PG8_STAGE(PG8_SB(0, 0), cB, voffB); PG8_STAGE(PG8_SB(0, 1), cB + hstepB, voffB); PG8_STAGE(PG8_SA(0, 0), cA, voffA); PG8_STAGE(PG8_SA(0, 1), cA + hstepA, voffA);
    if (wr == 1) PG8_BAR;
    PG8_WAIT_V(2); PG8_BAR;
    PG8_STAGE(PG8_SB(1, 0), cB + kstepB, voffB); PG8_STAGE(PG8_SA(1, 0), cA + kstepA, voffA); PG8_STAGE(PG8_SB(1, 1), cB + hstepB + kstepB, voffB);
    PG8_WAIT_V(6); PG8_BAR;
    for (;;) {
        const bool has_next = S.next(ui + 1, nxt);
        const int nt = S.nt(cur, g.K);
        const char* nA = has_next ? (const char*)(g.A + (size_t)nxt.z * g.zsA) + (size_t)nxt.pm * tstepA : cA; const char* nB = has_next ? (const char*)(g.Bt + (size_t)nxt.z * g.zsB) + (size_t)nxt.pn * tstepB : cB;
        const int ks = g.ksplit;
        const char* cA2 = ks ? (const char*)g.A2 + (size_t)cur.pm * tstepA - (size_t)ks * kstepA : cA; const char* cB2 = ks ? (const char*)g.Bt2 + (size_t)cur.pn * tstepB - (size_t)ks * kstepB : cB;
        for (int t = 0; t < nt; t += 2) {
            const bool last = (t == nt - 2);
            if constexpr (Epi::HAS_MID) { if (t == ks) E.mid(acc, cur, wr, wc, fr, fq); }
            const bool s1 = ks && (t + 1 >= ks), s2 = ks && (t + 2 >= ks);
            const char* a1 = (s1 ? cA2 : cA) + (size_t)(t + 1) * kstepA;
            const char* a2 = last ? nA : (s2 ? cA2 : cA) + (size_t)(t + 2) * kstepA; const char* b2 = last ? nB : (s2 ? cB2 : cB) + (size_t)(t + 2) * kstepB;
            const char* a3 = a2 + kstepA; const char* b3 = b2 + kstepB;
            PG8_LDB(B0, 0, 0); PG8_LDB(B1, 0, 1); PG8_SCHED; PG8_LDA(At, 0, 0); PG8_STAGE(PG8_SA(1, 1), a1 + hstepA, voffA);
            PG8_WAIT_V(8); PG8_WAIT_L(0); PG8_BAR; PG8_MMA(0, 0, At, B0); PG8_MMA(0, 1, At, B1); PG8_BAR; PG8_SCHED;
            PG8_LDA(At, 0, 1); PG8_STAGE(PG8_SB(0, 0), b2, voffB); PG8_STAGE(PG8_SB(0, 1), b2 + hstepB, voffB); PG8_STAGE(PG8_SA(0, 0), a2, voffA);
            PG8_WAIT_V(8); PG8_WAIT_L(0); PG8_BAR; PG8_MMA(1, 0, At, B0); PG8_MMA(1, 1, At, B1); PG8_BAR; PG8_SCHED;
            PG8_LDB(B0, 1, 0); PG8_LDB(B1, 1, 1); PG8_SCHED; PG8_LDA(At, 1, 0); PG8_STAGE(PG8_SA(0, 1), a2 + hstepA, voffA);
            PG8_WAIT_V(8); PG8_WAIT_L(0); PG8_BAR; PG8_MMA(0, 0, At, B0); PG8_MMA(0, 1, At, B1); PG8_BAR; PG8_SCHED;
            PG8_LDA(At, 1, 1); PG8_STAGE(PG8_SB(1, 0), b3, voffB); PG8_STAGE(PG8_SB(1, 1), b3 + hstepB, voffB); PG8_STAGE(PG8_SA(1, 0), a3, voffA);
            PG8_WAIT_V(8); PG8_WAIT_L(0); PG8_BAR; PG8_MMA(1, 0, At, B0); PG8_MMA(1, 1, At, B1); PG8_BAR; PG8_SCHED;
        }
        if (wr == 0) PG8_BAR;
        E(acc, cur, wr, wc, fr, fq);
        if (!has_next) break;
#pragma unroll
        for (int a = 0; a < 2; ++a)
#pragma unroll
            for (int b = 0; b < 2; ++b)
#pragma unroll
                for (int m = 0; m < 4; ++m)
#pragma unroll
                    for (int n = 0; n < 2; ++n) acc[a][b][m][n] = (f32x4){0.f, 0.f, 0.f, 0.f};
        cur = nxt; cA = nA; cB = nB; ++ui;
        if (wr == 1) PG8_BAR;
    }
    PG8_WAIT_V(0);
    PG8_BAR;
#undef PG8_SA
#undef PG8_SB
#undef PG8_STAGE
#undef PG8_LDA
#undef PG8_LDB
#undef PG8_MMA
#undef PG8_WAIT_V
#undef PG8_WAIT_L
#undef PG8_BAR
#undef PG8_SCHED
}
}

using pg8::bf16_t; using pg8::f32x4; using pg8::u32x4; using pg8::Unit; using pg8::cvt_pk_bf16; using pg8::bf_lo; using pg8::bf_hi; using pg8::sigm;
#define LAS __attribute__((address_space(3)))

constexpr int BATCH = 8, SEQ = 8192, DM = 1024, MTOK = BATCH * SEQ;
constexpr int NH = 8, HD = 64, AW = 512, SW = 512, NG = 32, GC = 16, NP = 64;
constexpr int INC = 5640;
constexpr int NPROJ = 5120;
constexpr int CH = 64, NCHK = MTOK / CH;
constexpr int KX = 1152;
constexpr float C2 = 0.125f * 1.4426950408889634f;
constexpr float LOG2E = 1.4426950408889634f;
constexpr float SKIP_LOG2 = 40.0f;

constexpr size_t MiB = 1u << 20;
constexpr size_t WS_SUMSQ = 0;
constexpr size_t WS_NRM = 512 * 1024;
constexpr size_t WS_LAM64 = 520 * 1024;
constexpr size_t WS_CNT = 576 * 1024;
constexpr size_t WS_BAR = 640 * 1024;
constexpr size_t WS_WIN = 1 * MiB;
constexpr size_t WS_WGLU = 11 * MiB;
constexpr size_t WS_WA = 12 * MiB;
constexpr size_t WS_WS = 13 * MiB;
constexpr size_t WS_WOUT = 14 * MiB;
constexpr size_t WS_LOGF = 16 * MiB;
constexpr size_t WS_CUM = 18 * MiB;
constexpr size_t WS_WEND = 20 * MiB;
constexpr size_t WS_E = 36 * MiB;
constexpr size_t WS_TZ = 52 * MiB;
constexpr size_t WS_U2 = 124 * MiB;
constexpr size_t WS_H = 196 * MiB;
constexpr size_t WS_YA = WS_H, WS_YS = WS_H + 64 * MiB;
constexpr size_t WS_Q = 324 * MiB, WS_K = 388 * MiB, WS_V = 452 * MiB, WS_GA = 516 * MiB, WS_GS = 580 * MiB;
constexpr size_t WS_MERGED = WS_Q;
constexpr size_t WS_MIXA = 644 * MiB, WS_MIXS = 772 * MiB;
constexpr size_t WS_PRE = WS_MIXA;
constexpr size_t WS_YS2 = 900 * MiB;
constexpr size_t WS_END = 964 * MiB;

constexpr int LDS_BYTES = 147456;

struct Params {
    const float *x, *norm_pre, *w_in, *b_forget, *lam_re, *lam_im, *log_dt, *b_re, *b_im, *c_re, *c_im, *d_skip, *w_glu, *b_glu, *w_a, *w_s, *w_out, *norm_post;
    float* out; unsigned char* ws; int ph_lo, ph_hi;
};

#define EPI_LOOP_BEGIN \
    _Pragma("unroll") for (int ai = 0; ai < 2; ++ai) _Pragma("unroll") for (int m = 0; m < 4; ++m) { const int row = u.pm * 256 + ai * 128 + wr * 64 + m * 16 + fr; \
    _Pragma("unroll") for (int bj = 0; bj < 2; ++bj) { const int ct = bj * 128 + wc * 32 + 8 * fq; f32x4 v0 = acc[ai][bj][m][0], v1 = acc[ai][bj][m][1];
#define EPI_LOOP_END } }
__device__ __forceinline__ u32x4 pack8(f32x4 a, f32x4 b) { u32x4 w; w.x = cvt_pk_bf16(a[0], a[1]); w.y = cvt_pk_bf16(a[2], a[3]); w.z = cvt_pk_bf16(b[0], b[1]); w.w = cvt_pk_bf16(b[2], b[3]); return w; }
__device__ __forceinline__ void unpack8(u32x4 w, f32x4& a, f32x4& b) { a = (f32x4){bf_lo(w.x), bf_hi(w.x), bf_lo(w.y), bf_hi(w.y)}; b = (f32x4){bf_lo(w.z), bf_hi(w.z), bf_lo(w.w), bf_hi(w.w)}; }

struct EpiProj {
    static constexpr bool HAS_MID = false;
    unsigned char* ws;
    __device__ __forceinline__ void operator()(const f32x4 (&acc)[2][2][4][2], const Unit& u, int wr, int wc, int fr, int fq) const {
        const int pn = u.pn;
        int act = 0, pitch = 512, cb = (pn & 1) * 256; size_t off; float sc = 1.f;
        if (pn < 2) { off = WS_Q; sc = C2; } else if (pn < 4) off = WS_K; else if (pn < 6) off = WS_V; else if (pn < 8) { off = WS_GA; act = 1; }
        else if (pn < 10) { off = WS_U2; act = 3; } else if (pn < 12) { off = WS_GS; act = 1; }
        else {
            bf16_t* RA = (bf16_t*)(ws + WS_MIXA); bf16_t* SS = (bf16_t*)(ws + WS_MIXS);
#pragma unroll
            for (int ai = 0; ai < 2; ++ai)
#pragma unroll
                for (int m = 0; m < 4; ++m) { const int row = u.pm * 256 + ai * 128 + wr * 64 + m * 16 + fr; const size_t o = (size_t)row * DM + (pn - 12) * 128 + wc * 32 + 8 * fq;
                    f32x4 r0, r1, s0, s1;
#pragma unroll
                    for (int e = 0; e < 4; ++e) {
                        const float ea0 = __expf(-fmaxf(acc[ai][0][m][0][e], -30.f)), ea1 = __expf(-fmaxf(acc[ai][0][m][1][e], -30.f));
                        const float es0 = __expf(-fmaxf(acc[ai][1][m][0][e], -30.f)), es1 = __expf(-fmaxf(acc[ai][1][m][1][e], -30.f));
                        r0[e] = (1.f + es0) * __builtin_amdgcn_rcpf(1.f + ea0); r1[e] = (1.f + es1) * __builtin_amdgcn_rcpf(1.f + ea1);
                        s0[e] = __builtin_amdgcn_rcpf(1.f + es0); s1[e] = __builtin_amdgcn_rcpf(1.f + es1); }
                    *(u32x4*)(RA + o) = pack8(r0, r1); *(u32x4*)(SS + o) = pack8(s0, s1); }
            return;
        }
        bf16_t* base = (bf16_t*)(ws + off);
        float mx0 = 0.f, mx1 = 0.f;
        EPI_LOOP_BEGIN
            v0 = v0 * sc; v1 = v1 * sc;
            if (act == 1) {
#pragma unroll
                for (int e = 0; e < 4; ++e) { v0[e] = v0[e] * sigm(v0[e]); v1[e] = v1[e] * sigm(v1[e]); }
            } else if (act == 2) {
#pragma unroll
                for (int e = 0; e < 4; ++e) { v0[e] = sigm(fmaxf(v0[e], -30.f)); v1[e] = sigm(fmaxf(v1[e], -30.f)); }
            }
            const u32x4 w = pack8(v0, v1);
            if (act == 3) { const int cu = cb + ct, gg = cu >> 4, c0 = cu & 15; *(u32x4*)(base + ((size_t)(gg * NCHK + (row >> 6)) * KX + 128 + (row & 63) * 16 + c0)) = w; }
            else *(u32x4*)(base + (size_t)row * pitch + cb + ct) = w;
            if (pn < 4) {
                float s = (v0[0] * v0[0] + v0[1] * v0[1]) + (v0[2] * v0[2] + v0[3] * v0[3]) + (v1[0] * v1[0] + v1[1] * v1[1]) + (v1[2] * v1[2] + v1[3] * v1[3]);
                s += __shfl_xor(s, 16); s += __shfl_xor(s, 32);
                if (bj == 0) mx0 = fmaxf(mx0, s); else mx1 = fmaxf(mx1, s);
            }
        EPI_LOOP_END
        if (pn < 4) {
#pragma unroll
            for (int o = 1; o < 16; o <<= 1) { mx0 = fmaxf(mx0, __shfl_xor(mx0, o)); mx1 = fmaxf(mx1, __shfl_xor(mx1, o)); }
            if ((threadIdx.x & 63) == 0) {
                unsigned* nrm = (unsigned*)(ws + WS_NRM); const int b = u.pm >> 5, which = (pn >> 1) * 2 + (wc & 1);
                const int h0 = (pn & 1) * 4 + (wc >> 1), h1 = h0 + 2;
                atomicMax(nrm + (b * 8 + h0) * 4 + which, __float_as_uint(mx0 * 1.02f));
                atomicMax(nrm + (b * 8 + h1) * 4 + which, __float_as_uint(mx1 * 1.02f));
            }
        }
    }
};
struct EpiSsmE {
    static constexpr bool HAS_MID = false;
    float* E;
    __device__ __forceinline__ void operator()(const f32x4 (&acc)[2][2][4][2], const Unit& u, int wr, int wc, int fr, int fq) const {
        EPI_LOOP_BEGIN
            if (bj == 0) { float* p = E + ((size_t)(u.z * NCHK + row) * 128 + ct); *(f32x4*)p = v0; *(f32x4*)(p + 4) = v1; }
        EPI_LOOP_END
    }
};
__device__ __forceinline__ float gelu_t(float x) { const float y = 0.7978845608028654f * (x + 0.044715f * x * x * x); return x * sigm(2.0f * y); }
struct EpiSsmY {
    static constexpr bool HAS_MID = false;
    bf16_t* YS;
    __device__ __forceinline__ void operator()(const f32x4 (&acc)[2][2][4][2], const Unit& u, int wr, int wc, int fr, int fq) const {
        EPI_LOOP_BEGIN
#pragma unroll
            for (int e = 0; e < 4; ++e) { v0[e] = gelu_t(v0[e]); v1[e] = gelu_t(v1[e]); }
            const int j = u.pn * 256 + ct, t = j >> 4, c0 = j & 15;
            *(u32x4*)(YS + (((size_t)u.z * MTOK + row * CH + t) * 16 + c0)) = pack8(v0, v1);
        EPI_LOOP_END
    }
};
struct EpiGlu {
    static constexpr bool HAS_MID = false;
    const bf16_t* YS; const bf16_t* GS; const float* bias; bf16_t* O;
    __device__ __forceinline__ void operator()(const f32x4 (&acc)[2][2][4][2], const Unit& u, int wr, int wc, int fr, int fq) const {
        EPI_LOOP_BEGIN
            const int col = u.pn * 256 + ct; const size_t o = (size_t)row * SW + col;
            const f32x4 b0 = *(const f32x4*)(bias + col), b1 = *(const f32x4*)(bias + col + 4);
            f32x4 y0, y1, g0, g1; unpack8(*(const u32x4*)(YS + (((size_t)(col >> 4) * MTOK + row) * 16 + (col & 15))), y0, y1); unpack8(*(const u32x4*)(GS + o), g0, g1);
#pragma unroll
            for (int e = 0; e < 4; ++e) { v0[e] = y0[e] * sigm(v0[e] + b0[e]) * g0[e]; v1[e] = y1[e] * sigm(v1[e] + b1[e]) * g1[e]; }
            *(u32x4*)(O + o) = pack8(v0, v1);
        EPI_LOOP_END
    }
};
struct EpiMerge {
    static constexpr bool HAS_MID = true;
    const bf16_t* MA; const bf16_t* MS; bf16_t* O;
    __device__ __forceinline__ void mid(f32x4 (&acc)[2][2][4][2], const Unit& u, int wr, int wc, int fr, int fq) const {
        __builtin_amdgcn_sched_barrier(0);
        unsigned o0 = (unsigned)((u.pm * 256 + wr * 64 + fr) * DM + u.pn * 256 + wc * 32 + 8 * fq);
        asm volatile("" : "+v"(o0));
#pragma unroll
        for (int ai = 0; ai < 2; ++ai) { u32x4 rr[2][4];
#pragma unroll
            for (int bj = 0; bj < 2; ++bj)
#pragma unroll
                for (int m = 0; m < 4; ++m) rr[bj][m] = *(const u32x4*)(MA + (o0 + (unsigned)((ai * 128 + m * 16) * DM + bj * 128)));
#pragma unroll
            for (int bj = 0; bj < 2; ++bj)
#pragma unroll
                for (int m = 0; m < 4; ++m) { f32x4 a0, a1; unpack8(rr[bj][m], a0, a1); acc[ai][bj][m][0] *= a0; acc[ai][bj][m][1] *= a1; }
            __builtin_amdgcn_sched_barrier(0); }
    }
    __device__ __forceinline__ void operator()(const f32x4 (&acc)[2][2][4][2], const Unit& u, int wr, int wc, int fr, int fq) const {
        unsigned o0 = (unsigned)((u.pm * 256 + wr * 64 + fr) * DM + u.pn * 256 + wc * 32 + 8 * fq);
#pragma unroll
        for (int ai = 0; ai < 2; ++ai) { u32x4 gg[2][4];
#pragma unroll
            for (int bj = 0; bj < 2; ++bj)
#pragma unroll
                for (int m = 0; m < 4; ++m) gg[bj][m] = *(const u32x4*)(MS + (o0 + (unsigned)((ai * 128 + m * 16) * DM + bj * 128)));
#pragma unroll
            for (int bj = 0; bj < 2; ++bj)
#pragma unroll
                for (int m = 0; m < 4; ++m) { f32x4 s0, s1; unpack8(gg[bj][m], s0, s1);
                    *(u32x4*)(O + (o0 + (unsigned)((ai * 128 + m * 16) * DM + bj * 128))) = pack8(acc[ai][bj][m][0] * s0, acc[ai][bj][m][1] * s1); }
            __builtin_amdgcn_sched_barrier(0); }
    }
};
struct EpiOut {
    static constexpr bool HAS_MID = false;
    bf16_t* pre; float* sumsq;
    __device__ __forceinline__ void operator()(const f32x4 (&acc)[2][2][4][2], const Unit& u, int wr, int wc, int fr, int fq) const {
#pragma unroll
        for (int ai = 0; ai < 2; ++ai)
#pragma unroll
            for (int m = 0; m < 4; ++m) { const int row = u.pm * 256 + ai * 128 + wr * 64 + m * 16 + fr; float s = 0.f;
#pragma unroll
                for (int bj = 0; bj < 2; ++bj) { const f32x4 v0 = acc[ai][bj][m][0], v1 = acc[ai][bj][m][1];
                    *(u32x4*)(pre + (size_t)row * DM + u.pn * 256 + bj * 128 + wc * 32 + 8 * fq) = pack8(v0, v1);
                    s += (v0[0] * v0[0] + v0[1] * v0[1]) + (v0[2] * v0[2] + v0[3] * v0[3]) + (v1[0] * v1[0] + v1[1] * v1[1]) + (v1[2] * v1[2] + v1[3] * v1[3]); }
                s += __shfl_xor(s, 16); s += __shfl_xor(s, 32);
                if (fq == 0) atomicAdd(sumsq + row, s); }
    }
};

namespace att {
typedef short bf16x8 __attribute__((ext_vector_type(8)));
typedef short s16x4 __attribute__((ext_vector_type(4)));
typedef float f32x16 __attribute__((ext_vector_type(16)));
constexpr int SLOTB = 8192;
constexpr int L_K = 0, L_V = 2 * SLOTB, L_B = 5 * SLOTB, L_WS = L_B + 512,
                         L_CNT = L_WS + 2048, L_OST = L_CNT + 128;
static_assert(L_OST + 8 * 8192 <= 131072, "attention LDS");
__device__ __forceinline__ int crow(int r, int hi) { return (r & 3) + 8 * (r >> 2) + 4 * hi; }
typedef float f32x2_t __attribute__((ext_vector_type(2))); typedef __bf16 bf16x2_t __attribute__((ext_vector_type(2)));
__device__ __forceinline__ unsigned cvtpk_s(float lo, float hi) { f32x2_t v = {lo, hi}; bf16x2_t b = __builtin_convertvector(v, bf16x2_t); return __builtin_bit_cast(unsigned, b); }
__device__ __forceinline__ float rowmax(const f32x16& p0, const f32x16& p1) {
    float a = fmaxf(p0[0], p1[0]);
#pragma unroll
    for (int r = 1; r < 16; ++r) a = fmaxf(a, fmaxf(p0[r], p1[r]));
    auto rr = __builtin_amdgcn_permlane32_swap(__float_as_uint(a), __float_as_uint(a), false, false);
    return fmaxf(__uint_as_float(rr[0]), __uint_as_float(rr[1]));
}
__device__ __forceinline__ void pv(f32x16* o, int vb, bf16x8 pa0, bf16x8 pa1, bf16x8 pa2, bf16x8 pa3) {
#pragma unroll
    for (int d0 = 0; d0 < 2; ++d0) { s16x4 lo[4], hi[4];
#pragma unroll
        for (int ks = 0; ks < 4; ++ks) {
            asm volatile("ds_read_b64_tr_b16 %0,%1 offset:%c2" : "=&v"(lo[ks]) : "v"(vb), "i"(d0 * 4096 + ks * 1024) : "memory");
            asm volatile("ds_read_b64_tr_b16 %0,%1 offset:%c2" : "=&v"(hi[ks]) : "v"(vb), "i"(d0 * 4096 + ks * 1024 + 512) : "memory"); }
        asm volatile("s_waitcnt lgkmcnt(0)" ::: "memory"); __builtin_amdgcn_sched_barrier(0);
#define PK(k) (bf16x8){lo[k][0], lo[k][1], lo[k][2], lo[k][3], hi[k][0], hi[k][1], hi[k][2], hi[k][3]}
        o[d0] = __builtin_amdgcn_mfma_f32_32x32x16_bf16(pa0, PK(0), o[d0], 0, 0, 0);
        o[d0] = __builtin_amdgcn_mfma_f32_32x32x16_bf16(pa1, PK(1), o[d0], 0, 0, 0);
        o[d0] = __builtin_amdgcn_mfma_f32_32x32x16_bf16(pa2, PK(2), o[d0], 0, 0, 0);
        o[d0] = __builtin_amdgcn_mfma_f32_32x32x16_bf16(pa3, PK(3), o[d0], 0, 0, 0);
#undef PK
    }
}
__device__ __forceinline__ void attn_unit(int b, int h, int qb, unsigned char* ws, LAS unsigned char* shm) {
    const int tid = threadIdx.x, lane = tid & 63, r32 = lane & 31, hi = lane >> 5; const int wid = __builtin_amdgcn_readfirstlane(tid >> 6);
    const long rowbase = (long)b * SEQ; const int q0 = qb * 256;
    const bf16_t* Qw = (const bf16_t*)(ws + WS_Q) + (rowbase + q0 + wid * 32) * AW + h * HD;
    const bf16_t* Kh = (const bf16_t*)(ws + WS_K) + rowbase * AW + h * HD; const bf16_t* Vh = (const bf16_t*)(ws + WS_V) + rowbase * AW + h * HD;
    const float* cum = (const float*)(ws + WS_CUM) + (size_t)(b * NH + h) * SEQ;
    const unsigned lds0 = (unsigned)(uintptr_t)shm;
    LAS float* wsf = (LAS float*)(shm + L_WS) + wid * 64;
    LAS int* cnt = (LAS int*)(shm + L_CNT);
    const float cref = cum[q0];
    const unsigned* nr = (const unsigned*)(ws + WS_NRM) + (b * NH + h) * 4;
    const float qn2 = __uint_as_float(nr[0]) + __uint_as_float(nr[1]), kn2 = __uint_as_float(nr[2]) + __uint_as_float(nr[3]);
    const float X = SKIP_LOG2 + 2.0f * (sqrtf(qn2 * kn2) * 1.01f + 0.01f);
    const float Sb = sqrtf(qn2 * kn2) * 1.01f + 0.01f;
    float bend = 0.f; if (tid < 4 * qb) bend = cref - cum[64 * tid + 63];
    int pred = (tid < 4 * qb && bend < -X) ? 1 : 0;
    { const unsigned long long bal = __ballot(pred); if (lane == 0) cnt[wid] = __popcll(bal); }
    __syncthreads();
    int tile_lo = 0;
#pragma unroll
    for (int w = 0; w < 8; ++w) tile_lo += cnt[w];
    const int NT = 4 * qb + 4;
    bf16x8 qr[4];
#pragma unroll
    for (int d0 = 0; d0 < 4; ++d0) qr[d0] = *(const bf16x8*)(Qw + (long)r32 * AW + d0 * 16 + hi * 8);
    const bf16_t* ksrc = Kh + (long)lane * AW + wid * 8;
    const bf16_t* vsrc = Vh + (long)(16 * (wid & 3) + (lane >> 2)) * AW + (wid >> 2) * 32 + (lane & 3) * 8;
    const int koff = wid * 1024 + lane * 16;
    const int vb0 = (int)(lds0 + L_V) + ((lane >> 4) & 1) * 32 + (lane & 3) * 8 + (4 * hi + ((lane & 15) >> 2)) * 64;
    int t = NT - 1;
    u32x4 kA = *(const u32x4*)(ksrc + (long)t * 64 * AW), vA = *(const u32x4*)(vsrc + (long)t * 64 * AW);
    float bA = (tid < 64) ? (cref - cum[64 * t + tid]) : 0.f;
    u32x4 kB = kA, vB = vA; float bB = 0.f;
    if (t - 1 >= tile_lo) { kB = *(const u32x4*)(ksrc + (long)(t - 1) * 64 * AW); vB = *(const u32x4*)(vsrc + (long)(t - 1) * 64 * AW); bB = (tid < 64) ? (cref - cum[64 * (t - 1) + tid]) : 0.f; }
    float mhat = -1e30f, l_reg = 0.f; f32x16 o[2]; o[0] = f32x16{}; o[1] = f32x16{};
    const int qrel = wid * 32 + r32;
    int cur = 0, vcur = 0, vprev = 2;
    u32x4 pw0 = (u32x4){0u, 0u, 0u, 0u}, pw1 = pw0, pw2 = pw0, pw3 = pw0;
#define ATT_STEP(KR, VR, BR) do { \
        *(LAS u32x4*)(shm + L_K + cur * SLOTB + koff) = KR; *(LAS u32x4*)(shm + L_V + vcur * SLOTB + koff) = VR; \
        if (tid < 64) *(LAS float*)(shm + L_B + cur * 256 + tid * 4) = BR; \
        asm volatile("s_waitcnt lgkmcnt(0)\n\ts_barrier" ::: "memory");     \
        if (t - 2 >= tile_lo) { KR = *(const u32x4*)(ksrc + (long)(t - 2) * 64 * AW); VR = *(const u32x4*)(vsrc + (long)(t - 2) * 64 * AW); BR = (tid < 64) ? (cref - cum[64 * (t - 2) + tid]) : 0.f; } \
        att_tile(); \
    } while (0)
    auto att_tile = [&]() __attribute__((always_inline)) {
        const int jb = t - (NT - 4);
        if (jb <= (wid >> 1)) {
            f32x16 p0, p1;
            { const LAS float* bb = (const LAS float*)(shm + L_B + cur * 256);
#pragma unroll
              for (int g4 = 0; g4 < 4; ++g4) { const f32x4 a = *(const LAS f32x4*)(bb + 8 * g4 + 4 * hi), c = *(const LAS f32x4*)(bb + 32 + 8 * g4 + 4 * hi);
#pragma unroll
                  for (int e = 0; e < 4; ++e) { p0[4 * g4 + e] = a[e]; p1[4 * g4 + e] = c[e]; } } }
            { const LAS unsigned char* kb = shm + L_K + cur * SLOTB + hi * 1024 + r32 * 16;
              __builtin_amdgcn_s_setprio(1);
#pragma unroll
              for (int d0 = 0; d0 < 4; ++d0) { const bf16x8 b0 = *(const LAS bf16x8*)(kb + d0 * 2048), b1 = *(const LAS bf16x8*)(kb + d0 * 2048 + 512);
                  p0 = __builtin_amdgcn_mfma_f32_32x32x16_bf16(b0, qr[d0], p0, 0, 0, 0); p1 = __builtin_amdgcn_mfma_f32_32x32x16_bf16(b1, qr[d0], p1, 0, 0, 0); } }
            pv(o, vb0 + vprev * SLOTB, __builtin_bit_cast(bf16x8, pw0), __builtin_bit_cast(bf16x8, pw1), __builtin_bit_cast(bf16x8, pw2), __builtin_bit_cast(bf16x8, pw3));
            __builtin_amdgcn_s_setprio(0);
            if (jb >= 0) { const int kb0 = 64 * jb + 4 * hi;
#pragma unroll
                for (int r = 0; r < 16; ++r) { const int kv = kb0 + (r & 3) + 8 * (r >> 2); if (kv > qrel) p0[r] = -INFINITY; if (kv + 32 > qrel) p1[r] = -INFINITY; } }
            const float rm = rowmax(p0, p1);
            const float mnew = fmaxf(mhat, rm);
            if (__any(mnew > mhat)) {
                const float alpha = __builtin_amdgcn_exp2f(mhat - mnew); l_reg *= alpha; mhat = mnew;
                if (hi == 0) wsf[r32] = alpha;
                asm volatile("s_waitcnt lgkmcnt(0)" ::: "memory");
#pragma unroll
                for (int r = 0; r < 16; ++r) { const float f = wsf[crow(r, hi)]; o[0][r] *= f; o[1][r] *= f; }
            }
            float sacc = 0.f;
#pragma unroll
            for (int r = 0; r < 16; ++r) { p0[r] = __builtin_amdgcn_exp2f(p0[r] - mhat); p1[r] = __builtin_amdgcn_exp2f(p1[r] - mhat); sacc += p0[r] + p1[r]; }
            l_reg += sacc;
            pw0 = (u32x4){cvtpk_s(p0[0], p0[1]), cvtpk_s(p0[2], p0[3]), cvtpk_s(p0[4], p0[5]), cvtpk_s(p0[6], p0[7])};
            pw1 = (u32x4){cvtpk_s(p0[8], p0[9]), cvtpk_s(p0[10], p0[11]), cvtpk_s(p0[12], p0[13]), cvtpk_s(p0[14], p0[15])};
            pw2 = (u32x4){cvtpk_s(p1[0], p1[1]), cvtpk_s(p1[2], p1[3]), cvtpk_s(p1[4], p1[5]), cvtpk_s(p1[6], p1[7])};
            pw3 = (u32x4){cvtpk_s(p1[8], p1[9]), cvtpk_s(p1[10], p1[11]), cvtpk_s(p1[12], p1[13]), cvtpk_s(p1[14], p1[15])};
        }
        cur ^= 1; vprev = vcur; vcur = (vcur == 2) ? 0 : vcur + 1;
        if (jb == 0 && tile_lo < NT - 4) {
            float mm = mhat;
#pragma unroll
            for (int o2 = 1; o2 < 64; o2 <<= 1) mm = fminf(mm, __shfl_xor(mm, o2));
            LAS float* mw = (LAS float*)(shm + L_CNT) + 8;
            if (lane == 0) mw[wid] = mm;
            __syncthreads();
            float mmin = mw[0];
#pragma unroll
            for (int w = 1; w < 8; ++w) mmin = fminf(mmin, mw[w]);
            const float X2 = SKIP_LOG2 + Sb - mmin;
            const int pred2 = (tid < 4 * qb && bend < -X2) ? 1 : 0;
            { const unsigned long long bal = __ballot(pred2); if (lane == 0) cnt[wid] = __popcll(bal); }
            __syncthreads();
            int tl2 = 0;
#pragma unroll
            for (int w = 0; w < 8; ++w) tl2 += cnt[w];
            tile_lo = tl2 > tile_lo ? tl2 : tile_lo;
        }
    };
    for (;;) {
        ATT_STEP(kA, vA, bA); --t; if (t < tile_lo) break;
        ATT_STEP(kB, vB, bB); --t; if (t < tile_lo) break;
    }
#undef ATT_STEP
    pv(o, vb0 + vprev * SLOTB, __builtin_bit_cast(bf16x8, pw0), __builtin_bit_cast(bf16x8, pw1), __builtin_bit_cast(bf16x8, pw2), __builtin_bit_cast(bf16x8, pw3));
    { auto rr = __builtin_amdgcn_permlane32_swap(__float_as_uint(l_reg), __float_as_uint(l_reg), false, false); l_reg = __uint_as_float(rr[0]) + __uint_as_float(rr[1]); }
    if (hi == 0) wsf[32 + r32] = l_reg;
    asm volatile("s_waitcnt lgkmcnt(0)" ::: "memory");
    LAS float* stg = (LAS float*)(shm + L_OST) + wid * 2048;
#pragma unroll
    for (int r = 0; r < 16; ++r) { const int orow = crow(r, hi); const float rl = __builtin_amdgcn_rcpf(wsf[32 + orow]);
        stg[orow * 64 + r32] = o[0][r] * rl; stg[orow * 64 + 32 + r32] = o[1][r] * rl; }
    asm volatile("s_waitcnt lgkmcnt(0)" ::: "memory");
    const bf16_t* GAw = (const bf16_t*)(ws + WS_GA) + (rowbase + q0 + wid * 32) * AW + h * HD;
    bf16_t* Ow = (bf16_t*)(ws + WS_YA) + (rowbase + q0 + wid * 32) * AW + h * HD;
#pragma unroll
    for (int i = 0; i < 4; ++i) { const int row = i * 8 + (lane >> 3), ch = lane & 7;
        f32x4 a = *(const LAS f32x4*)(stg + row * 64 + ch * 8), c = *(const LAS f32x4*)(stg + row * 64 + ch * 8 + 4);
        f32x4 g0, g1; unpack8(*(const u32x4*)(GAw + (long)row * AW + ch * 8), g0, g1);
        *(u32x4*)(Ow + (long)row * AW + ch * 8) = pack8(a * g0, c * g1); }
    __syncthreads();
}
}

__device__ __forceinline__ unsigned f2bf(float f) { unsigned u = __builtin_bit_cast(unsigned, f); return (u + 0x7fffu + ((u >> 16) & 1u)) >> 16; }
__device__ __forceinline__ unsigned pk2(float lo, float hi) { return f2bf(lo) | (f2bf(hi) << 16); }
__device__ __forceinline__ float wave_sum(float v) {
#pragma unroll
    for (int o = 1; o < 64; o <<= 1) v += __shfl_xor(v, o);
    return v;
}
__device__ __forceinline__ void transpose_item(const float* W, int K, int ldw, int N, int col_shift_from, bf16_t* WT, LAS float* scr, int item, int lane) {
    const int nblk = N / 32, kb = item / nblk, nb = item % nblk, k0 = 64 * kb, n0 = 32 * nb;
    int sc0 = n0;
    if (col_shift_from >= 0) { if (n0 >= 3072) { const int T = (n0 - 3072) >> 8, j = (n0 - 3072) & 255; sc0 = (j < 128) ? 3080 + T * 128 + j : 4104 + T * 128 + (j - 128); } else if (n0 >= 1536) sc0 = n0 + 8; }
#pragma unroll 8
    for (int i = 0; i < 32; ++i) { const int kk = 2 * i + (lane >> 5); scr[kk * 33 + (lane & 31)] = W[(size_t)(k0 + kk) * ldw + sc0 + (lane & 31)]; }
    asm volatile("s_waitcnt lgkmcnt(0)" ::: "memory");
    const int c = lane & 7;
#pragma unroll
    for (int j = 0; j < 4; ++j) { const int n = (lane >> 3) + 8 * j; const LAS float* s = scr + (8 * c) * 33 + n;
        u32x4 o; o.x = pk2(s[0 * 33], s[1 * 33]); o.y = pk2(s[2 * 33], s[3 * 33]); o.z = pk2(s[4 * 33], s[5 * 33]); o.w = pk2(s[6 * 33], s[7 * 33]);
        *(u32x4*)(WT + (size_t)(n0 + n) * K + k0 + 8 * c) = o; }
    asm volatile("s_waitcnt lgkmcnt(0)" ::: "memory");
}
__device__ __forceinline__ void sincos_d(double x, double& s, double& c) {
    const double k = rint(x * 0.63661977236758134308);
    const double r = (x - k * 1.57079632679489655800) - k * 6.123233995736766035869e-17;
    const double r2 = r * r;
    const double sp = r * (1.0 + r2 * (-1.0 / 6 + r2 * (1.0 / 120 + r2 * (-1.0 / 5040 + r2 * (1.0 / 362880 + r2 * (-1.0 / 39916800 + r2 * (1.0 / 6227020800.0)))))));
    const double cp = 1.0 + r2 * (-0.5 + r2 * (1.0 / 24 + r2 * (-1.0 / 720 + r2 * (1.0 / 40320 + r2 * (-1.0 / 3628800 + r2 * (1.0 / 479001600.0 + r2 * (-1.0 / 87178291200.0)))))));
    const int q = ((int)k) & 3;
    s = (q == 0) ? sp : (q == 1) ? cp : (q == 2) ? -sp : -cp;
    c = (q == 0) ? cp : (q == 1) ? -sp : (q == 2) ? -cp : sp;
}
__device__ __forceinline__ double exp_d(double x) {
    const double n = rint(x * 1.44269504088896340736);
    const double r = (x - n * 0.693147180369123816490) - n * 1.90821492927058770002e-10;
    double p = 1.0 / 6227020800.0;
    p = p * r + 1.0 / 479001600.0; p = p * r + 1.0 / 39916800.0; p = p * r + 1.0 / 3628800.0; p = p * r + 1.0 / 362880.0; p = p * r + 1.0 / 40320.0;
    p = p * r + 1.0 / 5040.0; p = p * r + 1.0 / 720.0; p = p * r + 1.0 / 120.0; p = p * r + 1.0 / 24.0; p = p * r + 1.0 / 6.0; p = p * r + 0.5; p = p * r + 1.0; p = p * r + 1.0;
    const long long bits = ((long long)((int)n + 1023)) << 52;
    return p * __builtin_bit_cast(double, bits);
}

__device__ __forceinline__ void ssm_ops_item(const Params& p, int g, int c, LAS unsigned char* lds) {
    typedef float f32x2 __attribute__((ext_vector_type(2)));
    LAS f32x2* P = (LAS f32x2*)lds;
    LAS f32x2* Bb = (LAS f32x2*)(lds + 33280);
    LAS f32x2* Cc = (LAS f32x2*)(lds + 41472);
    LAS float* Km = (LAS float*)(lds + 41984);
    const int tid = threadIdx.x;
    if (tid < 64) {
        const int pp = tid;
        const double dt = exp_d((double)p.log_dt[g]); const double lr = (double)p.lam_re[g * 64 + pp], li = (double)p.lam_im[g * 64 + pp];
        const double mag = exp_d(lr * dt); double sn, cs; sincos_d(li * dt, sn, cs);
        const double abr = mag * cs, abi = mag * sn, den = lr * lr + li * li, nre = abr - 1.0;
        const double fre = (nre * lr + abi * li) / den, fim = (abi * lr - nre * li) / den;
        double pr = 1.0, pi = 0.0;
        for (int j = 0; j <= 64; ++j) { P[j * 64 + pp] = (f32x2){(float)pr, (float)pi}; const double nr = pr * abr - pi * abi, ni = pr * abi + pi * abr; pr = nr; pi = ni; }
        if (c == 0) ((f32x2*)(p.ws + WS_LAM64))[g * 64 + pp] = P[64 * 64 + pp];
        for (int q = 0; q < 16; ++q) { const double br = (double)p.b_re[(g * 64 + pp) * 16 + q], bi = (double)p.b_im[(g * 64 + pp) * 16 + q];
            Bb[pp * 16 + q] = (f32x2){(float)(fre * br - fim * bi), (float)(fre * bi + fim * br)}; }
        Cc[pp] = (f32x2){p.c_re[(g * 16 + c) * 64 + pp], p.c_im[(g * 16 + c) * 64 + pp]};
    }
    __syncthreads();
    {
        const int j = tid >> 3, q0 = (tid & 7) * 2;
        float k0 = 0.f, k1 = 0.f;
        for (int pp = 0; pp < 64; ++pp) {
            const f32x2 cc = Cc[pp], gg = P[j * 64 + pp], b0 = Bb[pp * 16 + q0], b1 = Bb[pp * 16 + q0 + 1];
            const float clr = cc.x * gg.x - cc.y * gg.y, cli = cc.x * gg.y + cc.y * gg.x;
            k0 += clr * b0.x - cli * b0.y; k1 += clr * b1.x - cli * b1.y;
        }
        if (j == 0) { const float d = p.d_skip[g * 16 + c]; if (q0 == c) k0 += d; if (q0 + 1 == c) k1 += d; }
        Km[j * 16 + q0] = k0; Km[j * 16 + q0 + 1] = k1;
    }
    __syncthreads();
    {
        bf16_t* TZ = (bf16_t*)(p.ws + WS_TZ) + (size_t)g * 1024 * KX;
        for (int idx = tid; idx < 64 * 144; idx += 512) {
            const int t = idx / 144, i = idx % 144, col = 8 * i;
            float v[8];
            if (col >= 128) { const int s = (col - 128) >> 4, chh = (col >> 3) & 1;
                if (s <= t) { const LAS float* k = Km + (t - s) * 16 + chh * 8;
#pragma unroll
                    for (int e = 0; e < 8; ++e) v[e] = k[e]; }
                else {
#pragma unroll
                    for (int e = 0; e < 8; ++e) v[e] = 0.f; }
            } else { const int p0 = col >> 1;
#pragma unroll
                for (int e = 0; e < 4; ++e) { const f32x2 cc = Cc[p0 + e], gg = P[(t + 1) * 64 + p0 + e]; v[2 * e] = cc.x * gg.x - cc.y * gg.y; v[2 * e + 1] = -(cc.x * gg.y + cc.y * gg.x); } }
            u32x4 w; w.x = pk2(v[0], v[1]); w.y = pk2(v[2], v[3]); w.z = pk2(v[4], v[5]); w.w = pk2(v[6], v[7]);
            *(u32x4*)(TZ + (size_t)(t * 16 + c) * KX + col) = w;
        }
        bf16_t* WE = (bf16_t*)(p.ws + WS_WEND) + (size_t)g * 256 * 1024;
        for (int idx = tid; idx < 16 * 128; idx += 512) {
            const int rl = idx >> 7, i = idx & 127, s = i >> 1, chh = i & 1;
            const int row = (rl < 8) ? (8 * c + rl) : (128 + 8 * c + (rl - 8));
            float v[8];
            if (rl < 8) { const int pp = row >> 1, ri = row & 1; const f32x2 gg = P[(63 - s) * 64 + pp];
#pragma unroll
                for (int e = 0; e < 8; ++e) { const f32x2 bb = Bb[pp * 16 + chh * 8 + e]; v[e] = ri ? (gg.x * bb.y + gg.y * bb.x) : (gg.x * bb.x - gg.y * bb.y); } }
            else {
#pragma unroll
                for (int e = 0; e < 8; ++e) v[e] = 0.f; }
            u32x4 w; w.x = pk2(v[0], v[1]); w.y = pk2(v[2], v[3]); w.z = pk2(v[4], v[5]); w.w = pk2(v[6], v[7]);
            *(u32x4*)(WE + (size_t)row * 1024 + 8 * i) = w;
        }
    }
    __syncthreads();
}

#define XB_TMO      128
#define XB_XCNT(j)  (256  + 64 * (j))
#define XB_XSUB(j)  (1280 + 64 * (j))
#define XB_XGEN(j)  (2304 + 64 * (j))
#define XB_TOP      3328
#define XB_TOPGEN   3392
#define XCD_BAR_WORDS 3456
#define XB_SPIN_CAP (1u << 18)
__device__ __forceinline__ unsigned xb_ld(unsigned* p)              { return __hip_atomic_load(p, __ATOMIC_RELAXED, __HIP_MEMORY_SCOPE_AGENT); }
__device__ __forceinline__ unsigned xb_add(unsigned* p, unsigned v) { return __hip_atomic_fetch_add(p, v, __ATOMIC_RELAXED, __HIP_MEMORY_SCOPE_AGENT); }
__device__ __forceinline__ unsigned xb_xcc_id() { return (unsigned)__builtin_amdgcn_s_getreg((3 << 11) | 20) & 0xFu; }
#define XB_SPIN(cond, bar) do { unsigned _sp = 0; while (cond) { __builtin_amdgcn_s_sleep(1); \
    if ((++_sp & 255u) == 0u) { if (xb_ld(&(bar)[XB_TMO])) break; if (_sp > XB_SPIN_CAP) { atomicAdd(&(bar)[XB_TMO], 1u); break; } } } } while (0)
struct XcdBarrier { unsigned* bar; unsigned x; volatile LAS unsigned* st; };
__device__ __forceinline__ XcdBarrier xcd_barrier_post(unsigned* bar, volatile LAS unsigned* st) {
    XcdBarrier b; b.bar = bar; b.x = xb_xcc_id(); b.st = st;
    if (threadIdx.x == 0) (void)xb_add(&bar[XB_XCNT(b.x)], 1u);
    return b;
}
__device__ __forceinline__ void xcd_barrier_complete(unsigned* bar, unsigned x, unsigned& nloc, unsigned& nx) {
    const unsigned G = gridDim.x * gridDim.y * gridDim.z;
    unsigned sum, cnt, mine, sp = 0u;
    for (;;) {
        sum = 0u; cnt = 0u; mine = 0u;
#pragma unroll
        for (unsigned j = 0; j < 16; ++j) { const unsigned c = xb_ld(&bar[XB_XCNT(j)]); sum += c; cnt += (c > 0u) ? 1u : 0u; mine = (j == x) ? c : mine; }
        if (sum == G) break;
        __builtin_amdgcn_s_sleep(1);
        if ((++sp & 255u) == 0u) { if (xb_ld(&bar[XB_TMO])) break; if (sp > XB_SPIN_CAP) { atomicAdd(&bar[XB_TMO], 1u); break; } }
    }
    nloc = mine > 0u ? mine : 1u; nx = cnt > 0u ? cnt : 1u;
}
__device__ __forceinline__ void xcd_barrier(const XcdBarrier& b) {
    asm volatile("s_waitcnt vmcnt(0)" ::: "memory");
    __syncthreads();
    if (threadIdx.x == 0) {
        unsigned* bar = b.bar;
        __builtin_amdgcn_s_waitcnt(0);
        unsigned nloc = b.st[0], nx = b.st[1];
        if (nloc == 0u) { xcd_barrier_complete(bar, b.x, nloc, nx); b.st[0] = nloc; b.st[1] = nx; }
        const unsigned old = xb_add(&bar[XB_XSUB(b.x)], 1u);
        const unsigned gen = old / nloc;
        if (old + 1u == (gen + 1u) * nloc) {
            __builtin_amdgcn_fence(__ATOMIC_RELEASE, "agent");
            asm volatile("s_waitcnt vmcnt(0)" ::: "memory");
            const unsigned og = xb_add(&bar[XB_TOP], 1u);
            const unsigned tg = og / nx;
            if (og + 1u == (tg + 1u) * nx) xb_add(&bar[XB_TOPGEN], 1u);
            else XB_SPIN(xb_ld(&bar[XB_TOPGEN]) == tg, bar);
            __builtin_amdgcn_fence(__ATOMIC_ACQUIRE, "agent");
            xb_add(&bar[XB_XGEN(b.x)], 1u);
            asm volatile("s_waitcnt vmcnt(0)" ::: "memory");
        } else {
            XB_SPIN(xb_ld(&bar[XB_XGEN(b.x)]) == gen, bar);
            __builtin_amdgcn_fence(__ATOMIC_ACQUIRE, "agent");
            asm volatile("s_waitcnt vmcnt(0)" ::: "memory");
        }
    }
    __syncthreads();
}

__global__ void __launch_bounds__(512) fwd_megakernel(Params p) {
    extern __shared__ __attribute__((aligned(16))) unsigned char lds_raw[];
    LAS unsigned char* lds = (LAS unsigned char*)lds_raw;
    cg::grid_group grid = cg::this_grid();
    const int tid = threadIdx.x, lane = tid & 63, wave = __builtin_amdgcn_readfirstlane(tid >> 6);
    const int G = gridDim.x, bx = blockIdx.x;
    unsigned char* ws = p.ws;
    const int lo = p.ph_lo, hi = p.ph_hi;
#define IN(k) (lo <= (k) && (k) < hi)
    volatile LAS unsigned* bst = (volatile LAS unsigned*)(lds + 131072 + 128);
    if (tid == 0) { bst[0] = 0u; bst[1] = 0u; }
    __syncthreads();
    XcdBarrier xbar; xbar.bar = (unsigned*)(ws + WS_BAR); xbar.x = 0; xbar.st = bst;
#define SEAM(k) do { if (IN(k) && IN((k) + 1)) { if ((k) == 0) { grid.sync(); xbar = xcd_barrier_post((unsigned*)(ws + WS_BAR), bst); } else xcd_barrier(xbar); } } while (0)

    if (IN(0)) {
        for (int i = bx * 512 + tid; i < MTOK; i += G * 512) ((float*)(ws + WS_SUMSQ))[i] = 0.f;
        if (bx == 0) for (int i = tid; i < 2048; i += 512) ((unsigned*)(ws + WS_NRM))[i] = 0u;
        if (bx == 1 || G == 1) for (int i = tid; i < 256 * 64; i += 512) ((unsigned*)(ws + WS_CNT))[i] = 0u;
        if (bx == 2 || G < 3) for (int i = tid; i < XCD_BAR_WORDS; i += 512) ((unsigned*)(ws + WS_BAR))[i] = 0u;
        const int gw = bx * 8 + wave, NGW = G * 8;
        auto partL = [&]() __attribute__((always_inline)) {
        for (int it = bx; it < NG * 16; it += G) ssm_ops_item(p, it >> 4, it & 15, lds);
        LAS float* scr = (LAS float*)(lds + wave * 8704);
        constexpr int I_IN = 16 * (NPROJ / 32), I_GLU = 8 * 16, I_A = 8 * 32, I_S = 8 * 32, I_O = 16 * 32, NIT = I_IN + I_GLU + I_A + I_S + I_O;
        for (int it = gw; it < NIT; it += NGW) {
            int r = it;
            if (r < I_IN) { transpose_item(p.w_in, DM, INC, NPROJ, 0, (bf16_t*)(ws + WS_WIN), scr, r, lane); continue; } r -= I_IN;
            if (r < I_GLU) { transpose_item(p.w_glu, SW, SW, SW, -1, (bf16_t*)(ws + WS_WGLU), scr, r, lane); continue; } r -= I_GLU;
            if (r < I_A) { transpose_item(p.w_a, AW, DM, DM, -1, (bf16_t*)(ws + WS_WA), scr, r, lane); continue; } r -= I_A;
            if (r < I_S) { transpose_item(p.w_s, SW, DM, DM, -1, (bf16_t*)(ws + WS_WS), scr, r, lane); continue; } r -= I_S;
            transpose_item(p.w_out, DM, DM, DM, -1, (bf16_t*)(ws + WS_WOUT), scr, r, lane);
        }
        };
        auto partR = [&]() __attribute__((always_inline)) {
        LAS float* wf = (LAS float*)(lds + 73728);
        for (int i = tid; i < 8192; i += 512) { const int k = i >> 3, j = i & 7; wf[j * 1024 + k] = p.w_in[(size_t)k * INC + 1536 + j]; }
        __syncthreads();
        f32x4 gn[4];
#pragma unroll
        for (int j = 0; j < 4; ++j) gn[j] = ((const f32x4*)p.norm_pre)[lane + 64 * j];
        f32x4 wreg[8][4];
#pragma unroll
        for (int e = 0; e < 8; ++e)
#pragma unroll
            for (int j = 0; j < 4; ++j) wreg[e][j] = *(const LAS f32x4*)(wf + e * 1024 + 4 * lane + 256 * j);
        const int fidx = ((lane & 1) << 2) | (lane & 2) | ((lane & 4) >> 2);
        const float bfg = p.b_forget[fidx];
        f32x4 vn[4];
        if (gw < MTOK) {
#pragma unroll
            for (int j = 0; j < 4; ++j) vn[j] = ((const f32x4*)(p.x + (size_t)gw * DM) + lane)[64 * j];
        }
        for (int m = gw; m < MTOK; m += NGW) {
            f32x4 v[4]; float s = 0.f;
#pragma unroll
            for (int j = 0; j < 4; ++j) v[j] = vn[j];
            if (m + NGW < MTOK) {
#pragma unroll
                for (int j = 0; j < 4; ++j) vn[j] = ((const f32x4*)(p.x + (size_t)(m + NGW) * DM) + lane)[64 * j];
            }
#pragma unroll
            for (int j = 0; j < 4; ++j) s += (v[j][0] * v[j][0] + v[j][1] * v[j][1]) + (v[j][2] * v[j][2] + v[j][3] * v[j][3]);
            const float rstd = 1.0f / sqrtf(wave_sum(s) * (1.f / DM) + 1e-6f);
            unsigned long long* o8 = (unsigned long long*)((bf16_t*)(ws + WS_H) + (size_t)m * DM) + lane;
            float fa[8];
#pragma unroll
            for (int e = 0; e < 8; ++e) fa[e] = 0.f;
#pragma unroll
            for (int j = 0; j < 4; ++j) { v[j] = v[j] * rstd * gn[j];
                o8[64 * j] = (unsigned long long)pk2(v[j][0], v[j][1]) | ((unsigned long long)pk2(v[j][2], v[j][3]) << 32);
#pragma unroll
                for (int e = 0; e < 8; ++e) { const f32x4 w = wreg[e][j]; fa[e] += (v[j][0] * w[0] + v[j][1] * w[1]) + (v[j][2] * w[2] + v[j][3] * w[3]); } }
#pragma unroll
            for (int e = 0; e < 4; ++e) { const float a = fa[e], c = fa[e + 4]; const bool up = lane & 1; fa[e] = (up ? c : a) + __shfl_xor(up ? a : c, 1); }
#pragma unroll
            for (int e = 0; e < 2; ++e) { const float a = fa[e], c = fa[e + 2]; const bool up = lane & 2; fa[e] = (up ? c : a) + __shfl_xor(up ? a : c, 2); }
            { const float a = fa[0], c = fa[1]; const bool up = lane & 4; fa[0] = (up ? c : a) + __shfl_xor(up ? a : c, 4); }
            float z = fa[0];
            z += __shfl_xor(z, 8); z += __shfl_xor(z, 16); z += __shfl_xor(z, 32);
            if (lane < 8) { z += bfg;
                const float ls = fminf(z, 0.f) - log1pf(expf(-fabsf(z)));
                ((float*)(ws + WS_LOGF))[(size_t)m * 8 + fidx] = ls; }
        }
        };
        if ((bx >> 3) & 1) { partR(); __syncthreads(); partL(); } else { partL(); __syncthreads(); partR(); }
        __syncthreads();
    }
    SEAM(0);

    if (IN(1)) {
        for (int bh = bx; bh < BATCH * NH; bh += G) {
            const int b = bh >> 3, h = bh & 7;
            const float* lf = (const float*)(ws + WS_LOGF) + (size_t)b * SEQ * 8 + h;
            float v[16]; float s = 0.f;
#pragma unroll
            for (int e = 0; e < 16; ++e) { s += lf[(size_t)(tid * 16 + e) * 8]; v[e] = s; }
            float incl = s;
#pragma unroll
            for (int o = 1; o < 64; o <<= 1) { const float n = __shfl_up(incl, o); if (lane >= o) incl += n; }
            LAS float* wt = (LAS float*)lds;
            if (lane == 63) wt[wave] = incl;
            __syncthreads();
            float base = incl - s;
            for (int w = 0; w < wave; ++w) base += wt[w];
            float* co = (float*)(ws + WS_CUM) + (size_t)bh * SEQ + tid * 16;
#pragma unroll
            for (int e = 0; e < 16; ++e) co[e] = (base + v[e]) * LOG2E;
            __syncthreads();
        }
        pg8::Gemm g{(const bf16_t*)(ws + WS_H), (const bf16_t*)(ws + WS_WIN), DM, DM, DM, 0, 0, nullptr, nullptr, 0, 16};
        pg8::TileOrder S{MTOK / 256, NPROJ / 256, 1, G, bx, 1};
        EpiProj E{ws};
        pg8::gemm_phase(lds, g, S, E);
    }
    SEAM(1);

    if (IN(2)) {
        {
            pg8::Gemm g{(const bf16_t*)(ws + WS_U2) + 128, (const bf16_t*)(ws + WS_WEND), 1024, KX, 1024, (long)NCHK * KX, 256L * 1024, nullptr, nullptr, 0, 16};
            pg8::TileOrder S{NCHK / 256, 1, NG, G, G - 1 - bx, 0};
            EpiSsmE E{(float*)(ws + WS_E)};
            pg8::gemm_phase(lds, g, S, E);
        }
        __syncthreads();
        {
            unsigned* uctr = (unsigned*)(ws + WS_NRM) + 1024;
            LAS int* nxt = (LAS int*)(lds + 131072 + 256);
            for (;;) {
                if (tid == 0) *nxt = (int)atomicAdd(uctr, 1u);
                __syncthreads();
                const int uidx = *nxt;
                __syncthreads();
                if (uidx >= BATCH * NH * 32) break;
                const int bh = uidx & 63, qb = 31 - (uidx >> 6);
                att::attn_unit(bh >> 3, bh & 7, qb, ws, lds);
            }
        }
    }
    SEAM(2);

    if (IN(3)) {
        typedef float f32x2 __attribute__((ext_vector_type(2)));
        LAS f32x2* ex = (LAS f32x2*)lds;
        for (int idx = bx; idx < BATCH * NG; idx += G) {
            const int b = idx >> 5, g = idx & 31, pp = lane;
            const f32x2 L = ((const f32x2*)(ws + WS_LAM64))[g * 64 + pp];
            f32x2 L16 = L;
#pragma unroll
            for (int q = 0; q < 4; ++q) L16 = (f32x2){L16.x * L16.x - L16.y * L16.y, 2.f * L16.x * L16.y};
            const float* Eb = (const float*)(ws + WS_E) + ((size_t)(g * NCHK + b * 128 + 16 * wave) * 128 + 2 * pp);
            bf16_t* Ub = (bf16_t*)(ws + WS_U2) + ((size_t)(g * NCHK + b * 128 + 16 * wave) * KX + 2 * pp);
            f32x2 e[16];
#pragma unroll
            for (int j = 0; j < 16; ++j) e[j] = *(const f32x2*)(Eb + (size_t)j * 128);
            float sr = 0.f, si = 0.f;
#pragma unroll
            for (int j = 0; j < 16; ++j) { const float nr = L.x * sr - L.y * si + e[j].x, ni = L.x * si + L.y * sr + e[j].y; sr = nr; si = ni; }
            ex[wave * 64 + pp] = (f32x2){sr, si};
            __syncthreads();
            sr = 0.f; si = 0.f;
            for (int w = 0; w < wave; ++w) { const f32x2 en = ex[w * 64 + pp]; const float nr = L16.x * sr - L16.y * si + en.x, ni = L16.x * si + L16.y * sr + en.y; sr = nr; si = ni; }
#pragma unroll
            for (int j = 0; j < 16; ++j) {
                *(unsigned*)(Ub + (size_t)j * KX) = pk2(sr, si);
                const float nr = L.x * sr - L.y * si + e[j].x, ni = L.x * si + L.y * sr + e[j].y; sr = nr; si = ni;
            }
            __syncthreads();
        }
    }
    SEAM(3);

    if (IN(4)) {
        pg8::Gemm g{(const bf16_t*)(ws + WS_U2), (const bf16_t*)(ws + WS_TZ), KX, KX, KX, (long)NCHK * KX, 1024L * KX, nullptr, nullptr, 0, 16};
        pg8::SsmYOrder S{G, bx};
        EpiSsmY E{(bf16_t*)(ws + WS_YS)};
        pg8::gemm_phase(lds, g, S, E);
    }
    SEAM(4);

    if (IN(5)) {
        pg8::Gemm g{(const bf16_t*)(ws + WS_YS), (const bf16_t*)(ws + WS_WGLU), SW, 16, SW, 0, 0, nullptr, nullptr, 0, (long)MTOK * 16};
        pg8::TileOrder S{MTOK / 256, SW / 256, 1, G, bx, 1};
        EpiGlu E{(const bf16_t*)(ws + WS_YS), (const bf16_t*)(ws + WS_GS), p.b_glu, (bf16_t*)(ws + WS_YS2)};
        pg8::gemm_phase(lds, g, S, E);
    }
    SEAM(5);

    if (IN(6)) {
        pg8::Gemm g{(const bf16_t*)(ws + WS_YA), (const bf16_t*)(ws + WS_WA), 1024, 512, 512, 0, 0, (const bf16_t*)(ws + WS_YS2), (const bf16_t*)(ws + WS_WS), 8, 16};
        pg8::TileOrder S{MTOK / 256, DM / 256, 1, G, bx, 1};
        EpiMerge E{(const bf16_t*)(ws + WS_MIXA), (const bf16_t*)(ws + WS_MIXS), (bf16_t*)(ws + WS_MERGED)};
        pg8::gemm_phase(lds, g, S, E);
    }
    SEAM(6);

    if (IN(7)) {
        pg8::Gemm g{(const bf16_t*)(ws + WS_MERGED), (const bf16_t*)(ws + WS_WOUT), DM, DM, DM, 0, 0, nullptr, nullptr, 0, 16};
        pg8::TileOrder S{MTOK / 256, DM / 256, 1, G, bx, 1};
        EpiOut E{(bf16_t*)(ws + WS_PRE), (float*)(ws + WS_SUMSQ)};
        pg8::gemm_phase(lds, g, S, E);
    }

    SEAM(7);

    if (IN(8)) {
        const int gw = bx * 8 + wave, NGW = G * 8;
        f32x4 gn[4];
#pragma unroll
        for (int j = 0; j < 4; ++j) gn[j] = ((const f32x4*)p.norm_post)[lane + 64 * j];
        for (int m = gw; m < MTOK; m += NGW) {
            const float rstd = 1.0f / sqrtf(((const float*)(ws + WS_SUMSQ))[m] * (1.f / DM) + 1e-6f);
            const f32x4* xr = (const f32x4*)(p.x + (size_t)m * DM) + lane; f32x4* orow = (f32x4*)(p.out + (size_t)m * DM) + lane;
            const unsigned long long* pr = (const unsigned long long*)((const bf16_t*)(ws + WS_PRE) + (size_t)m * DM) + lane;
            f32x4 xv[4]; unsigned long long pv8[4];
#pragma unroll
            for (int j = 0; j < 4; ++j) { xv[j] = xr[64 * j]; pv8[j] = pr[64 * j]; }
#pragma unroll
            for (int j = 0; j < 4; ++j) { const unsigned lo32 = (unsigned)pv8[j], hi32 = (unsigned)(pv8[j] >> 32);
                const f32x4 pf = (f32x4){bf_lo(lo32), bf_hi(lo32), bf_lo(hi32), bf_hi(hi32)};
                orow[64 * j] = xv[j] + pf * rstd * gn[j]; }
        }
    }
#undef IN
#undef SEAM
}

extern "C" void kernel_launch(void* const* d_in, const int* in_sizes, int n_in, void* d_out, int out_size, void* d_ws, size_t ws_size, hipStream_t stream) {
    static int grid = 0;
    if (grid == 0) {
        if (n_in != 18 || out_size != MTOK * DM || ws_size < WS_END) { fprintf(stderr, "kernel_launch: unexpected shapes (n_in %d, out %d, ws %zu)\n", n_in, out_size, ws_size); grid = -1; return; }
        int dev = 0, cus = 0, per_cu = 0;
        hipGetDevice(&dev); hipDeviceGetAttribute(&cus, hipDeviceAttributeMultiprocessorCount, dev);
        if (hipFuncSetAttribute((const void*)fwd_megakernel, hipFuncAttributeMaxDynamicSharedMemorySize, LDS_BYTES) != hipSuccess) { fprintf(stderr, "kernel_launch: hipFuncSetAttribute failed\n"); grid = -1; return; }
        if (hipOccupancyMaxActiveBlocksPerMultiprocessor(&per_cu, (const void*)fwd_megakernel, 512, LDS_BYTES) != hipSuccess || per_cu < 1) { fprintf(stderr, "kernel_launch: occupancy query says %d\n", per_cu); per_cu = 1; }
        (void)hipGetLastError();
        grid = cus < 256 ? cus : 256;
    }
    if (grid < 0) return;
    Params p{};
    p.x = (const float*)d_in[0]; p.norm_pre = (const float*)d_in[1]; p.w_in = (const float*)d_in[2]; p.b_forget = (const float*)d_in[3];
    p.lam_re = (const float*)d_in[4]; p.lam_im = (const float*)d_in[5]; p.log_dt = (const float*)d_in[6]; p.b_re = (const float*)d_in[7]; p.b_im = (const float*)d_in[8];
    p.c_re = (const float*)d_in[9]; p.c_im = (const float*)d_in[10]; p.d_skip = (const float*)d_in[11]; p.w_glu = (const float*)d_in[12]; p.b_glu = (const float*)d_in[13];
    p.w_a = (const float*)d_in[14]; p.w_s = (const float*)d_in[15]; p.w_out = (const float*)d_in[16]; p.norm_post = (const float*)d_in[17];
    p.out = (float*)d_out; p.ws = (unsigned char*)d_ws;
#if MK_MULTI
    for (int ph = 0; ph < 9; ++ph) { p.ph_lo = ph; p.ph_hi = ph + 1; hipLaunchKernelGGL(fwd_megakernel, dim3(grid), dim3(512), LDS_BYTES, stream, p); }
#else
    p.ph_lo = 0; p.ph_hi = 9;
    void* args[] = {&p};
    hipError_t e = hipLaunchCooperativeKernel((const void*)fwd_megakernel, dim3(grid), dim3(512), args, LDS_BYTES, stream);
    if (e != hipSuccess) fprintf(stderr, "cooperative launch failed: %s (grid %d)\n", hipGetErrorString(e), grid);
#endif
}
```

```cpp
#include <hip/hip_runtime.h>
#include <hip/hip_cooperative_groups.h>
#include <hip/hip_bf16.h>
#include <cstdio>
#include <cstdint>
#include <cmath>
namespace cg = cooperative_groups;

#ifndef MK_MULTI
#define MK_MULTI 0
#endif

namespace pg8 {
#define PG8_LAS __attribute__((address_space(3)))
typedef unsigned short bf16_t;
typedef short bf16x8 __attribute__((ext_vector_type(8)));
typedef float f32x4 __attribute__((ext_vector_type(4)));
typedef unsigned u32x4 __attribute__((ext_vector_type(4)));
constexpr int BM = 256, BK = 64, HALF = 128, HTB = HALF * BK * 2, STAGE_BYTES = 8 * HTB, NXCD = 8, WGM = 8;

__host__ __device__ __forceinline__ int lds_byte(int r, int c) { const int st = (r >> 4) * 2 + (c >> 5), rr = r & 15, cc = c & 31, ob = rr * 64 + cc * 2; return st * 1024 + (ob ^ (((ob >> 9) & 1) << 5)); }
__host__ __device__ __forceinline__ void stage_rc(int b, int& R, int& C) { const int st = b / 1024, sb = b % 1024, swz = sb ^ (((sb >> 9) & 1) << 5); R = (st >> 1) * 16 + swz / 64; C = (st & 1) * 32 + (swz % 64) / 2; }
__host__ __device__ __forceinline__ int perm32(int rho) { const int n = rho >> 4, i = rho & 15; return 8 * (i >> 2) + 4 * n + (i & 3); }

struct Unit { int pm, pn, z; };
struct Gemm { const bf16_t* A; const bf16_t* Bt; int K, lda, ldb; long zsA, zsB; const bf16_t* A2; const bf16_t* Bt2; int ksplit; long cgA; };

__device__ __forceinline__ void swz_map(int L, int nM, int nN, int& pm, int& pn) {
    const int nwg = nM * nN; int wgid = L; { const int q = nwg / NXCD, r = nwg % NXCD, xcd = wgid % NXCD, off = wgid / NXCD; wgid = (xcd < r ? xcd * (q + 1) : r * (q + 1) + (xcd - r) * q) + off; }
    const int nig = WGM * nN, gid = wgid / nig, fm = gid * WGM, gsz = (nM - fm) < WGM ? (nM - fm) : WGM;
    pm = fm + ((wgid % nig) % gsz); pn = (wgid % nig) / gsz;
}
struct TileOrder {
    int nM, nN, nz, G, c, swz;
    __device__ __forceinline__ bool next(int i, Unit& u) const {
        const long L = (long)i * G + c; const int per = nM * nN; if (L >= (long)per * nz) return false;
        const int z = (int)(L / per), l = (int)(L % per); u.z = z;
        if (swz) swz_map(l, nM, nN, u.pm, u.pn); else { u.pm = l % nM; u.pn = l / nM; }
        return true;
    }
    __device__ __forceinline__ int nt(const Unit&, int K) const { return K / BK; }
};
struct SsmYOrder {
    int G, c;
    __device__ __forceinline__ bool next(int i, Unit& u) const {
        const long L = (long)i * G + c; if (L >= 32 * 16) return false;
        u.z = (int)(L >> 4); const int l = (int)(L & 15); u.pm = l & 3; u.pn = (i & 1) ? 3 - (l >> 2) : (l >> 2); return true;
    }
    __device__ __forceinline__ int nt(const Unit& u, int) const { return 6 + 4 * u.pn; }
};
struct PassOrder {
    int nM, nN, G, c;
    __device__ __forceinline__ bool next(int i, Unit& u) const {
        const long L = (long)(i >> 1) * G + c; if (L >= (long)nM * nN) return false;
        u.z = i & 1; swz_map((int)L, nM, nN, u.pm, u.pn); return true;
    }
    __device__ __forceinline__ int nt(const Unit&, int K) const { return K / BK; }
};

__device__ __forceinline__ unsigned cvt_pk_bf16(float lo, float hi) { unsigned r; asm volatile("v_cvt_pk_bf16_f32 %0, %1, %2" : "=v"(r) : "v"(lo), "v"(hi)); return r; }
__device__ __forceinline__ float bf_lo(unsigned w) { return __uint_as_float(w << 16); }
__device__ __forceinline__ float bf_hi(unsigned w) { return __uint_as_float(w & 0xffff0000u); }
__device__ __forceinline__ float sigm(float v) { return __builtin_amdgcn_rcpf(1.0f + __expf(-v)); }

template <class Epi, class Sched>
__device__ __forceinline__ void gemm_phase(PG8_LAS unsigned char* lds, const Gemm g, const Sched& S, const Epi& E) {
    const int tid = threadIdx.x, wid = __builtin_amdgcn_readfirstlane(tid >> 6), lane = tid & 63, wr = wid >> 2, wc = wid & 3, fr = lane & 15, fq = lane >> 4;
    unsigned voffA[2], voffB[2];
#pragma unroll
    for (int i = 0; i < 2; ++i) { int R, C; stage_rc(tid * 16 + i * 8192, R, C); const int Rb = (R & ~31) + perm32(R & 31);
        voffA[i] = (unsigned)(R * g.lda + (C & 15) + (long)(C >> 4) * g.cgA) * 2u; voffB[i] = (unsigned)(Rb * g.ldb + C) * 2u; }
    const size_t kstepA = (size_t)(4 * g.cgA * 2), kstepB = (size_t)(BK * 2);
    const size_t hstepA = (size_t)HALF * g.lda * 2, hstepB = (size_t)HALF * g.ldb * 2;
    const size_t tstepA = 2 * hstepA, tstepB = 2 * hstepB;
    const unsigned ldsw = (unsigned)wid * 1024u;
    const int aoff = lds_byte(wr * 64 + fr, fq * 8), boff = lds_byte(wc * 32 + fr, fq * 8);
#define PG8_SA(b, h) (((b) * 2 + (h)) * HTB)
#define PG8_SB(b, h) ((4 + (b) * 2 + (h)) * HTB)
#define PG8_STAGE(bufoff, gbase, voff) do { _Pragma("unroll") for (int _i = 0; _i < 2; ++_i) \
        __builtin_amdgcn_global_load_lds((const unsigned*)((const char*)(gbase) + (voff)[_i]), (PG8_LAS unsigned*)(lds + (bufoff) + ldsw + _i * 8192), 16, 0, 0); } while (0)
#define PG8_LDA(dst, b, h) do { _Pragma("unroll") for (int m = 0; m < 4; ++m) _Pragma("unroll") for (int k = 0; k < 2; ++k) dst[m][k] = *(const PG8_LAS bf16x8*)(lds + PG8_SA(b, h) + aoff + m * 2048 + k * 1024); } while (0)
#define PG8_LDB(dst, b, h) do { _Pragma("unroll") for (int n = 0; n < 2; ++n) _Pragma("unroll") for (int k = 0; k < 2; ++k) dst[n][k] = *(const PG8_LAS bf16x8*)(lds + PG8_SB(b, h) + boff + n * 2048 + k * 1024); } while (0)
#define PG8_MMA(ai, bj, At, Bt) do { __builtin_amdgcn_s_setprio(1); _Pragma("unroll") for (int m = 0; m < 4; ++m) _Pragma("unroll") for (int n = 0; n < 2; ++n) _Pragma("unroll") for (int k = 0; k < 2; ++k) \
        acc[ai][bj][m][n] = __builtin_amdgcn_mfma_f32_16x16x32_bf16(Bt[n][k], At[m][k], acc[ai][bj][m][n], 0, 0, 0); __builtin_amdgcn_s_setprio(0); } while (0)
#define PG8_WAIT_V(n) asm volatile("s_waitcnt vmcnt(" #n ")" ::: "memory")
#define PG8_WAIT_L(n) asm volatile("s_waitcnt lgkmcnt(" #n ")" ::: "memory")
#define PG8_BAR __builtin_amdgcn_s_barrier()
#define PG8_SCHED __builtin_amdgcn_sched_barrier(0)
    Unit cur, nxt; int ui = 0;
    if (!S.next(0, cur)) return;
    f32x4 acc[2][2][4][2];
#pragma unroll
    for (int a = 0; a < 2; ++a)
#pragma unroll
        for (int b = 0; b < 2; ++b)
#pragma unroll
            for (int m = 0; m < 4; ++m)
#pragma unroll
                for (int n = 0; n < 2; ++n) acc[a][b][m][n] = (f32x4){0.f, 0.f, 0.f, 0.f};
    bf16x8 At[4][2], B0[2][2], B1[2][2];
    const char* cA = (const char*)(g.A + (size_t)cur.z * g.zsA) + (size_t)cur.pm * tstepA; const char* cB = (const char*)(g.Bt + (size_t)cur.z * g.zsB) + (size_t)cur.pn * tstepB;
    PG8_STAGE(PG8_SB(0, 0), cB, voffB); PG8_STAGE(PG8_SB(0, 1), cB + hstepB, voffB); PG8_STAGE(PG8_SA(0, 0), cA, voffA); PG8_STAGE(PG8_SA(0, 1), cA + hstepA, voffA);
    if (wr == 1) PG8_BAR;
    PG8_WAIT_V(2); PG8_BAR;
    PG8_STAGE(PG8_SB(1, 0), cB + kstepB, voffB); PG8_STAGE(PG8_SA(1, 0), cA + kstepA, voffA); PG8_STAGE(PG8_SB(1, 1), cB + hstepB + kstepB, voffB);
    PG8_WAIT_V(6); PG8_BAR;
    for (;;) {
        const bool has_next = S.next(ui + 1, nxt);
        const int nt = S.nt(cur, g.K);
        const char* nA = has_next ? (const char*)(g.A + (size_t)nxt.z * g.zsA) + (size_t)nxt.pm * tstepA : cA; const char* nB = has_next ? (const char*)(g.Bt + (size_t)nxt.z * g.zsB) + (size_t)nxt.pn * tstepB : cB;
        const int ks = g.ksplit;
        const char* cA2 = ks ? (const char*)g.A2 + (size_t)cur.pm * tstepA - (size_t)ks * kstepA : cA; const char* cB2 = ks ? (const char*)g.Bt2 + (size_t)cur.pn * tstepB - (size_t)ks * kstepB : cB;
        for (int t = 0; t < nt; t += 2) {
            const bool last = (t == nt - 2);
            if constexpr (Epi::HAS_MID) { if (t == ks) E.mid(acc, cur, wr, wc, fr, fq); }
            const bool s1 = ks && (t + 1 >= ks), s2 = ks && (t + 2 >= ks);
            const char* a1 = (s1 ? cA2 : cA) + (size_t)(t + 1) * kstepA;
            const char* a2 = last ? nA : (s2 ? cA2 : cA) + (size_t)(t + 2) * kstepA; const char* b2 = last ? nB : (s2 ? cB2 : cB) + (size_t)(t + 2) * kstepB;
            const char* a3 = a2 + kstepA; const char* b3 = b2 + kstepB;
            PG8_LDB(B0, 0, 0); PG8_LDB(B1, 0, 1); PG8_SCHED; PG8_LDA(At, 0, 0); PG8_STAGE(PG8_SA(1, 1), a1 + hstepA, voffA);
            PG8_WAIT_V(8); PG8_WAIT_L(0); PG8_BAR; PG8_MMA(0, 0, At, B0); PG8_MMA(0, 1, At, B1); PG8_BAR; PG8_SCHED;
            PG8_LDA(At, 0, 1); PG8_STAGE(PG8_SB(0, 0), b2, voffB); PG8_STAGE(PG8_SB(0, 1), b2 + hstepB, voffB); PG8_STAGE(PG8_SA(0, 0), a2, voffA);
            PG8_WAIT_V(8); PG8_WAIT_L(0); PG8_BAR; PG8_MMA(1, 0, At, B0); PG8_MMA(1, 1, At, B1); PG8_BAR; PG8_SCHED;
            PG8_LDB(B0, 1, 0); PG8_LDB(B1, 1, 1); PG8_SCHED; PG8_LDA(At, 1, 0); PG8_STAGE(PG8_SA(0, 1), a2 + hstepA, voffA);
            PG8_WAIT_V(8); PG8_WAIT_L(0); PG8_BAR; PG8_MMA(0, 0, At, B0); PG8_MMA(0, 1, At, B1); PG8_BAR; PG8_SCHED;
            PG8_LDA(At, 1, 1); PG8_STAGE(PG8_SB(1, 0), b3, voffB); PG8_STAGE(PG8_SB(1, 1), b3 + hstepB, voffB); PG8_STAGE(PG8_SA(1, 0), a3, voffA);
            PG8_WAIT_V(8); PG8_WAIT_L(0); PG8_BAR; PG8_MMA(1, 0, At, B0); PG8_MMA(1, 1, At, B1); PG8_BAR; PG8_SCHED;
        }
        if (wr == 0) PG8_BAR;
        E(acc, cur, wr, wc, fr, fq);
        if (!has_next) break;
#pragma unroll
        for (int a = 0; a < 2; ++a)
#pragma unroll
            for (int b = 0; b < 2; ++b)
#pragma unroll
                for (int m = 0; m < 4; ++m)
#pragma unroll
                    for (int n = 0; n < 2; ++n) acc[a][b][m][n] = (f32x4){0.f, 0.f, 0.f, 0.f};
        cur = nxt; cA = nA; cB = nB; ++ui;
        if (wr == 1) PG8_BAR;
    }
    PG8_WAIT_V(0);
    PG8_BAR;
#undef PG8_SA
#undef PG8_SB
#undef PG8_STAGE
#undef PG8_LDA
#undef PG8_LDB
#undef PG8_MMA
#undef PG8_WAIT_V
#undef PG8_WAIT_L
#undef PG8_BAR
#undef PG8_SCHED
}
}

using pg8::bf16_t; using pg8::f32x4; using pg8::u32x4; using pg8::Unit; using pg8::cvt_pk_bf16; using pg8::bf_lo; using pg8::bf_hi; using pg8::sigm;
#define LAS __attribute__((address_space(3)))

constexpr int BATCH = 8, SEQ = 8192, DM = 1024, MTOK = BATCH * SEQ;
constexpr int NH = 8, HD = 64, AW = 512, SW = 512, NG = 32, GC = 16, NP = 64;
constexpr int INC = 5640;
constexpr int NPROJ = 5120;
constexpr int CH = 64, NCHK = MTOK / CH;
constexpr int KX = 1152;
constexpr float C2 = 0.125f * 1.4426950408889634f;
constexpr float LOG2E = 1.4426950408889634f;
constexpr float SKIP_LOG2 = 40.0f;

constexpr size_t MiB = 1u << 20;
constexpr size_t WS_SUMSQ = 0;
constexpr size_t WS_NRM = 512 * 1024;
constexpr size_t WS_LAM64 = 520 * 1024;
constexpr size_t WS_CNT = 576 * 1024;
constexpr size_t WS_BAR = 640 * 1024;
constexpr size_t WS_WIN = 1 * MiB;
constexpr size_t WS_WGLU = 11 * MiB;
constexpr size_t WS_WA = 12 * MiB;
constexpr size_t WS_WS = 13 * MiB;
constexpr size_t WS_WOUT = 14 * MiB;
constexpr size_t WS_LOGF = 16 * MiB;
constexpr size_t WS_CUM = 18 * MiB;
constexpr size_t WS_WEND = 20 * MiB;
constexpr size_t WS_E = 36 * MiB;
constexpr size_t WS_TZ = 52 * MiB;
constexpr size_t WS_U2 = 124 * MiB;
constexpr size_t WS_H = 196 * MiB;
constexpr size_t WS_RSTD = 704 * 1024;
constexpr size_t WS_Q = 324 * MiB, WS_K = 388 * MiB, WS_V = 452 * MiB, WS_GA = 516 * MiB, WS_GS = 580 * MiB;
constexpr size_t WS_MERGED = WS_Q;
constexpr size_t WS_MIXA = 644 * MiB, WS_MIXS = 772 * MiB;
constexpr size_t WS_PRE = WS_MIXA;
constexpr size_t WS_YA = 900 * MiB;
constexpr size_t WS_YS = WS_GA;
constexpr size_t WS_YS2 = WS_V;
constexpr size_t WS_END = 964 * MiB;

constexpr int LDS_BYTES = 147456;

struct Params {
    const float *x, *norm_pre, *w_in, *b_forget, *lam_re, *lam_im, *log_dt, *b_re, *b_im, *c_re, *c_im, *d_skip, *w_glu, *b_glu, *w_a, *w_s, *w_out, *norm_post;
    float* out; unsigned char* ws; int ph_lo, ph_hi;
};

#define EPI_LOOP_BEGIN \
    _Pragma("unroll") for (int ai = 0; ai < 2; ++ai) _Pragma("unroll") for (int m = 0; m < 4; ++m) { const int row = u.pm * 256 + ai * 128 + wr * 64 + m * 16 + fr; \
    _Pragma("unroll") for (int bj = 0; bj < 2; ++bj) { const int ct = bj * 128 + wc * 32 + 8 * fq; f32x4 v0 = acc[ai][bj][m][0], v1 = acc[ai][bj][m][1];
#define EPI_LOOP_END } }
__device__ __forceinline__ u32x4 pack8(f32x4 a, f32x4 b) { u32x4 w; w.x = cvt_pk_bf16(a[0], a[1]); w.y = cvt_pk_bf16(a[2], a[3]); w.z = cvt_pk_bf16(b[0], b[1]); w.w = cvt_pk_bf16(b[2], b[3]); return w; }
__device__ __forceinline__ void unpack8(u32x4 w, f32x4& a, f32x4& b) { a = (f32x4){bf_lo(w.x), bf_hi(w.x), bf_lo(w.y), bf_hi(w.y)}; b = (f32x4){bf_lo(w.z), bf_hi(w.z), bf_lo(w.w), bf_hi(w.w)}; }

struct EpiProj {
    static constexpr bool HAS_MID = false;
    unsigned char* ws;
    __device__ __forceinline__ void operator()(const f32x4 (&acc)[2][2][4][2], const Unit& u, int wr, int wc, int fr, int fq) const {
        const int pn = u.pn;
        int act = 0, pitch = 512, cb = (pn & 1) * 256; size_t off; float sc = 1.f;
        if (pn < 2) { off = WS_Q; sc = C2; } else if (pn < 4) off = WS_K; else if (pn < 6) off = WS_V; else if (pn < 8) { off = WS_GA; act = 1; }
        else if (pn < 10) { off = WS_U2; act = 3; } else if (pn < 12) { off = WS_GS; act = 1; }
        else {
            bf16_t* RA = (bf16_t*)(ws + WS_MIXA); bf16_t* SS = (bf16_t*)(ws + WS_MIXS);
#pragma unroll
            for (int ai = 0; ai < 2; ++ai)
#pragma unroll
                for (int m = 0; m < 4; ++m) { const int row = u.pm * 256 + ai * 128 + wr * 64 + m * 16 + fr; const size_t o = (size_t)row * DM + (pn - 12) * 128 + wc * 32 + 8 * fq;
                    f32x4 r0, r1, s0, s1;
#pragma unroll
                    for (int e = 0; e < 4; ++e) {
                        const float ea0 = __expf(-fmaxf(acc[ai][0][m][0][e], -30.f)), ea1 = __expf(-fmaxf(acc[ai][0][m][1][e], -30.f));
                        const float es0 = __expf(-fmaxf(acc[ai][1][m][0][e], -30.f)), es1 = __expf(-fmaxf(acc[ai][1][m][1][e], -30.f));
                        r0[e] = (1.f + es0) * __builtin_amdgcn_rcpf(1.f + ea0); r1[e] = (1.f + es1) * __builtin_amdgcn_rcpf(1.f + ea1);
                        s0[e] = __builtin_amdgcn_rcpf(1.f + es0); s1[e] = __builtin_amdgcn_rcpf(1.f + es1); }
                    *(u32x4*)(RA + o) = pack8(r0, r1); *(u32x4*)(SS + o) = pack8(s0, s1); }
            return;
        }
        bf16_t* base = (bf16_t*)(ws + off);
        float mx0 = 0.f, mx1 = 0.f;
        EPI_LOOP_BEGIN
            v0 = v0 * sc; v1 = v1 * sc;
            if (act == 1) {
#pragma unroll
                for (int e = 0; e < 4; ++e) { v0[e] = v0[e] * sigm(v0[e]); v1[e] = v1[e] * sigm(v1[e]); }
            } else if (act == 2) {
#pragma unroll
                for (int e = 0; e < 4; ++e) { v0[e] = sigm(fmaxf(v0[e], -30.f)); v1[e] = sigm(fmaxf(v1[e], -30.f)); }
            }
            const u32x4 w = pack8(v0, v1);
            if (act == 3) { const int cu = cb + ct, gg = cu >> 4, c0 = cu & 15; *(u32x4*)(base + ((size_t)(gg * NCHK + (row >> 6)) * KX + 128 + (row & 63) * 16 + c0)) = w; }
            else *(u32x4*)(base + (size_t)row * pitch + cb + ct) = w;
            if (pn < 4) {
                float s = (v0[0] * v0[0] + v0[1] * v0[1]) + (v0[2] * v0[2] + v0[3] * v0[3]) + (v1[0] * v1[0] + v1[1] * v1[1]) + (v1[2] * v1[2] + v1[3] * v1[3]);
                s += __shfl_xor(s, 16); s += __shfl_xor(s, 32);
                if (bj == 0) mx0 = fmaxf(mx0, s); else mx1 = fmaxf(mx1, s);
            }
        EPI_LOOP_END
        if (pn < 4) {
#pragma unroll
            for (int o = 1; o < 16; o <<= 1) { mx0 = fmaxf(mx0, __shfl_xor(mx0, o)); mx1 = fmaxf(mx1, __shfl_xor(mx1, o)); }
            if ((threadIdx.x & 63) == 0) {
                unsigned* nrm = (unsigned*)(ws + WS_NRM); const int b = u.pm >> 5, which = (pn >> 1) * 2 + (wc & 1);
                const int h0 = (pn & 1) * 4 + (wc >> 1), h1 = h0 + 2;
                atomicMax(nrm + (b * 8 + h0) * 4 + which, __float_as_uint(mx0 * 1.02f));
                atomicMax(nrm + (b * 8 + h1) * 4 + which, __float_as_uint(mx1 * 1.02f));
            }
        }
    }
};
struct EpiSsmE {
    static constexpr bool HAS_MID = false;
    float* E;
    __device__ __forceinline__ void operator()(const f32x4 (&acc)[2][2][4][2], const Unit& u, int wr, int wc, int fr, int fq) const {
        EPI_LOOP_BEGIN
            if (bj == 0) { float* p = E + ((size_t)(u.z * NCHK + row) * 128 + ct); *(f32x4*)p = v0; *(f32x4*)(p + 4) = v1; }
        EPI_LOOP_END
    }
};
__device__ __forceinline__ float gelu_t(float x) { const float y = 0.7978845608028654f * (x + 0.044715f * x * x * x); return x * sigm(2.0f * y); }
struct EpiSsmY {
    static constexpr bool HAS_MID = false;
    bf16_t* YS;
    __device__ __forceinline__ void operator()(const f32x4 (&acc)[2][2][4][2], const Unit& u, int wr, int wc, int fr, int fq) const {
        EPI_LOOP_BEGIN
#pragma unroll
            for (int e = 0; e < 4; ++e) { v0[e] = gelu_t(v0[e]); v1[e] = gelu_t(v1[e]); }
            const int j = u.pn * 256 + ct, t = j >> 4, c0 = j & 15;
            *(u32x4*)(YS + (((size_t)u.z * MTOK + row * CH + t) * 16 + c0)) = pack8(v0, v1);
        EPI_LOOP_END
    }
};
struct EpiGlu {
    static constexpr bool HAS_MID = false;
    const bf16_t* YS; const bf16_t* GS; const float* bias; bf16_t* O;
    __device__ __forceinline__ void operator()(const f32x4 (&acc)[2][2][4][2], const Unit& u, int wr, int wc, int fr, int fq) const {
        EPI_LOOP_BEGIN
            const int col = u.pn * 256 + ct; const size_t o = (size_t)row * SW + col;
            const f32x4 b0 = *(const f32x4*)(bias + col), b1 = *(const f32x4*)(bias + col + 4);
            f32x4 y0, y1, g0, g1; unpack8(*(const u32x4*)(YS + (((size_t)(col >> 4) * MTOK + row) * 16 + (col & 15))), y0, y1); unpack8(*(const u32x4*)(GS + o), g0, g1);
#pragma unroll
            for (int e = 0; e < 4; ++e) { v0[e] = y0[e] * sigm(v0[e] + b0[e]) * g0[e]; v1[e] = y1[e] * sigm(v1[e] + b1[e]) * g1[e]; }
            *(u32x4*)(O + o) = pack8(v0, v1);
        EPI_LOOP_END
    }
};
struct EpiMerge {
    static constexpr bool HAS_MID = true;
    const bf16_t* MA; const bf16_t* MS; bf16_t* O;
    __device__ __forceinline__ void mid(f32x4 (&acc)[2][2][4][2], const Unit& u, int wr, int wc, int fr, int fq) const {
        __builtin_amdgcn_sched_barrier(0);
        unsigned o0 = (unsigned)((u.pm * 256 + wr * 64 + fr) * DM + u.pn * 256 + wc * 32 + 8 * fq);
        asm volatile("" : "+v"(o0));
#pragma unroll
        for (int ai = 0; ai < 2; ++ai) { u32x4 rr[2][4];
#pragma unroll
            for (int bj = 0; bj < 2; ++bj)
#pragma unroll
                for (int m = 0; m < 4; ++m) rr[bj][m] = *(const u32x4*)(MA + (o0 + (unsigned)((ai * 128 + m * 16) * DM + bj * 128)));
#pragma unroll
            for (int bj = 0; bj < 2; ++bj)
#pragma unroll
                for (int m = 0; m < 4; ++m) { f32x4 a0, a1; unpack8(rr[bj][m], a0, a1); acc[ai][bj][m][0] *= a0; acc[ai][bj][m][1] *= a1; }
            __builtin_amdgcn_sched_barrier(0); }
    }
    __device__ __forceinline__ void operator()(const f32x4 (&acc)[2][2][4][2], const Unit& u, int wr, int wc, int fr, int fq) const {
        unsigned o0 = (unsigned)((u.pm * 256 + wr * 64 + fr) * DM + u.pn * 256 + wc * 32 + 8 * fq);
#pragma unroll
        for (int ai = 0; ai < 2; ++ai) { u32x4 gg[2][4];
#pragma unroll
            for (int bj = 0; bj < 2; ++bj)
#pragma unroll
                for (int m = 0; m < 4; ++m) gg[bj][m] = *(const u32x4*)(MS + (o0 + (unsigned)((ai * 128 + m * 16) * DM + bj * 128)));
#pragma unroll
            for (int bj = 0; bj < 2; ++bj)
#pragma unroll
                for (int m = 0; m < 4; ++m) { f32x4 s0, s1; unpack8(gg[bj][m], s0, s1);
                    *(u32x4*)(O + (o0 + (unsigned)((ai * 128 + m * 16) * DM + bj * 128))) = pack8(acc[ai][bj][m][0] * s0, acc[ai][bj][m][1] * s1); }
            __builtin_amdgcn_sched_barrier(0); }
    }
};
struct EpiOut {
    static constexpr bool HAS_MID = false;
    bf16_t* pre; float* sumsq;
    __device__ __forceinline__ void operator()(const f32x4 (&acc)[2][2][4][2], const Unit& u, int wr, int wc, int fr, int fq) const {
#pragma unroll
        for (int ai = 0; ai < 2; ++ai)
#pragma unroll
            for (int m = 0; m < 4; ++m) { const int row = u.pm * 256 + ai * 128 + wr * 64 + m * 16 + fr; float s = 0.f;
#pragma unroll
                for (int bj = 0; bj < 2; ++bj) { const f32x4 v0 = acc[ai][bj][m][0], v1 = acc[ai][bj][m][1];
                    *(u32x4*)(pre + (size_t)row * DM + u.pn * 256 + bj * 128 + wc * 32 + 8 * fq) = pack8(v0, v1);
                    s += (v0[0] * v0[0] + v0[1] * v0[1]) + (v0[2] * v0[2] + v0[3] * v0[3]) + (v1[0] * v1[0] + v1[1] * v1[1]) + (v1[2] * v1[2] + v1[3] * v1[3]); }
                s += __shfl_xor(s, 16); s += __shfl_xor(s, 32);
                if (fq == 0) atomicAdd(sumsq + row, s); }
    }
};

namespace att {
typedef short bf16x8 __attribute__((ext_vector_type(8)));
typedef short s16x4 __attribute__((ext_vector_type(4)));
typedef float f32x16 __attribute__((ext_vector_type(16)));
constexpr int SLOTB = 8192;
constexpr int L_K = 0, L_V = 2 * SLOTB, L_B = 5 * SLOTB, L_WS = L_B + 512,
                         L_CNT = L_WS + 2048, L_OST = L_CNT + 128;
static_assert(L_OST + 8 * 8192 <= 131072, "attention LDS");
__device__ __forceinline__ int crow(int r, int hi) { return (r & 3) + 8 * (r >> 2) + 4 * hi; }
typedef float f32x2_t __attribute__((ext_vector_type(2))); typedef __bf16 bf16x2_t __attribute__((ext_vector_type(2)));
__device__ __forceinline__ unsigned cvtpk_s(float lo, float hi) { f32x2_t v = {lo, hi}; bf16x2_t b = __builtin_convertvector(v, bf16x2_t); return __builtin_bit_cast(unsigned, b); }
__device__ __forceinline__ float rowmax(const f32x16& p0, const f32x16& p1) {
    float a = fmaxf(p0[0], p1[0]);
#pragma unroll
    for (int r = 1; r < 16; ++r) a = fmaxf(a, fmaxf(p0[r], p1[r]));
    auto rr = __builtin_amdgcn_permlane32_swap(__float_as_uint(a), __float_as_uint(a), false, false);
    return fmaxf(__uint_as_float(rr[0]), __uint_as_float(rr[1]));
}
__device__ __forceinline__ void pv(f32x16* o, int vb, bf16x8 pa0, bf16x8 pa1, bf16x8 pa2, bf16x8 pa3) {
#pragma unroll
    for (int d0 = 0; d0 < 2; ++d0) { s16x4 lo[4], hi[4];
#pragma unroll
        for (int ks = 0; ks < 4; ++ks) {
            asm volatile("ds_read_b64_tr_b16 %0,%1 offset:%c2" : "=&v"(lo[ks]) : "v"(vb), "i"(d0 * 4096 + ks * 1024) : "memory");
            asm volatile("ds_read_b64_tr_b16 %0,%1 offset:%c2" : "=&v"(hi[ks]) : "v"(vb), "i"(d0 * 4096 + ks * 1024 + 512) : "memory"); }
        asm volatile("s_waitcnt lgkmcnt(0)" ::: "memory"); __builtin_amdgcn_sched_barrier(0);
#define PK(k) (bf16x8){lo[k][0], lo[k][1], lo[k][2], lo[k][3], hi[k][0], hi[k][1], hi[k][2], hi[k][3]}
        o[d0] = __builtin_amdgcn_mfma_f32_32x32x16_bf16(pa0, PK(0), o[d0], 0, 0, 0);
        o[d0] = __builtin_amdgcn_mfma_f32_32x32x16_bf16(pa1, PK(1), o[d0], 0, 0, 0);
        o[d0] = __builtin_amdgcn_mfma_f32_32x32x16_bf16(pa2, PK(2), o[d0], 0, 0, 0);
        o[d0] = __builtin_amdgcn_mfma_f32_32x32x16_bf16(pa3, PK(3), o[d0], 0, 0, 0);
#undef PK
    }
}
__device__ __forceinline__ void attn_unit(int b, int h, int qb, unsigned char* ws, LAS unsigned char* shm) {
    const int tid = threadIdx.x, lane = tid & 63, r32 = lane & 31, hi = lane >> 5; const int wid = __builtin_amdgcn_readfirstlane(tid >> 6);
    const long rowbase = (long)b * SEQ; const int q0 = qb * 256;
    const bf16_t* Qw = (const bf16_t*)(ws + WS_Q) + (rowbase + q0 + wid * 32) * AW + h * HD;
    const bf16_t* Kh = (const bf16_t*)(ws + WS_K) + rowbase * AW + h * HD; const bf16_t* Vh = (const bf16_t*)(ws + WS_V) + rowbase * AW + h * HD;
    const float* cum = (const float*)(ws + WS_CUM) + (size_t)(b * NH + h) * SEQ;
    const unsigned lds0 = (unsigned)(uintptr_t)shm;
    LAS float* wsf = (LAS float*)(shm + L_WS) + wid * 64;
    LAS int* cnt = (LAS int*)(shm + L_CNT);
    const float cref = cum[q0];
    const unsigned* nr = (const unsigned*)(ws + WS_NRM) + (b * NH + h) * 4;
    const float qn2 = __uint_as_float(nr[0]) + __uint_as_float(nr[1]), kn2 = __uint_as_float(nr[2]) + __uint_as_float(nr[3]);
    const float X = SKIP_LOG2 + 2.0f * (sqrtf(qn2 * kn2) * 1.01f + 0.01f);
    const float Sb = sqrtf(qn2 * kn2) * 1.01f + 0.01f;
    float bend = 0.f; if (tid < 4 * qb) bend = cref - cum[64 * tid + 63];
    int pred = (tid < 4 * qb && bend < -X) ? 1 : 0;
    { const unsigned long long bal = __ballot(pred); if (lane == 0) cnt[wid] = __popcll(bal); }
    __syncthreads();
    int tile_lo = 0;
#pragma unroll
    for (int w = 0; w < 8; ++w) tile_lo += cnt[w];
    const int NT = 4 * qb + 4;
    bf16x8 qr[4];
#pragma unroll
    for (int d0 = 0; d0 < 4; ++d0) qr[d0] = *(const bf16x8*)(Qw + (long)r32 * AW + d0 * 16 + hi * 8);
    const bf16_t* ksrc = Kh + (long)lane * AW + wid * 8;
    const bf16_t* vsrc = Vh + (long)(16 * (wid & 3) + (lane >> 2)) * AW + (wid >> 2) * 32 + (lane & 3) * 8;
    const int koff = wid * 1024 + lane * 16;
    const int vb0 = (int)(lds0 + L_V) + ((lane >> 4) & 1) * 32 + (lane & 3) * 8 + (4 * hi + ((lane & 15) >> 2)) * 64;
    int t = NT - 1;
    u32x4 kA = *(const u32x4*)(ksrc + (long)t * 64 * AW), vA = *(const u32x4*)(vsrc + (long)t * 64 * AW);
    float bA = (tid < 64) ? (cref - cum[64 * t + tid]) : 0.f;
    u32x4 kB = kA, vB = vA; float bB = 0.f;
    if (t - 1 >= tile_lo) { kB = *(const u32x4*)(ksrc + (long)(t - 1) * 64 * AW); vB = *(const u32x4*)(vsrc + (long)(t - 1) * 64 * AW); bB = (tid < 64) ? (cref - cum[64 * (t - 1) + tid]) : 0.f; }
    float mhat = -1e30f, l_reg = 0.f; f32x16 o[2]; o[0] = f32x16{}; o[1] = f32x16{};
    const int qrel = wid * 32 + r32;
    int cur = 0, vcur = 0, vprev = 2;
    u32x4 pw0 = (u32x4){0u, 0u, 0u, 0u}, pw1 = pw0, pw2 = pw0, pw3 = pw0;
#define ATT_STEP(KR, VR, BR) do { \
        *(LAS u32x4*)(shm + L_K + cur * SLOTB + koff) = KR; *(LAS u32x4*)(shm + L_V + vcur * SLOTB + koff) = VR; \
        if (tid < 64) *(LAS float*)(shm + L_B + cur * 256 + tid * 4) = BR; \
        asm volatile("s_waitcnt lgkmcnt(0)\n\ts_barrier" ::: "memory");     \
        if (t - 2 >= tile_lo) { KR = *(const u32x4*)(ksrc + (long)(t - 2) * 64 * AW); VR = *(const u32x4*)(vsrc + (long)(t - 2) * 64 * AW); BR = (tid < 64) ? (cref - cum[64 * (t - 2) + tid]) : 0.f; } \
        att_tile(); \
    } while (0)
    auto att_tile = [&]() __attribute__((always_inline)) {
        const int jb = t - (NT - 4);
        if (jb <= (wid >> 1)) {
            f32x16 p0, p1;
            { const LAS float* bb = (const LAS float*)(shm + L_B + cur * 256);
#pragma unroll
              for (int g4 = 0; g4 < 4; ++g4) { const f32x4 a = *(const LAS f32x4*)(bb + 8 * g4 + 4 * hi), c = *(const LAS f32x4*)(bb + 32 + 8 * g4 + 4 * hi);
#pragma unroll
                  for (int e = 0; e < 4; ++e) { p0[4 * g4 + e] = a[e]; p1[4 * g4 + e] = c[e]; } } }
            { const LAS unsigned char* kb = shm + L_K + cur * SLOTB + hi * 1024 + r32 * 16;
              __builtin_amdgcn_s_setprio(1);
#pragma unroll
              for (int d0 = 0; d0 < 4; ++d0) { const bf16x8 b0 = *(const LAS bf16x8*)(kb + d0 * 2048), b1 = *(const LAS bf16x8*)(kb + d0 * 2048 + 512);
                  p0 = __builtin_amdgcn_mfma_f32_32x32x16_bf16(b0, qr[d0], p0, 0, 0, 0); p1 = __builtin_amdgcn_mfma_f32_32x32x16_bf16(b1, qr[d0], p1, 0, 0, 0); } }
            pv(o, vb0 + vprev * SLOTB, __builtin_bit_cast(bf16x8, pw0), __builtin_bit_cast(bf16x8, pw1), __builtin_bit_cast(bf16x8, pw2), __builtin_bit_cast(bf16x8, pw3));
            __builtin_amdgcn_s_setprio(0);
            if (jb >= 0) { const int kb0 = 64 * jb + 4 * hi;
#pragma unroll
                for (int r = 0; r < 16; ++r) { const int kv = kb0 + (r & 3) + 8 * (r >> 2); if (kv > qrel) p0[r] = -INFINITY; if (kv + 32 > qrel) p1[r] = -INFINITY; } }
            const float rm = rowmax(p0, p1);
            const float mnew = fmaxf(mhat, rm);
            if (__any(mnew > mhat)) {
                const float alpha = __builtin_amdgcn_exp2f(mhat - mnew); l_reg *= alpha; mhat = mnew;
                if (hi == 0) wsf[r32] = alpha;
                asm volatile("s_waitcnt lgkmcnt(0)" ::: "memory");
#pragma unroll
                for (int r = 0; r < 16; ++r) { const float f = wsf[crow(r, hi)]; o[0][r] *= f; o[1][r] *= f; }
            }
            float sacc = 0.f;
#pragma unroll
            for (int r = 0; r < 16; ++r) { p0[r] = __builtin_amdgcn_exp2f(p0[r] - mhat); p1[r] = __builtin_amdgcn_exp2f(p1[r] - mhat); sacc += p0[r] + p1[r]; }
            l_reg += sacc;
            pw0 = (u32x4){cvtpk_s(p0[0], p0[1]), cvtpk_s(p0[2], p0[3]), cvtpk_s(p0[4], p0[5]), cvtpk_s(p0[6], p0[7])};
            pw1 = (u32x4){cvtpk_s(p0[8], p0[9]), cvtpk_s(p0[10], p0[11]), cvtpk_s(p0[12], p0[13]), cvtpk_s(p0[14], p0[15])};
            pw2 = (u32x4){cvtpk_s(p1[0], p1[1]), cvtpk_s(p1[2], p1[3]), cvtpk_s(p1[4], p1[5]), cvtpk_s(p1[6], p1[7])};
            pw3 = (u32x4){cvtpk_s(p1[8], p1[9]), cvtpk_s(p1[10], p1[11]), cvtpk_s(p1[12], p1[13]), cvtpk_s(p1[14], p1[15])};
        }
        cur ^= 1; vprev = vcur; vcur = (vcur == 2) ? 0 : vcur + 1;
        if (jb == 0 && tile_lo < NT - 4) {
            float mm = mhat;
#pragma unroll
            for (int o2 = 1; o2 < 64; o2 <<= 1) mm = fminf(mm, __shfl_xor(mm, o2));
            LAS float* mw = (LAS float*)(shm + L_CNT) + 8;
            if (lane == 0) mw[wid] = mm;
            __syncthreads();
            float mmin = mw[0];
#pragma unroll
            for (int w = 1; w < 8; ++w) mmin = fminf(mmin, mw[w]);
            const float X2 = SKIP_LOG2 + Sb - mmin;
            const int pred2 = (tid < 4 * qb && bend < -X2) ? 1 : 0;
            { const unsigned long long bal = __ballot(pred2); if (lane == 0) cnt[wid] = __popcll(bal); }
            __syncthreads();
            int tl2 = 0;
#pragma unroll
            for (int w = 0; w < 8; ++w) tl2 += cnt[w];
            tile_lo = tl2 > tile_lo ? tl2 : tile_lo;
        }
    };
    for (;;) {
        ATT_STEP(kA, vA, bA); --t; if (t < tile_lo) break;
        ATT_STEP(kB, vB, bB); --t; if (t < tile_lo) break;
    }
#undef ATT_STEP
    pv(o, vb0 + vprev * SLOTB, __builtin_bit_cast(bf16x8, pw0), __builtin_bit_cast(bf16x8, pw1), __builtin_bit_cast(bf16x8, pw2), __builtin_bit_cast(bf16x8, pw3));
    { auto rr = __builtin_amdgcn_permlane32_swap(__float_as_uint(l_reg), __float_as_uint(l_reg), false, false); l_reg = __uint_as_float(rr[0]) + __uint_as_float(rr[1]); }
    if (hi == 0) wsf[32 + r32] = l_reg;
    asm volatile("s_waitcnt lgkmcnt(0)" ::: "memory");
    LAS float* stg = (LAS float*)(shm + L_OST) + wid * 2048;
#pragma unroll
    for (int r = 0; r < 16; ++r) { const int orow = crow(r, hi); const float rl = __builtin_amdgcn_rcpf(wsf[32 + orow]);
        stg[orow * 64 + r32] = o[0][r] * rl; stg[orow * 64 + 32 + r32] = o[1][r] * rl; }
    asm volatile("s_waitcnt lgkmcnt(0)" ::: "memory");
    const bf16_t* GAw = (const bf16_t*)(ws + WS_GA) + (rowbase + q0 + wid * 32) * AW + h * HD;
    bf16_t* Ow = (bf16_t*)(ws + WS_YA) + (rowbase + q0 + wid * 32) * AW + h * HD;
#pragma unroll
    for (int i = 0; i < 4; ++i) { const int row = i * 8 + (lane >> 3), ch = lane & 7;
        f32x4 a = *(const LAS f32x4*)(stg + row * 64 + ch * 8), c = *(const LAS f32x4*)(stg + row * 64 + ch * 8 + 4);
        f32x4 g0, g1; unpack8(*(const u32x4*)(GAw + (long)row * AW + ch * 8), g0, g1);
        *(u32x4*)(Ow + (long)row * AW + ch * 8) = pack8(a * g0, c * g1); }
    __syncthreads();
}
}

__device__ __forceinline__ unsigned f2bf(float f) { unsigned u = __builtin_bit_cast(unsigned, f); return (u + 0x7fffu + ((u >> 16) & 1u)) >> 16; }
__device__ __forceinline__ unsigned pk2(float lo, float hi) { return f2bf(lo) | (f2bf(hi) << 16); }
__device__ __forceinline__ float wave_sum(float v) {
#pragma unroll
    for (int o = 1; o < 64; o <<= 1) v += __shfl_xor(v, o);
    return v;
}
__device__ __forceinline__ void transpose_item(const float* W, int K, int ldw, int N, int col_shift_from, bf16_t* WT, LAS float* scr, int item, int lane) {
    const int nblk = N / 32, kb = item / nblk, nb = item % nblk, k0 = 64 * kb, n0 = 32 * nb;
    int sc0 = n0;
    if (col_shift_from >= 0) { if (n0 >= 3072) { const int T = (n0 - 3072) >> 8, j = (n0 - 3072) & 255; sc0 = (j < 128) ? 3080 + T * 128 + j : 4104 + T * 128 + (j - 128); } else if (n0 >= 1536) sc0 = n0 + 8; }
#pragma unroll 8
    for (int i = 0; i < 32; ++i) { const int kk = 2 * i + (lane >> 5); scr[kk * 33 + (lane & 31)] = W[(size_t)(k0 + kk) * ldw + sc0 + (lane & 31)]; }
    asm volatile("s_waitcnt lgkmcnt(0)" ::: "memory");
    const int c = lane & 7;
#pragma unroll
    for (int j = 0; j < 4; ++j) { const int n = (lane >> 3) + 8 * j; const LAS float* s = scr + (8 * c) * 33 + n;
        u32x4 o; o.x = pk2(s[0 * 33], s[1 * 33]); o.y = pk2(s[2 * 33], s[3 * 33]); o.z = pk2(s[4 * 33], s[5 * 33]); o.w = pk2(s[6 * 33], s[7 * 33]);
        *(u32x4*)(WT + (size_t)(n0 + n) * K + k0 + 8 * c) = o; }
    asm volatile("s_waitcnt lgkmcnt(0)" ::: "memory");
}
__device__ __forceinline__ void sincos_d(double x, double& s, double& c) {
    const double k = rint(x * 0.63661977236758134308);
    const double r = (x - k * 1.57079632679489655800) - k * 6.123233995736766035869e-17;
    const double r2 = r * r;
    const double sp = r * (1.0 + r2 * (-1.0 / 6 + r2 * (1.0 / 120 + r2 * (-1.0 / 5040 + r2 * (1.0 / 362880 + r2 * (-1.0 / 39916800 + r2 * (1.0 / 6227020800.0)))))));
    const double cp = 1.0 + r2 * (-0.5 + r2 * (1.0 / 24 + r2 * (-1.0 / 720 + r2 * (1.0 / 40320 + r2 * (-1.0 / 3628800 + r2 * (1.0 / 479001600.0 + r2 * (-1.0 / 87178291200.0)))))));
    const int q = ((int)k) & 3;
    s = (q == 0) ? sp : (q == 1) ? cp : (q == 2) ? -sp : -cp;
    c = (q == 0) ? cp : (q == 1) ? -sp : (q == 2) ? -cp : sp;
}
__device__ __forceinline__ double exp_d(double x) {
    const double n = rint(x * 1.44269504088896340736);
    const double r = (x - n * 0.693147180369123816490) - n * 1.90821492927058770002e-10;
    double p = 1.0 / 6227020800.0;
    p = p * r + 1.0 / 479001600.0; p = p * r + 1.0 / 39916800.0; p = p * r + 1.0 / 3628800.0; p = p * r + 1.0 / 362880.0; p = p * r + 1.0 / 40320.0;
    p = p * r + 1.0 / 5040.0; p = p * r + 1.0 / 720.0; p = p * r + 1.0 / 120.0; p = p * r + 1.0 / 24.0; p = p * r + 1.0 / 6.0; p = p * r + 0.5; p = p * r + 1.0; p = p * r + 1.0;
    const long long bits = ((long long)((int)n + 1023)) << 52;
    return p * __builtin_bit_cast(double, bits);
}

__device__ __forceinline__ void ssm_ops_item(const Params& p, int g, int c, LAS unsigned char* lds) {
    typedef float f32x2 __attribute__((ext_vector_type(2)));
    LAS f32x2* P = (LAS f32x2*)lds;
    LAS f32x2* Bb = (LAS f32x2*)(lds + 33280);
    LAS f32x2* Cc = (LAS f32x2*)(lds + 41472);
    LAS float* Km = (LAS float*)(lds + 41984);
    const int tid = threadIdx.x;
    if (tid < 64) {
        const int pp = tid;
        const double dt = exp_d((double)p.log_dt[g]); const double lr = (double)p.lam_re[g * 64 + pp], li = (double)p.lam_im[g * 64 + pp];
        const double mag = exp_d(lr * dt); double sn, cs; sincos_d(li * dt, sn, cs);
        const double abr = mag * cs, abi = mag * sn, den = lr * lr + li * li, nre = abr - 1.0;
        const double fre = (nre * lr + abi * li) / den, fim = (abi * lr - nre * li) / den;
        double pr = 1.0, pi = 0.0;
        for (int j = 0; j <= 64; ++j) { P[j * 64 + pp] = (f32x2){(float)pr, (float)pi}; const double nr = pr * abr - pi * abi, ni = pr * abi + pi * abr; pr = nr; pi = ni; }
        if (c == 0) ((f32x2*)(p.ws + WS_LAM64))[g * 64 + pp] = P[64 * 64 + pp];
        for (int q = 0; q < 16; ++q) { const double br = (double)p.b_re[(g * 64 + pp) * 16 + q], bi = (double)p.b_im[(g * 64 + pp) * 16 + q];
            Bb[pp * 16 + q] = (f32x2){(float)(fre * br - fim * bi), (float)(fre * bi + fim * br)}; }
        Cc[pp] = (f32x2){p.c_re[(g * 16 + c) * 64 + pp], p.c_im[(g * 16 + c) * 64 + pp]};
    }
    __syncthreads();
    {
        const int j = tid >> 3, q0 = (tid & 7) * 2;
        float k0 = 0.f, k1 = 0.f;
        for (int pp = 0; pp < 64; ++pp) {
            const f32x2 cc = Cc[pp], gg = P[j * 64 + pp], b0 = Bb[pp * 16 + q0], b1 = Bb[pp * 16 + q0 + 1];
            const float clr = cc.x * gg.x - cc.y * gg.y, cli = cc.x * gg.y + cc.y * gg.x;
            k0 += clr * b0.x - cli * b0.y; k1 += clr * b1.x - cli * b1.y;
        }
        if (j == 0) { const float d = p.d_skip[g * 16 + c]; if (q0 == c) k0 += d; if (q0 + 1 == c) k1 += d; }
        Km[j * 16 + q0] = k0; Km[j * 16 + q0 + 1] = k1;
    }
    __syncthreads();
    {
        bf16_t* TZ = (bf16_t*)(p.ws + WS_TZ) + (size_t)g * 1024 * KX;
        for (int idx = tid; idx < 64 * 144; idx += 512) {
            const int t = idx / 144, i = idx % 144, col = 8 * i;
            float v[8];
            if (col >= 128) { const int s = (col - 128) >> 4, chh = (col >> 3) & 1;
                if (s <= t) { const LAS float* k = Km + (t - s) * 16 + chh * 8;
#pragma unroll
                    for (int e = 0; e < 8; ++e) v[e] = k[e]; }
                else {
#pragma unroll
                    for (int e = 0; e < 8; ++e) v[e] = 0.f; }
            } else { const int p0 = col >> 1;
#pragma unroll
                for (int e = 0; e < 4; ++e) { const f32x2 cc = Cc[p0 + e], gg = P[(t + 1) * 64 + p0 + e]; v[2 * e] = cc.x * gg.x - cc.y * gg.y; v[2 * e + 1] = -(cc.x * gg.y + cc.y * gg.x); } }
            u32x4 w; w.x = pk2(v[0], v[1]); w.y = pk2(v[2], v[3]); w.z = pk2(v[4], v[5]); w.w = pk2(v[6], v[7]);
            *(u32x4*)(TZ + (size_t)(t * 16 + c) * KX + col) = w;
        }
        bf16_t* WE = (bf16_t*)(p.ws + WS_WEND) + (size_t)g * 256 * 1024;
        for (int idx = tid; idx < 16 * 128; idx += 512) {
            const int rl = idx >> 7, i = idx & 127, s = i >> 1, chh = i & 1;
            const int row = (rl < 8) ? (8 * c + rl) : (128 + 8 * c + (rl - 8));
            float v[8];
            if (rl < 8) { const int pp = row >> 1, ri = row & 1; const f32x2 gg = P[(63 - s) * 64 + pp];
#pragma unroll
                for (int e = 0; e < 8; ++e) { const f32x2 bb = Bb[pp * 16 + chh * 8 + e]; v[e] = ri ? (gg.x * bb.y + gg.y * bb.x) : (gg.x * bb.x - gg.y * bb.y); } }
            else {
#pragma unroll
                for (int e = 0; e < 8; ++e) v[e] = 0.f; }
            u32x4 w; w.x = pk2(v[0], v[1]); w.y = pk2(v[2], v[3]); w.z = pk2(v[4], v[5]); w.w = pk2(v[6], v[7]);
            *(u32x4*)(WE + (size_t)row * 1024 + 8 * i) = w;
        }
    }
    __syncthreads();
}

#define XB_TMO      128
#define XB_XCNT(j)  (256  + 64 * (j))
#define XB_XSUB(j)  (1280 + 64 * (j))
#define XB_XGEN(j)  (2304 + 64 * (j))
#define XB_TOP      3328
#define XB_TOPGEN   3392
#define XCD_BAR_WORDS 3456
#define XB_SPIN_CAP (1u << 18)
__device__ __forceinline__ unsigned xb_ld(unsigned* p)              { return __hip_atomic_load(p, __ATOMIC_RELAXED, __HIP_MEMORY_SCOPE_AGENT); }
__device__ __forceinline__ unsigned xb_add(unsigned* p, unsigned v) { return __hip_atomic_fetch_add(p, v, __ATOMIC_RELAXED, __HIP_MEMORY_SCOPE_AGENT); }
__device__ __forceinline__ unsigned xb_xcc_id() { return (unsigned)__builtin_amdgcn_s_getreg((3 << 11) | 20) & 0xFu; }
#define XB_SPIN(cond, bar) do { unsigned _sp = 0; while (cond) { __builtin_amdgcn_s_sleep(1); \
    if ((++_sp & 255u) == 0u) { if (xb_ld(&(bar)[XB_TMO])) break; if (_sp > XB_SPIN_CAP) { atomicAdd(&(bar)[XB_TMO], 1u); break; } } } } while (0)
struct XcdBarrier { unsigned* bar; unsigned x; volatile LAS unsigned* st; };
__device__ __forceinline__ XcdBarrier xcd_barrier_post(unsigned* bar, volatile LAS unsigned* st) {
    XcdBarrier b; b.bar = bar; b.x = xb_xcc_id(); b.st = st;
    if (threadIdx.x == 0) (void)xb_add(&bar[XB_XCNT(b.x)], 1u);
    return b;
}
__device__ __forceinline__ void xcd_barrier_complete(unsigned* bar, unsigned x, unsigned& nloc, unsigned& nx) {
    const unsigned G = gridDim.x * gridDim.y * gridDim.z;
    unsigned sum, cnt, mine, sp = 0u;
    for (;;) {
        sum = 0u; cnt = 0u; mine = 0u;
#pragma unroll
        for (unsigned j = 0; j < 16; ++j) { const unsigned c = xb_ld(&bar[XB_XCNT(j)]); sum += c; cnt += (c > 0u) ? 1u : 0u; mine = (j == x) ? c : mine; }
        if (sum == G) break;
        __builtin_amdgcn_s_sleep(1);
        if ((++sp & 255u) == 0u) { if (xb_ld(&bar[XB_TMO])) break; if (sp > XB_SPIN_CAP) { atomicAdd(&bar[XB_TMO], 1u); break; } }
    }
    nloc = mine > 0u ? mine : 1u; nx = cnt > 0u ? cnt : 1u;
}
__device__ __forceinline__ void xcd_barrier(const XcdBarrier& b) {
    asm volatile("s_waitcnt vmcnt(0)" ::: "memory");
    __syncthreads();
    if (threadIdx.x == 0) {
        unsigned* bar = b.bar;
        __builtin_amdgcn_s_waitcnt(0);
        unsigned nloc = b.st[0], nx = b.st[1];
        if (nloc == 0u) { xcd_barrier_complete(bar, b.x, nloc, nx); b.st[0] = nloc; b.st[1] = nx; }
        const unsigned old = xb_add(&bar[XB_XSUB(b.x)], 1u);
        const unsigned gen = old / nloc;
        if (old + 1u == (gen + 1u) * nloc) {
            __builtin_amdgcn_fence(__ATOMIC_RELEASE, "agent");
            asm volatile("s_waitcnt vmcnt(0)" ::: "memory");
            const unsigned og = xb_add(&bar[XB_TOP], 1u);
            const unsigned tg = og / nx;
            if (og + 1u == (tg + 1u) * nx) xb_add(&bar[XB_TOPGEN], 1u);
            else XB_SPIN(xb_ld(&bar[XB_TOPGEN]) == tg, bar);
            __builtin_amdgcn_fence(__ATOMIC_ACQUIRE, "agent");
            xb_add(&bar[XB_XGEN(b.x)], 1u);
            asm volatile("s_waitcnt vmcnt(0)" ::: "memory");
        } else {
            XB_SPIN(xb_ld(&bar[XB_XGEN(b.x)]) == gen, bar);
            __builtin_amdgcn_fence(__ATOMIC_ACQUIRE, "agent");
            asm volatile("s_waitcnt vmcnt(0)" ::: "memory");
        }
    }
    __syncthreads();
}

__global__ void __launch_bounds__(512) fwd_megakernel(Params p) {
    extern __shared__ __attribute__((aligned(16))) unsigned char lds_raw[];
    LAS unsigned char* lds = (LAS unsigned char*)lds_raw;
    cg::grid_group grid = cg::this_grid();
    const int tid = threadIdx.x, lane = tid & 63, wave = __builtin_amdgcn_readfirstlane(tid >> 6);
    const int G = gridDim.x, bx = blockIdx.x;
    unsigned char* ws = p.ws;
    const int lo = p.ph_lo, hi = p.ph_hi;
#define IN(k) (lo <= (k) && (k) < hi)
    volatile LAS unsigned* bst = (volatile LAS unsigned*)(lds + 131072 + 128);
    if (tid == 0) { bst[0] = 0u; bst[1] = 0u; }
    __syncthreads();
    XcdBarrier xbar; xbar.bar = (unsigned*)(ws + WS_BAR); xbar.x = 0; xbar.st = bst;
#define SEAM(k) do { if (IN(k) && IN((k) + 1)) { if ((k) == 0) { grid.sync(); xbar = xcd_barrier_post((unsigned*)(ws + WS_BAR), bst); } else xcd_barrier(xbar); } } while (0)

    if (IN(0)) {
        for (int i = bx * 512 + tid; i < MTOK; i += G * 512) ((float*)(ws + WS_SUMSQ))[i] = 0.f;
        if (bx == 0) for (int i = tid; i < 2048; i += 512) ((unsigned*)(ws + WS_NRM))[i] = 0u;
        if (bx == 1 || G == 1) for (int i = tid; i < 256 * 64; i += 512) ((unsigned*)(ws + WS_CNT))[i] = 0u;
        if (bx == 2 || G < 3) for (int i = tid; i < XCD_BAR_WORDS; i += 512) ((unsigned*)(ws + WS_BAR))[i] = 0u;
        const int gw = bx * 8 + wave, NGW = G * 8;
        auto partL = [&]() __attribute__((always_inline)) {
        for (int it = bx; it < NG * 16; it += G) ssm_ops_item(p, it >> 4, it & 15, lds);
        LAS float* scr = (LAS float*)(lds + wave * 8704);
        constexpr int I_IN = 16 * (NPROJ / 32), I_GLU = 8 * 16, I_A = 8 * 32, I_S = 8 * 32, I_O = 16 * 32, NIT = I_IN + I_GLU + I_A + I_S + I_O;
        for (int it = gw; it < NIT; it += NGW) {
            int r = it;
            if (r < I_IN) { transpose_item(p.w_in, DM, INC, NPROJ, 0, (bf16_t*)(ws + WS_WIN), scr, r, lane); continue; } r -= I_IN;
            if (r < I_GLU) { transpose_item(p.w_glu, SW, SW, SW, -1, (bf16_t*)(ws + WS_WGLU), scr, r, lane); continue; } r -= I_GLU;
            if (r < I_A) { transpose_item(p.w_a, AW, DM, DM, -1, (bf16_t*)(ws + WS_WA), scr, r, lane); continue; } r -= I_A;
            if (r < I_S) { transpose_item(p.w_s, SW, DM, DM, -1, (bf16_t*)(ws + WS_WS), scr, r, lane); continue; } r -= I_S;
            transpose_item(p.w_out, DM, DM, DM, -1, (bf16_t*)(ws + WS_WOUT), scr, r, lane);
        }
        };
        auto partR = [&]() __attribute__((always_inline)) {
        LAS float* wf = (LAS float*)(lds + 73728);
        for (int i = tid; i < 8192; i += 512) { const int k = i >> 3, j = i & 7; wf[j * 1024 + k] = p.w_in[(size_t)k * INC + 1536 + j]; }
        __syncthreads();
        f32x4 gn[4];
#pragma unroll
        for (int j = 0; j < 4; ++j) gn[j] = ((const f32x4*)p.norm_pre)[lane + 64 * j];
        f32x4 wreg[8][4];
#pragma unroll
        for (int e = 0; e < 8; ++e)
#pragma unroll
            for (int j = 0; j < 4; ++j) wreg[e][j] = *(const LAS f32x4*)(wf + e * 1024 + 4 * lane + 256 * j);
        const int fidx = ((lane & 1) << 2) | (lane & 2) | ((lane & 4) >> 2);
        const float bfg = p.b_forget[fidx];
        f32x4 vn[4];
        if (gw < MTOK) {
#pragma unroll
            for (int j = 0; j < 4; ++j) vn[j] = ((const f32x4*)(p.x + (size_t)gw * DM) + lane)[64 * j];
        }
        for (int m = gw; m < MTOK; m += NGW) {
            f32x4 v[4]; float s = 0.f;
#pragma unroll
            for (int j = 0; j < 4; ++j) v[j] = vn[j];
            if (m + NGW < MTOK) {
#pragma unroll
                for (int j = 0; j < 4; ++j) vn[j] = ((const f32x4*)(p.x + (size_t)(m + NGW) * DM) + lane)[64 * j];
            }
#pragma unroll
            for (int j = 0; j < 4; ++j) s += (v[j][0] * v[j][0] + v[j][1] * v[j][1]) + (v[j][2] * v[j][2] + v[j][3] * v[j][3]);
            const float rstd = 1.0f / sqrtf(wave_sum(s) * (1.f / DM) + 1e-6f);
            if (lane == 0) ((float*)(ws + WS_RSTD))[m] = rstd;
            unsigned long long* o8 = (unsigned long long*)((bf16_t*)(ws + WS_H) + (size_t)m * DM) + lane;
            float fa[8];
#pragma unroll
            for (int e = 0; e < 8; ++e) fa[e] = 0.f;
#pragma unroll
            for (int j = 0; j < 4; ++j) { v[j] = v[j] * rstd * gn[j];
                o8[64 * j] = (unsigned long long)pk2(v[j][0], v[j][1]) | ((unsigned long long)pk2(v[j][2], v[j][3]) << 32);
#pragma unroll
                for (int e = 0; e < 8; ++e) { const f32x4 w = wreg[e][j]; fa[e] += (v[j][0] * w[0] + v[j][1] * w[1]) + (v[j][2] * w[2] + v[j][3] * w[3]); } }
#pragma unroll
            for (int e = 0; e < 4; ++e) { const float a = fa[e], c = fa[e + 4]; const bool up = lane & 1; fa[e] = (up ? c : a) + __shfl_xor(up ? a : c, 1); }
#pragma unroll
            for (int e = 0; e < 2; ++e) { const float a = fa[e], c = fa[e + 2]; const bool up = lane & 2; fa[e] = (up ? c : a) + __shfl_xor(up ? a : c, 2); }
            { const float a = fa[0], c = fa[1]; const bool up = lane & 4; fa[0] = (up ? c : a) + __shfl_xor(up ? a : c, 4); }
            float z = fa[0];
            z += __shfl_xor(z, 8); z += __shfl_xor(z, 16); z += __shfl_xor(z, 32);
            if (lane < 8) { z += bfg;
                const float ls = fminf(z, 0.f) - log1pf(expf(-fabsf(z)));
                ((float*)(ws + WS_LOGF))[(size_t)m * 8 + fidx] = ls; }
        }
        };
        if ((bx >> 3) & 1) { partR(); __syncthreads(); partL(); } else { partL(); __syncthreads(); partR(); }
        __syncthreads();
    }
    SEAM(0);

    if (IN(1)) {
        for (int bh = bx; bh < BATCH * NH; bh += G) {
            const int b = bh >> 3, h = bh & 7;
            const float* lf = (const float*)(ws + WS_LOGF) + (size_t)b * SEQ * 8 + h;
            float v[16]; float s = 0.f;
#pragma unroll
            for (int e = 0; e < 16; ++e) { s += lf[(size_t)(tid * 16 + e) * 8]; v[e] = s; }
            float incl = s;
#pragma unroll
            for (int o = 1; o < 64; o <<= 1) { const float n = __shfl_up(incl, o); if (lane >= o) incl += n; }
            LAS float* wt = (LAS float*)lds;
            if (lane == 63) wt[wave] = incl;
            __syncthreads();
            float base = incl - s;
            for (int w = 0; w < wave; ++w) base += wt[w];
            float* co = (float*)(ws + WS_CUM) + (size_t)bh * SEQ + tid * 16;
#pragma unroll
            for (int e = 0; e < 16; ++e) co[e] = (base + v[e]) * LOG2E;
            __syncthreads();
        }
        pg8::Gemm g{(const bf16_t*)(ws + WS_H), (const bf16_t*)(ws + WS_WIN), DM, DM, DM, 0, 0, nullptr, nullptr, 0, 16};
        pg8::TileOrder S{MTOK / 256, NPROJ / 256, 1, G, bx, 1};
        EpiProj E{ws};
        pg8::gemm_phase(lds, g, S, E);
    }
    SEAM(1);

    if (IN(2)) {
        {
            pg8::Gemm g{(const bf16_t*)(ws + WS_U2) + 128, (const bf16_t*)(ws + WS_WEND), 1024, KX, 1024, (long)NCHK * KX, 256L * 1024, nullptr, nullptr, 0, 16};
            pg8::TileOrder S{NCHK / 256, 1, NG, G, G - 1 - bx, 0};
            EpiSsmE E{(float*)(ws + WS_E)};
            pg8::gemm_phase(lds, g, S, E);
        }
        __syncthreads();
        {
            unsigned* uctr = (unsigned*)(ws + WS_NRM) + 1024;
            LAS int* nxt = (LAS int*)(lds + 131072 + 256);
            for (;;) {
                if (tid == 0) *nxt = (int)atomicAdd(uctr, 1u);
                __syncthreads();
                const int uidx = *nxt;
                __syncthreads();
                if (uidx >= BATCH * NH * 32) break;
                const int bh = uidx & 63, qb = 31 - (uidx >> 6);
                att::attn_unit(bh >> 3, bh & 7, qb, ws, lds);
            }
        }
    }
    SEAM(2);

    if (IN(3)) {
        typedef float f32x2 __attribute__((ext_vector_type(2)));
        LAS f32x2* ex = (LAS f32x2*)lds;
        for (int idx = bx; idx < BATCH * NG; idx += G) {
            const int b = idx >> 5, g = idx & 31, pp = lane;
            const f32x2 L = ((const f32x2*)(ws + WS_LAM64))[g * 64 + pp];
            f32x2 L16 = L;
#pragma unroll
            for (int q = 0; q < 4; ++q) L16 = (f32x2){L16.x * L16.x - L16.y * L16.y, 2.f * L16.x * L16.y};
            const float* Eb = (const float*)(ws + WS_E) + ((size_t)(g * NCHK + b * 128 + 16 * wave) * 128 + 2 * pp);
            bf16_t* Ub = (bf16_t*)(ws + WS_U2) + ((size_t)(g * NCHK + b * 128 + 16 * wave) * KX + 2 * pp);
            f32x2 e[16];
#pragma unroll
            for (int j = 0; j < 16; ++j) e[j] = *(const f32x2*)(Eb + (size_t)j * 128);
            float sr = 0.f, si = 0.f;
#pragma unroll
            for (int j = 0; j < 16; ++j) { const float nr = L.x * sr - L.y * si + e[j].x, ni = L.x * si + L.y * sr + e[j].y; sr = nr; si = ni; }
            ex[wave * 64 + pp] = (f32x2){sr, si};
            __syncthreads();
            sr = 0.f; si = 0.f;
            for (int w = 0; w < wave; ++w) { const f32x2 en = ex[w * 64 + pp]; const float nr = L16.x * sr - L16.y * si + en.x, ni = L16.x * si + L16.y * sr + en.y; sr = nr; si = ni; }
#pragma unroll
            for (int j = 0; j < 16; ++j) {
                *(unsigned*)(Ub + (size_t)j * KX) = pk2(sr, si);
                const float nr = L.x * sr - L.y * si + e[j].x, ni = L.x * si + L.y * sr + e[j].y; sr = nr; si = ni;
            }
            __syncthreads();
        }
    }
    SEAM(3);

    if (IN(4)) {
        pg8::Gemm g{(const bf16_t*)(ws + WS_U2), (const bf16_t*)(ws + WS_TZ), KX, KX, KX, (long)NCHK * KX, 1024L * KX, nullptr, nullptr, 0, 16};
        pg8::SsmYOrder S{G, bx};
        EpiSsmY E{(bf16_t*)(ws + WS_YS)};
        pg8::gemm_phase(lds, g, S, E);
    }
    SEAM(4);

    if (IN(5)) {
        pg8::Gemm g{(const bf16_t*)(ws + WS_YS), (const bf16_t*)(ws + WS_WGLU), SW, 16, SW, 0, 0, nullptr, nullptr, 0, (long)MTOK * 16};
        pg8::TileOrder S{MTOK / 256, SW / 256, 1, G, bx, 1};
        EpiGlu E{(const bf16_t*)(ws + WS_YS), (const bf16_t*)(ws + WS_GS), p.b_glu, (bf16_t*)(ws + WS_YS2)};
        pg8::gemm_phase(lds, g, S, E);
    }
    SEAM(5);

    if (IN(6)) {
        pg8::Gemm g{(const bf16_t*)(ws + WS_YA), (const bf16_t*)(ws + WS_WA), 1024, 512, 512, 0, 0, (const bf16_t*)(ws + WS_YS2), (const bf16_t*)(ws + WS_WS), 8, 16};
        pg8::TileOrder S{MTOK / 256, DM / 256, 1, G, bx, 1};
        EpiMerge E{(const bf16_t*)(ws + WS_MIXA), (const bf16_t*)(ws + WS_MIXS), (bf16_t*)(ws + WS_MERGED)};
        pg8::gemm_phase(lds, g, S, E);
    }
    SEAM(6);

    if (IN(7)) {
        pg8::Gemm g{(const bf16_t*)(ws + WS_MERGED), (const bf16_t*)(ws + WS_WOUT), DM, DM, DM, 0, 0, nullptr, nullptr, 0, 16};
        pg8::TileOrder S{MTOK / 256, DM / 256, 1, G, bx, 1};
        EpiOut E{(bf16_t*)(ws + WS_PRE), (float*)(ws + WS_SUMSQ)};
        pg8::gemm_phase(lds, g, S, E);
    }

    SEAM(7);

    if (IN(8)) {
        const int gw = bx * 8 + wave, NGW = G * 8;
        f32x4 gn[4], ig[4]; bool gsmall = false;
#pragma unroll
        for (int j = 0; j < 4; ++j) { gn[j] = ((const f32x4*)p.norm_post)[lane + 64 * j]; const f32x4 g = ((const f32x4*)p.norm_pre)[lane + 64 * j];
#pragma unroll
            for (int e = 0; e < 4; ++e) { gsmall = gsmall || (fabsf(g[e]) < 1e-2f); ig[j][e] = 1.0f / g[e]; } }
        const bool use_x = __any(gsmall ? 1 : 0) != 0;
        for (int m = gw; m < MTOK; m += NGW) {
            const float rstd = 1.0f / sqrtf(((const float*)(ws + WS_SUMSQ))[m] * (1.f / DM) + 1e-6f);
            f32x4* orow = (f32x4*)(p.out + (size_t)m * DM) + lane;
            const unsigned long long* pr = (const unsigned long long*)((const bf16_t*)(ws + WS_PRE) + (size_t)m * DM) + lane;
            f32x4 xv[4]; unsigned long long pv8[4];
            if (!use_x) {
                const unsigned long long* hr = (const unsigned long long*)((const bf16_t*)(ws + WS_H) + (size_t)m * DM) + lane;
                const float inv = 1.0f / ((const float*)(ws + WS_RSTD))[m];
                unsigned long long h8[4];
#pragma unroll
                for (int j = 0; j < 4; ++j) { h8[j] = hr[64 * j]; pv8[j] = pr[64 * j]; }
#pragma unroll
                for (int j = 0; j < 4; ++j) { const unsigned lo32 = (unsigned)h8[j], hi32 = (unsigned)(h8[j] >> 32);
                    xv[j] = (f32x4){bf_lo(lo32), bf_hi(lo32), bf_lo(hi32), bf_hi(hi32)} * ig[j] * inv; }
            } else {
                const f32x4* xr = (const f32x4*)(p.x + (size_t)m * DM) + lane;
#pragma unroll
                for (int j = 0; j < 4; ++j) { xv[j] = xr[64 * j]; pv8[j] = pr[64 * j]; }
            }
#pragma unroll
            for (int j = 0; j < 4; ++j) { const unsigned lo32 = (unsigned)pv8[j], hi32 = (unsigned)(pv8[j] >> 32);
                const f32x4 pf = (f32x4){bf_lo(lo32), bf_hi(lo32), bf_lo(hi32), bf_hi(hi32)};
                orow[64 * j] = xv[j] + pf * rstd * gn[j]; }
        }
    }
#undef IN
#undef SEAM
}

extern "C" void kernel_launch(void* const* d_in, const int* in_sizes, int n_in, void* d_out, int out_size, void* d_ws, size_t ws_size, hipStream_t stream) {
    static int grid = 0;
    if (grid == 0) {
        if (n_in != 18 || out_size != MTOK * DM || ws_size < WS_END) { fprintf(stderr, "kernel_launch: unexpected shapes (n_in %d, out %d, ws %zu)\n", n_in, out_size, ws_size); grid = -1; return; }
        int dev = 0, cus = 0, per_cu = 0;
        hipGetDevice(&dev); hipDeviceGetAttribute(&cus, hipDeviceAttributeMultiprocessorCount, dev);
        if (hipFuncSetAttribute((const void*)fwd_megakernel, hipFuncAttributeMaxDynamicSharedMemorySize, LDS_BYTES) != hipSuccess) { fprintf(stderr, "kernel_launch: hipFuncSetAttribute failed\n"); grid = -1; return; }
        if (hipOccupancyMaxActiveBlocksPerMultiprocessor(&per_cu, (const void*)fwd_megakernel, 512, LDS_BYTES) != hipSuccess || per_cu < 1) { fprintf(stderr, "kernel_launch: occupancy query says %d\n", per_cu); per_cu = 1; }
        (void)hipGetLastError();
        grid = cus < 256 ? cus : 256;
    }
    if (grid < 0) return;
    Params p{};
    p.x = (const float*)d_in[0]; p.norm_pre = (const float*)d_in[1]; p.w_in = (const float*)d_in[2]; p.b_forget = (const float*)d_in[3];
    p.lam_re = (const float*)d_in[4]; p.lam_im = (const float*)d_in[5]; p.log_dt = (const float*)d_in[6]; p.b_re = (const float*)d_in[7]; p.b_im = (const float*)d_in[8];
    p.c_re = (const float*)d_in[9]; p.c_im = (const float*)d_in[10]; p.d_skip = (const float*)d_in[11]; p.w_glu = (const float*)d_in[12]; p.b_glu = (const float*)d_in[13];
    p.w_a = (const float*)d_in[14]; p.w_s = (const float*)d_in[15]; p.w_out = (const float*)d_in[16]; p.norm_post = (const float*)d_in[17];
    p.out = (float*)d_out; p.ws = (unsigned char*)d_ws;
#if MK_MULTI
    for (int ph = 0; ph < 9; ++ph) { p.ph_lo = ph; p.ph_hi = ph + 1; hipLaunchKernelGGL(fwd_megakernel, dim3(grid), dim3(512), LDS_BYTES, stream, p); }
#else
    p.ph_lo = 0; p.ph_hi = 9;
    void* args[] = {&p};
    hipError_t e = hipLaunchCooperativeKernel((const void*)fwd_megakernel, dim3(grid), dim3(512), args, LDS_BYTES, stream);
    if (e != hipSuccess) fprintf(stderr, "cooperative launch failed: %s (grid %d)\n", hipGetErrorString(e), grid);
#endif
}
```

```cpp
#include <hip/hip_runtime.h>
#include <hip/hip_cooperative_groups.h>
#include <hip/hip_bf16.h>
#include <cstdio>
#include <cstdint>
#include <cmath>
namespace cg = cooperative_groups;

#ifndef MK_MULTI
#define MK_MULTI 0
#endif

namespace pg8 {
#define PG8_LAS __attribute__((address_space(3)))
typedef unsigned short bf16_t;
typedef short bf16x8 __attribute__((ext_vector_type(8)));
typedef float f32x4 __attribute__((ext_vector_type(4)));
typedef unsigned u32x4 __attribute__((ext_vector_type(4)));
constexpr int BM = 256, BK = 64, HALF = 128, HTB = HALF * BK * 2, STAGE_BYTES = 8 * HTB, NXCD = 8, WGM = 8;

__host__ __device__ __forceinline__ int lds_byte(int r, int c) { const int st = (r >> 4) * 2 + (c >> 5), rr = r & 15, cc = c & 31, ob = rr * 64 + cc * 2; return st * 1024 + (ob ^ (((ob >> 9) & 1) << 5)); }
__host__ __device__ __forceinline__ void stage_rc(int b, int& R, int& C) { const int st = b / 1024, sb = b % 1024, swz = sb ^ (((sb >> 9) & 1) << 5); R = (st >> 1) * 16 + swz / 64; C = (st & 1) * 32 + (swz % 64) / 2; }
__host__ __device__ __forceinline__ int perm32(int rho) { const int n = rho >> 4, i = rho & 15; return 8 * (i >> 2) + 4 * n + (i & 3); }

struct Unit { int pm, pn, z; };
struct Gemm { const bf16_t* A; const bf16_t* Bt; int K, lda, ldb; long zsA, zsB; const bf16_t* A2; const bf16_t* Bt2; int ksplit; long cgA; };

__device__ __forceinline__ void swz_map(int L, int nM, int nN, int& pm, int& pn) {
    const int nwg = nM * nN; int wgid = L; { const int q = nwg / NXCD, r = nwg % NXCD, xcd = wgid % NXCD, off = wgid / NXCD; wgid = (xcd < r ? xcd * (q + 1) : r * (q + 1) + (xcd - r) * q) + off; }
    const int nig = WGM * nN, gid = wgid / nig, fm = gid * WGM, gsz = (nM - fm) < WGM ? (nM - fm) : WGM;
    pm = fm + ((wgid % nig) % gsz); pn = (wgid % nig) / gsz;
}
struct TileOrder {
    int nM, nN, nz, G, c, swz;
    __device__ __forceinline__ bool next(int i, Unit& u) const {
        const long L = (long)i * G + c; const int per = nM * nN; if (L >= (long)per * nz) return false;
        const int z = (int)(L / per), l = (int)(L % per); u.z = z;
        if (swz) swz_map(l, nM, nN, u.pm, u.pn); else { u.pm = l % nM; u.pn = l / nM; }
        return true;
    }
    __device__ __forceinline__ int nt(const Unit&, int K) const { return K / BK; }
};
struct SsmYOrder {
    int G, c;
    __device__ __forceinline__ bool next(int i, Unit& u) const {
        const long L = (long)i * G + c; if (L >= 32 * 16) return false;
        u.z = (int)(L >> 4); const int l = (int)(L & 15); u.pm = l & 3; u.pn = (i & 1) ? 3 - (l >> 2) : (l >> 2); return true;
    }
    __device__ __forceinline__ int nt(const Unit& u, int) const { return 6 + 4 * u.pn; }
};
struct PassOrder {
    int nM, nN, G, c;
    __device__ __forceinline__ bool next(int i, Unit& u) const {
        const long L = (long)(i >> 1) * G + c; if (L >= (long)nM * nN) return false;
        u.z = i & 1; swz_map((int)L, nM, nN, u.pm, u.pn); return true;
    }
    __device__ __forceinline__ int nt(const Unit&, int K) const { return K / BK; }
};

__device__ __forceinline__ unsigned cvt_pk_bf16(float lo, float hi) { unsigned r; asm volatile("v_cvt_pk_bf16_f32 %0, %1, %2" : "=v"(r) : "v"(lo), "v"(hi)); return r; }
__device__ __forceinline__ float bf_lo(unsigned w) { return __uint_as_float(w << 16); }
__device__ __forceinline__ float bf_hi(unsigned w) { return __uint_as_float(w & 0xffff0000u); }
__device__ __forceinline__ float sigm(float v) { return __builtin_amdgcn_rcpf(1.0f + __expf(-v)); }

template <class Epi, class Sched>
__device__ __forceinline__ void gemm_phase(PG8_LAS unsigned char* lds, const Gemm g, const Sched& S, const Epi& E) {
    const int tid = threadIdx.x, wid = __builtin_amdgcn_readfirstlane(tid >> 6), lane = tid & 63, wr = wid >> 2, wc = wid & 3, fr = lane & 15, fq = lane >> 4;
    unsigned voffA[2], voffB[2];
#pragma unroll
    for (int i = 0; i < 2; ++i) { int R, C; stage_rc(tid * 16 + i * 8192, R, C); const int Rb = (R & ~31) + perm32(R & 31);
        voffA[i] = (unsigned)(R * g.lda + (C & 15) + (long)(C >> 4) * g.cgA) * 2u; voffB[i] = (unsigned)(Rb * g.ldb + C) * 2u; }
    const size_t kstepA = (size_t)(4 * g.cgA * 2), kstepB = (size_t)(BK * 2);
    const size_t hstepA = (size_t)HALF * g.lda * 2, hstepB = (size_t)HALF * g.ldb * 2;
    const size_t tstepA = 2 * hstepA, tstepB = 2 * hstepB;
    const unsigned ldsw = (unsigned)wid * 1024u;
    const int aoff = lds_byte(wr * 64 + fr, fq * 8), boff = lds_byte(wc * 32 + fr, fq * 8);
#define PG8_SA(b, h) (((b) * 2 + (h)) * HTB)
#define PG8_SB(b, h) ((4 + (b) * 2 + (h)) * HTB)
#define PG8_STAGE(bufoff, gbase, voff) do { _Pragma("unroll") for (int _i = 0; _i < 2; ++_i) \
        __builtin_amdgcn_global_load_lds((const unsigned*)((const char*)(gbase) + (voff)[_i]), (PG8_LAS unsigned*)(lds + (bufoff) + ldsw + _i * 8192), 16, 0, 0); } while (0)
#define PG8_LDA(dst, b, h) do { _Pragma("unroll") for (int m = 0; m < 4; ++m) _Pragma("unroll") for (int k = 0; k < 2; ++k) dst[m][k] = *(const PG8_LAS bf16x8*)(lds + PG8_SA(b, h) + aoff + m * 2048 + k * 1024); } while (0)
#define PG8_LDB(dst, b, h) do { _Pragma("unroll") for (int n = 0; n < 2; ++n) _Pragma("unroll") for (int k = 0; k < 2; ++k) dst[n][k] = *(const PG8_LAS bf16x8*)(lds + PG8_SB(b, h) + boff + n * 2048 + k * 1024); } while (0)
#define PG8_MMA(ai, bj, At, Bt) do { __builtin_amdgcn_s_setprio(1); _Pragma("unroll") for (int m = 0; m < 4; ++m) _Pragma("unroll") for (int n = 0; n < 2; ++n) _Pragma("unroll") for (int k = 0; k < 2; ++k) \
        acc[ai][bj][m][n] = __builtin_amdgcn_mfma_f32_16x16x32_bf16(Bt[n][k], At[m][k], acc[ai][bj][m][n], 0, 0, 0); __builtin_amdgcn_s_setprio(0); } while (0)
#define PG8_WAIT_V(n) asm volatile("s_waitcnt vmcnt(" #n ")" ::: "memory")
#define PG8_WAIT_L(n) asm volatile("s_waitcnt lgkmcnt(" #n ")" ::: "memory")
#define PG8_BAR __builtin_amdgcn_s_barrier()
#define PG8_SCHED __builtin_amdgcn_sched_barrier(0)
    Unit cur, nxt; int ui = 0;
    if (!S.next(0, cur)) return;
    f32x4 acc[2][2][4][2];
#pragma unroll
    for (int a = 0; a < 2; ++a)
#pragma unroll
        for (int b = 0; b < 2; ++b)
#pragma unroll
            for (int m = 0; m < 4; ++m)
#pragma unroll
                for (int n = 0; n < 2; ++n) acc[a][b][m][n] = (f32x4){0.f, 0.f, 0.f, 0.f};
    bf16x8 At[4][2], B0[2][2], B1[2][2];
    const char* cA = (const char*)(g.A + (size_t)cur.z * g.zsA) + (size_t)cur.pm * tstepA; const char* cB = (const char*)(g.Bt + (size_t)cur.z * g.zsB) + (size_t)cur.pn * tstepB;
    PG8_STAGE(PG8_SB(0, 0), cB, voffB); PG8_STAGE(PG8_SB(0, 1), cB + hstepB, voffB); PG8_STAGE(PG8_SA(0, 0), cA, voffA); PG8_STAGE(PG8_SA(0, 1), cA + hstepA, voffA);
    if (wr == 1) PG8_BAR;
    PG8_WAIT_V(2); PG8_BAR;
    PG8_STAGE(PG8_SB(1, 0), cB + kstepB, voffB); PG8_STAGE(PG8_SA(1, 0), cA + kstepA, voffA); PG8_STAGE(PG8_SB(1, 1), cB + hstepB + kstepB, voffB);
    PG8_WAIT_V(6); PG8_BAR;
    for (;;) {
        const bool has_next = S.next(ui + 1, nxt);
        const int nt = S.nt(cur, g.K);
        const char* nA = has_next ? (const char*)(g.A + (size_t)nxt.z * g.zsA) + (size_t)nxt.pm * tstepA : cA; const char* nB = has_next ? (const char*)(g.Bt + (size_t)nxt.z * g.zsB) + (size_t)nxt.pn * tstepB : cB;
        const int ks = g.ksplit;
        const char* cA2 = ks ? (const char*)g.A2 + (size_t)cur.pm * tstepA - (size_t)ks * kstepA : cA; const char* cB2 = ks ? (const char*)g.Bt2 + (size_t)cur.pn * tstepB - (size_t)ks * kstepB : cB;
        for (int t = 0; t < nt; t += 2) {
            const bool last = (t == nt - 2);
            if constexpr (Epi::HAS_MID) { if (t == ks) E.mid(acc, cur, wr, wc, fr, fq); }
            const bool s1 = ks && (t + 1 >= ks), s2 = ks && (t + 2 >= ks);
            const char* a1 = (s1 ? cA2 : cA) + (size_t)(t + 1) * kstepA;
            const char* a2 = last ? nA : (s2 ? cA2 : cA) + (size_t)(t + 2) * kstepA; const char* b2 = last ? nB : (s2 ? cB2 : cB) + (size_t)(t + 2) * kstepB;
            const char* a3 = a2 + kstepA; const char* b3 = b2 + kstepB;
            PG8_LDB(B0, 0, 0); PG8_LDB(B1, 0, 1); PG8_SCHED; PG8_LDA(At, 0, 0); PG8_STAGE(PG8_SA(1, 1), a1 + hstepA, voffA);
            PG8_WAIT_V(8); PG8_WAIT_L(0); PG8_BAR; PG8_MMA(0, 0, At, B0); PG8_MMA(0, 1, At, B1); PG8_BAR; PG8_SCHED;
            PG8_LDA(At, 0, 1); PG8_STAGE(PG8_SB(0, 0), b2, voffB); PG8_STAGE(PG8_SB(0, 1), b2 + hstepB, voffB); PG8_STAGE(PG8_SA(0, 0), a2, voffA);
            PG8_WAIT_V(8); PG8_WAIT_L(0); PG8_BAR; PG8_MMA(1, 0, At, B0); PG8_MMA(1, 1, At, B1); PG8_BAR; PG8_SCHED;
            PG8_LDB(B0, 1, 0); PG8_LDB(B1, 1, 1); PG8_SCHED; PG8_LDA(At, 1, 0); PG8_STAGE(PG8_SA(0, 1), a2 + hstepA, voffA);
            PG8_WAIT_V(8); PG8_WAIT_L(0); PG8_BAR; PG8_MMA(0, 0, At, B0); PG8_MMA(0, 1, At, B1); PG8_BAR; PG8_SCHED;
            PG8_LDA(At, 1, 1); PG8_STAGE(PG8_SB(1, 0), b3, voffB); PG8_STAGE(PG8_SB(1, 1), b3 + hstepB, voffB); PG8_STAGE(PG8_SA(1, 0), a3, voffA);
            PG8_WAIT_V(8); PG8_WAIT_L(0); PG8_BAR; PG8_MMA(1, 0, At, B0); PG8_MMA(1, 1, At, B1); PG8_BAR; PG8_SCHED;
        }
        if (wr == 0) PG8_BAR;
        E(acc, cur, wr, wc, fr, fq);
        if (!has_next) break;
#pragma unroll
        for (int a = 0; a < 2; ++a)
#pragma unroll
            for (int b = 0; b < 2; ++b)
#pragma unroll
                for (int m = 0; m < 4; ++m)
#pragma unroll
                    for (int n = 0; n < 2; ++n) acc[a][b][m][n] = (f32x4){0.f, 0.f, 0.f, 0.f};
        cur = nxt; cA = nA; cB = nB; ++ui;
        if (wr == 1) PG8_BAR;
    }
    PG8_WAIT_V(0);
    PG8_BAR;
#undef PG8_SA
#undef PG8_SB
#undef PG8_STAGE
#undef PG8_LDA
#undef PG8_LDB
#undef PG8_MMA
#undef PG8_WAIT_V
#undef PG8_WAIT_L
#undef PG8_BAR
#undef PG8_SCHED
}
}

using pg8::bf16_t; using pg8::f32x4; using pg8::u32x4; using pg8::Unit; using pg8::cvt_pk_bf16; using pg8::bf_lo; using pg8::bf_hi; using pg8::sigm;
#define LAS __attribute__((address_space(3)))

constexpr int BATCH = 8, SEQ = 8192, DM = 1024, MTOK = BATCH * SEQ;
constexpr int NH = 8, HD = 64, AW = 512, SW = 512, NG = 32, GC = 16, NP = 64;
constexpr int INC = 5640;
constexpr int NPROJ = 5120;
constexpr int CH = 64, NCHK = MTOK / CH;
constexpr int KX = 1152;
constexpr float C2 = 0.125f * 1.4426950408889634f;
constexpr float LOG2E = 1.4426950408889634f;
constexpr float SKIP_LOG2 = 40.0f;

constexpr size_t MiB = 1u << 20;
constexpr size_t WS_SUMSQ = 0;
constexpr size_t WS_NRM = 512 * 1024;
constexpr size_t WS_LAM64 = 520 * 1024;
constexpr size_t WS_CNT = 576 * 1024;
constexpr size_t WS_BAR = 640 * 1024;
constexpr size_t WS_WIN = 1 * MiB;
constexpr size_t WS_WGLU = 11 * MiB;
constexpr size_t WS_WA = 12 * MiB;
constexpr size_t WS_WS = 13 * MiB;
constexpr size_t WS_WOUT = 14 * MiB;
constexpr size_t WS_LOGF = 16 * MiB;
constexpr size_t WS_CUM = 18 * MiB;
constexpr size_t WS_WEND = 20 * MiB;
constexpr size_t WS_E = 36 * MiB;
constexpr size_t WS_TZ = 52 * MiB;
constexpr size_t WS_U2 = 124 * MiB;
constexpr size_t WS_H = 196 * MiB;
constexpr size_t WS_RSTD = 704 * 1024;
constexpr size_t WS_Q = 324 * MiB, WS_K = 388 * MiB, WS_V = 452 * MiB, WS_GA = 516 * MiB, WS_GS = 580 * MiB;
constexpr size_t WS_MERGED = WS_Q;
constexpr size_t WS_MIXA = 644 * MiB, WS_MIXS = 772 * MiB;
constexpr size_t WS_PRE = WS_MIXA;
constexpr size_t WS_YA = 900 * MiB;
constexpr size_t WS_YS = WS_GA;
constexpr size_t WS_YS2 = WS_V;
constexpr size_t WS_END = 964 * MiB;

constexpr int LDS_BYTES = 147456;

struct Params {
    const float *x, *norm_pre, *w_in, *b_forget, *lam_re, *lam_im, *log_dt, *b_re, *b_im, *c_re, *c_im, *d_skip, *w_glu, *b_glu, *w_a, *w_s, *w_out, *norm_post;
    float* out; unsigned char* ws; int ph_lo, ph_hi;
};

#define EPI_LOOP_BEGIN \
    _Pragma("unroll") for (int ai = 0; ai < 2; ++ai) _Pragma("unroll") for (int m = 0; m < 4; ++m) { const int row = u.pm * 256 + ai * 128 + wr * 64 + m * 16 + fr; \
    _Pragma("unroll") for (int bj = 0; bj < 2; ++bj) { const int ct = bj * 128 + wc * 32 + 8 * fq; f32x4 v0 = acc[ai][bj][m][0], v1 = acc[ai][bj][m][1];
#define EPI_LOOP_END } }
__device__ __forceinline__ u32x4 pack8(f32x4 a, f32x4 b) { u32x4 w; w.x = cvt_pk_bf16(a[0], a[1]); w.y = cvt_pk_bf16(a[2], a[3]); w.z = cvt_pk_bf16(b[0], b[1]); w.w = cvt_pk_bf16(b[2], b[3]); return w; }
__device__ __forceinline__ void unpack8(u32x4 w, f32x4& a, f32x4& b) { a = (f32x4){bf_lo(w.x), bf_hi(w.x), bf_lo(w.y), bf_hi(w.y)}; b = (f32x4){bf_lo(w.z), bf_hi(w.z), bf_lo(w.w), bf_hi(w.w)}; }

struct EpiProj {
    static constexpr bool HAS_MID = false;
    unsigned char* ws;
    __device__ __forceinline__ void operator()(const f32x4 (&acc)[2][2][4][2], const Unit& u, int wr, int wc, int fr, int fq) const {
        const int pn = u.pn;
        int act = 0, pitch = 512, cb = (pn & 1) * 256; size_t off; float sc = 1.f;
        if (pn < 2) { off = WS_Q; sc = C2; } else if (pn < 4) off = WS_K; else if (pn < 6) off = WS_V; else if (pn < 8) { off = WS_GA; act = 1; }
        else if (pn < 10) { off = WS_U2; act = 3; } else if (pn < 12) { off = WS_GS; act = 1; }
        else {
            bf16_t* RA = (bf16_t*)(ws + WS_MIXA); bf16_t* SS = (bf16_t*)(ws + WS_MIXS);
#pragma unroll
            for (int ai = 0; ai < 2; ++ai)
#pragma unroll
                for (int m = 0; m < 4; ++m) { const int row = u.pm * 256 + ai * 128 + wr * 64 + m * 16 + fr; const size_t o = (size_t)row * DM + (pn - 12) * 128 + wc * 32 + 8 * fq;
                    f32x4 r0, r1, s0, s1;
#pragma unroll
                    for (int e = 0; e < 4; ++e) {
                        const float ea0 = __expf(-fmaxf(acc[ai][0][m][0][e], -30.f)), ea1 = __expf(-fmaxf(acc[ai][0][m][1][e], -30.f));
                        const float es0 = __expf(-fmaxf(acc[ai][1][m][0][e], -30.f)), es1 = __expf(-fmaxf(acc[ai][1][m][1][e], -30.f));
                        r0[e] = (1.f + es0) * __builtin_amdgcn_rcpf(1.f + ea0); r1[e] = (1.f + es1) * __builtin_amdgcn_rcpf(1.f + ea1);
                        s0[e] = __builtin_amdgcn_rcpf(1.f + es0); s1[e] = __builtin_amdgcn_rcpf(1.f + es1); }
                    *(u32x4*)(RA + o) = pack8(r0, r1); *(u32x4*)(SS + o) = pack8(s0, s1); }
            return;
        }
        bf16_t* base = (bf16_t*)(ws + off);
        float mx0 = 0.f, mx1 = 0.f;
        EPI_LOOP_BEGIN
            v0 = v0 * sc; v1 = v1 * sc;
            if (act == 1) {
#pragma unroll
                for (int e = 0; e < 4; ++e) { v0[e] = v0[e] * sigm(v0[e]); v1[e] = v1[e] * sigm(v1[e]); }
            } else if (act == 2) {
#pragma unroll
                for (int e = 0; e < 4; ++e) { v0[e] = sigm(fmaxf(v0[e], -30.f)); v1[e] = sigm(fmaxf(v1[e], -30.f)); }
            }
            const u32x4 w = pack8(v0, v1);
            if (act == 3) { const int cu = cb + ct, gg = cu >> 4, c0 = cu & 15; *(u32x4*)(base + ((size_t)(gg * NCHK + (row >> 6)) * KX + 128 + (row & 63) * 16 + c0)) = w; }
            else *(u32x4*)(base + (size_t)row * pitch + cb + ct) = w;
            if (pn < 4) {
                float s = (v0[0] * v0[0] + v0[1] * v0[1]) + (v0[2] * v0[2] + v0[3] * v0[3]) + (v1[0] * v1[0] + v1[1] * v1[1]) + (v1[2] * v1[2] + v1[3] * v1[3]);
                s += __shfl_xor(s, 16); s += __shfl_xor(s, 32);
                if (bj == 0) mx0 = fmaxf(mx0, s); else mx1 = fmaxf(mx1, s);
            }
        EPI_LOOP_END
        if (pn < 4) {
#pragma unroll
            for (int o = 1; o < 16; o <<= 1) { mx0 = fmaxf(mx0, __shfl_xor(mx0, o)); mx1 = fmaxf(mx1, __shfl_xor(mx1, o)); }
            if ((threadIdx.x & 63) == 0) {
                unsigned* nrm = (unsigned*)(ws + WS_NRM); const int b = u.pm >> 5, which = (pn >> 1) * 2 + (wc & 1);
                const int h0 = (pn & 1) * 4 + (wc >> 1), h1 = h0 + 2;
                atomicMax(nrm + (b * 8 + h0) * 4 + which, __float_as_uint(mx0 * 1.02f));
                atomicMax(nrm + (b * 8 + h1) * 4 + which, __float_as_uint(mx1 * 1.02f));
            }
        }
    }
};
struct EpiSsmE {
    static constexpr bool HAS_MID = false;
    float* E;
    __device__ __forceinline__ void operator()(const f32x4 (&acc)[2][2][4][2], const Unit& u, int wr, int wc, int fr, int fq) const {
        EPI_LOOP_BEGIN
            if (bj == 0) { float* p = E + ((size_t)(u.z * NCHK + row) * 128 + ct); *(f32x4*)p = v0; *(f32x4*)(p + 4) = v1; }
        EPI_LOOP_END
    }
};
__device__ __forceinline__ float gelu_t(float x) { const float y = 0.7978845608028654f * (x + 0.044715f * x * x * x); return x * sigm(2.0f * y); }
struct EpiSsmY {
    static constexpr bool HAS_MID = false;
    bf16_t* YS;
    __device__ __forceinline__ void operator()(const f32x4 (&acc)[2][2][4][2], const Unit& u, int wr, int wc, int fr, int fq) const {
        EPI_LOOP_BEGIN
#pragma unroll
            for (int e = 0; e < 4; ++e) { v0[e] = gelu_t(v0[e]); v1[e] = gelu_t(v1[e]); }
            const int j = u.pn * 256 + ct, t = j >> 4, c0 = j & 15;
            *(u32x4*)(YS + (((size_t)u.z * MTOK + row * CH + t) * 16 + c0)) = pack8(v0, v1);
        EPI_LOOP_END
    }
};
struct EpiGlu {
    static constexpr bool HAS_MID = false;
    const bf16_t* YS; const bf16_t* GS; const float* bias; bf16_t* O;
    __device__ __forceinline__ void operator()(const f32x4 (&acc)[2][2][4][2], const Unit& u, int wr, int wc, int fr, int fq) const {
        EPI_LOOP_BEGIN
            const int col = u.pn * 256 + ct; const size_t o = (size_t)row * SW + col;
            const f32x4 b0 = *(const f32x4*)(bias + col), b1 = *(const f32x4*)(bias + col + 4);
            f32x4 y0, y1, g0, g1; unpack8(*(const u32x4*)(YS + (((size_t)(col >> 4) * MTOK + row) * 16 + (col & 15))), y0, y1); unpack8(*(const u32x4*)(GS + o), g0, g1);
#pragma unroll
            for (int e = 0; e < 4; ++e) { v0[e] = y0[e] * sigm(v0[e] + b0[e]) * g0[e]; v1[e] = y1[e] * sigm(v1[e] + b1[e]) * g1[e]; }
            *(u32x4*)(O + o) = pack8(v0, v1);
        EPI_LOOP_END
    }
};
struct EpiMerge {
    static constexpr bool HAS_MID = true;
    const bf16_t* MA; const bf16_t* MS; bf16_t* O;
    __device__ __forceinline__ void mid(f32x4 (&acc)[2][2][4][2], const Unit& u, int wr, int wc, int fr, int fq) const {
        __builtin_amdgcn_sched_barrier(0);
        unsigned o0 = (unsigned)((u.pm * 256 + wr * 64 + fr) * DM + u.pn * 256 + wc * 32 + 8 * fq);
        asm volatile("" : "+v"(o0));
#pragma unroll
        for (int ai = 0; ai < 2; ++ai) { u32x4 rr[2][4];
#pragma unroll
            for (int bj = 0; bj < 2; ++bj)
#pragma unroll
                for (int m = 0; m < 4; ++m) rr[bj][m] = *(const u32x4*)(MA + (o0 + (unsigned)((ai * 128 + m * 16) * DM + bj * 128)));
#pragma unroll
            for (int bj = 0; bj < 2; ++bj)
#pragma unroll
                for (int m = 0; m < 4; ++m) { f32x4 a0, a1; unpack8(rr[bj][m], a0, a1); acc[ai][bj][m][0] *= a0; acc[ai][bj][m][1] *= a1; }
            __builtin_amdgcn_sched_barrier(0); }
    }
    __device__ __forceinline__ void operator()(const f32x4 (&acc)[2][2][4][2], const Unit& u, int wr, int wc, int fr, int fq) const {
        unsigned o0 = (unsigned)((u.pm * 256 + wr * 64 + fr) * DM + u.pn * 256 + wc * 32 + 8 * fq);
#pragma unroll
        for (int ai = 0; ai < 2; ++ai) { u32x4 gg[2][4];
#pragma unroll
            for (int bj = 0; bj < 2; ++bj)
#pragma unroll
                for (int m = 0; m < 4; ++m) gg[bj][m] = *(const u32x4*)(MS + (o0 + (unsigned)((ai * 128 + m * 16) * DM + bj * 128)));
#pragma unroll
            for (int bj = 0; bj < 2; ++bj)
#pragma unroll
                for (int m = 0; m < 4; ++m) { f32x4 s0, s1; unpack8(gg[bj][m], s0, s1);
                    *(u32x4*)(O + (o0 + (unsigned)((ai * 128 + m * 16) * DM + bj * 128))) = pack8(acc[ai][bj][m][0] * s0, acc[ai][bj][m][1] * s1); }
            __builtin_amdgcn_sched_barrier(0); }
    }
};
struct EpiOut {
    static constexpr bool HAS_MID = false;
    bf16_t* pre; float* sumsq;
    __device__ __forceinline__ void operator()(const f32x4 (&acc)[2][2][4][2], const Unit& u, int wr, int wc, int fr, int fq) const {
#pragma unroll
        for (int ai = 0; ai < 2; ++ai)
#pragma unroll
            for (int m = 0; m < 4; ++m) { const int row = u.pm * 256 + ai * 128 + wr * 64 + m * 16 + fr; float s = 0.f;
#pragma unroll
                for (int bj = 0; bj < 2; ++bj) { const f32x4 v0 = acc[ai][bj][m][0], v1 = acc[ai][bj][m][1];
                    *(u32x4*)(pre + (size_t)row * DM + u.pn * 256 + bj * 128 + wc * 32 + 8 * fq) = pack8(v0, v1);
                    s += (v0[0] * v0[0] + v0[1] * v0[1]) + (v0[2] * v0[2] + v0[3] * v0[3]) + (v1[0] * v1[0] + v1[1] * v1[1]) + (v1[2] * v1[2] + v1[3] * v1[3]); }
                s += __shfl_xor(s, 16); s += __shfl_xor(s, 32);
                if (fq == 0) atomicAdd(sumsq + row, s); }
    }
};

namespace att {
typedef short bf16x8 __attribute__((ext_vector_type(8)));
typedef short s16x4 __attribute__((ext_vector_type(4)));
typedef float f32x16 __attribute__((ext_vector_type(16)));
constexpr int SLOTB = 8192;
constexpr int L_K = 0, L_V = 2 * SLOTB, L_B = 5 * SLOTB, L_WS = L_B + 512,
                         L_CNT = L_WS + 2048, L_OST = L_CNT + 128;
static_assert(L_OST + 8 * 8192 <= 131072, "attention LDS");
__device__ __forceinline__ int crow(int r, int hi) { return (r & 3) + 8 * (r >> 2) + 4 * hi; }
typedef float f32x2_t __attribute__((ext_vector_type(2))); typedef __bf16 bf16x2_t __attribute__((ext_vector_type(2)));
__device__ __forceinline__ unsigned cvtpk_s(float lo, float hi) { f32x2_t v = {lo, hi}; bf16x2_t b = __builtin_convertvector(v, bf16x2_t); return __builtin_bit_cast(unsigned, b); }
__device__ __forceinline__ float rowmax(const f32x16& p0, const f32x16& p1) {
    float a = fmaxf(p0[0], p1[0]);
#pragma unroll
    for (int r = 1; r < 16; ++r) a = fmaxf(a, fmaxf(p0[r], p1[r]));
    auto rr = __builtin_amdgcn_permlane32_swap(__float_as_uint(a), __float_as_uint(a), false, false);
    return fmaxf(__uint_as_float(rr[0]), __uint_as_float(rr[1]));
}
__device__ __forceinline__ void pv(f32x16* o, int vb, bf16x8 pa0, bf16x8 pa1, bf16x8 pa2, bf16x8 pa3) {
#pragma unroll
    for (int d0 = 0; d0 < 2; ++d0) { s16x4 lo[4], hi[4];
#pragma unroll
        for (int ks = 0; ks < 4; ++ks) {
            asm volatile("ds_read_b64_tr_b16 %0,%1 offset:%c2" : "=&v"(lo[ks]) : "v"(vb), "i"(d0 * 4096 + ks * 1024) : "memory");
            asm volatile("ds_read_b64_tr_b16 %0,%1 offset:%c2" : "=&v"(hi[ks]) : "v"(vb), "i"(d0 * 4096 + ks * 1024 + 512) : "memory"); }
        asm volatile("s_waitcnt lgkmcnt(0)" ::: "memory"); __builtin_amdgcn_sched_barrier(0);
#define PK(k) (bf16x8){lo[k][0], lo[k][1], lo[k][2], lo[k][3], hi[k][0], hi[k][1], hi[k][2], hi[k][3]}
        o[d0] = __builtin_amdgcn_mfma_f32_32x32x16_bf16(pa0, PK(0), o[d0], 0, 0, 0);
        o[d0] = __builtin_amdgcn_mfma_f32_32x32x16_bf16(pa1, PK(1), o[d0], 0, 0, 0);
        o[d0] = __builtin_amdgcn_mfma_f32_32x32x16_bf16(pa2, PK(2), o[d0], 0, 0, 0);
        o[d0] = __builtin_amdgcn_mfma_f32_32x32x16_bf16(pa3, PK(3), o[d0], 0, 0, 0);
#undef PK
    }
}
__device__ __forceinline__ void attn_unit(int b, int h, int qb, unsigned char* ws, LAS unsigned char* shm) {
    const int tid = threadIdx.x, lane = tid & 63, r32 = lane & 31, hi = lane >> 5; const int wid = __builtin_amdgcn_readfirstlane(tid >> 6);
    const long rowbase = (long)b * SEQ; const int q0 = qb * 256;
    const bf16_t* Qw = (const bf16_t*)(ws + WS_Q) + (rowbase + q0 + wid * 32) * AW + h * HD;
    const bf16_t* Kh = (const bf16_t*)(ws + WS_K) + rowbase * AW + h * HD; const bf16_t* Vh = (const bf16_t*)(ws + WS_V) + rowbase * AW + h * HD;
    const float* cum = (const float*)(ws + WS_CUM) + (size_t)(b * NH + h) * SEQ;
    const unsigned lds0 = (unsigned)(uintptr_t)shm;
    LAS float* wsf = (LAS float*)(shm + L_WS) + wid * 64;
    LAS int* cnt = (LAS int*)(shm + L_CNT);
    const float cref = cum[q0];
    const unsigned* nr = (const unsigned*)(ws + WS_NRM) + (b * NH + h) * 4;
    const float qn2 = __uint_as_float(nr[0]) + __uint_as_float(nr[1]), kn2 = __uint_as_float(nr[2]) + __uint_as_float(nr[3]);
    const float X = SKIP_LOG2 + 2.0f * (sqrtf(qn2 * kn2) * 1.01f + 0.01f);
    const float Sb = sqrtf(qn2 * kn2) * 1.01f + 0.01f;
    float bend = 0.f; if (tid < 4 * qb) bend = cref - cum[64 * tid + 63];
    int pred = (tid < 4 * qb && bend < -X) ? 1 : 0;
    { const unsigned long long bal = __ballot(pred); if (lane == 0) cnt[wid] = __popcll(bal); }
    __syncthreads();
    int tile_lo = 0;
#pragma unroll
    for (int w = 0; w < 8; ++w) tile_lo += cnt[w];
    const int NT = 4 * qb + 4;
    bf16x8 qr[4];
#pragma unroll
    for (int d0 = 0; d0 < 4; ++d0) qr[d0] = *(const bf16x8*)(Qw + (long)r32 * AW + d0 * 16 + hi * 8);
    const bf16_t* ksrc = Kh + (long)lane * AW + wid * 8;
    const bf16_t* vsrc = Vh + (long)(16 * (wid & 3) + (lane >> 2)) * AW + (wid >> 2) * 32 + (lane & 3) * 8;
    const int koff = wid * 1024 + lane * 16;
    const int vb0 = (int)(lds0 + L_V) + ((lane >> 4) & 1) * 32 + (lane & 3) * 8 + (4 * hi + ((lane & 15) >> 2)) * 64;
    int t = NT - 1;
    u32x4 kA = *(const u32x4*)(ksrc + (long)t * 64 * AW), vA = *(const u32x4*)(vsrc + (long)t * 64 * AW);
    float bA = (tid < 64) ? (cref - cum[64 * t + tid]) : 0.f;
    u32x4 kB = kA, vB = vA; float bB = 0.f;
    if (t - 1 >= tile_lo) { kB = *(const u32x4*)(ksrc + (long)(t - 1) * 64 * AW); vB = *(const u32x4*)(vsrc + (long)(t - 1) * 64 * AW); bB = (tid < 64) ? (cref - cum[64 * (t - 1) + tid]) : 0.f; }
    float mhat = -1e30f, l_reg = 0.f; f32x16 o[2]; o[0] = f32x16{}; o[1] = f32x16{};
    const int qrel = wid * 32 + r32;
    int cur = 0, vcur = 0, vprev = 2;
    u32x4 pw0 = (u32x4){0u, 0u, 0u, 0u}, pw1 = pw0, pw2 = pw0, pw3 = pw0;
#define ATT_STEP(KR, VR, BR) do { \
        *(LAS u32x4*)(shm + L_K + cur * SLOTB + koff) = KR; *(LAS u32x4*)(shm + L_V + vcur * SLOTB + koff) = VR; \
        if (tid < 64) *(LAS float*)(shm + L_B + cur * 256 + tid * 4) = BR; \
        asm volatile("s_waitcnt lgkmcnt(0)\n\ts_barrier" ::: "memory");     \
        if (t - 2 >= tile_lo) { KR = *(const u32x4*)(ksrc + (long)(t - 2) * 64 * AW); VR = *(const u32x4*)(vsrc + (long)(t - 2) * 64 * AW); BR = (tid < 64) ? (cref - cum[64 * (t - 2) + tid]) : 0.f; } \
        att_tile(); \
    } while (0)
    auto att_tile = [&]() __attribute__((always_inline)) {
        const int jb = t - (NT - 4);
        if (jb <= (wid >> 1)) {
            f32x16 p0, p1;
            { const LAS float* bb = (const LAS float*)(shm + L_B + cur * 256);
#pragma unroll
              for (int g4 = 0; g4 < 4; ++g4) { const f32x4 a = *(const LAS f32x4*)(bb + 8 * g4 + 4 * hi), c = *(const LAS f32x4*)(bb + 32 + 8 * g4 + 4 * hi);
#pragma unroll
                  for (int e = 0; e < 4; ++e) { p0[4 * g4 + e] = a[e]; p1[4 * g4 + e] = c[e]; } } }
            { const LAS unsigned char* kb = shm + L_K + cur * SLOTB + hi * 1024 + r32 * 16;
              __builtin_amdgcn_s_setprio(1);
#pragma unroll
              for (int d0 = 0; d0 < 4; ++d0) { const bf16x8 b0 = *(const LAS bf16x8*)(kb + d0 * 2048), b1 = *(const LAS bf16x8*)(kb + d0 * 2048 + 512);
                  p0 = __builtin_amdgcn_mfma_f32_32x32x16_bf16(b0, qr[d0], p0, 0, 0, 0); p1 = __builtin_amdgcn_mfma_f32_32x32x16_bf16(b1, qr[d0], p1, 0, 0, 0); } }
            pv(o, vb0 + vprev * SLOTB, __builtin_bit_cast(bf16x8, pw0), __builtin_bit_cast(bf16x8, pw1), __builtin_bit_cast(bf16x8, pw2), __builtin_bit_cast(bf16x8, pw3));
            __builtin_amdgcn_s_setprio(0);
            if (jb >= 0) { const int kb0 = 64 * jb + 4 * hi;
#pragma unroll
                for (int r = 0; r < 16; ++r) { const int kv = kb0 + (r & 3) + 8 * (r >> 2); if (kv > qrel) p0[r] = -INFINITY; if (kv + 32 > qrel) p1[r] = -INFINITY; } }
            const float rm = rowmax(p0, p1);
            const float mnew = fmaxf(mhat, rm);
            if (__any(mnew > mhat)) {
                const float alpha = __builtin_amdgcn_exp2f(mhat - mnew); l_reg *= alpha; mhat = mnew;
                if (hi == 0) wsf[r32] = alpha;
                asm volatile("s_waitcnt lgkmcnt(0)" ::: "memory");
#pragma unroll
                for (int r = 0; r < 16; ++r) { const float f = wsf[crow(r, hi)]; o[0][r] *= f; o[1][r] *= f; }
            }
            float sacc = 0.f;
#pragma unroll
            for (int r = 0; r < 16; ++r) { p0[r] = __builtin_amdgcn_exp2f(p0[r] - mhat); p1[r] = __builtin_amdgcn_exp2f(p1[r] - mhat); sacc += p0[r] + p1[r]; }
            l_reg += sacc;
            pw0 = (u32x4){cvtpk_s(p0[0], p0[1]), cvtpk_s(p0[2], p0[3]), cvtpk_s(p0[4], p0[5]), cvtpk_s(p0[6], p0[7])};
            pw1 = (u32x4){cvtpk_s(p0[8], p0[9]), cvtpk_s(p0[10], p0[11]), cvtpk_s(p0[12], p0[13]), cvtpk_s(p0[14], p0[15])};
            pw2 = (u32x4){cvtpk_s(p1[0], p1[1]), cvtpk_s(p1[2], p1[3]), cvtpk_s(p1[4], p1[5]), cvtpk_s(p1[6], p1[7])};
            pw3 = (u32x4){cvtpk_s(p1[8], p1[9]), cvtpk_s(p1[10], p1[11]), cvtpk_s(p1[12], p1[13]), cvtpk_s(p1[14], p1[15])};
        }
        cur ^= 1; vprev = vcur; vcur = (vcur == 2) ? 0 : vcur + 1;
        if (jb == 0 && tile_lo < NT - 4) {
            float mm = mhat;
#pragma unroll
            for (int o2 = 1; o2 < 64; o2 <<= 1) mm = fminf(mm, __shfl_xor(mm, o2));
            LAS float* mw = (LAS float*)(shm + L_CNT) + 8;
            if (lane == 0) mw[wid] = mm;
            __syncthreads();
            float mmin = mw[0];
#pragma unroll
            for (int w = 1; w < 8; ++w) mmin = fminf(mmin, mw[w]);
            const float X2 = SKIP_LOG2 + Sb - mmin;
            const int pred2 = (tid < 4 * qb && bend < -X2) ? 1 : 0;
            { const unsigned long long bal = __ballot(pred2); if (lane == 0) cnt[wid] = __popcll(bal); }
            __syncthreads();
            int tl2 = 0;
#pragma unroll
            for (int w = 0; w < 8; ++w) tl2 += cnt[w];
            tile_lo = tl2 > tile_lo ? tl2 : tile_lo;
        }
    };
    for (;;) {
        ATT_STEP(kA, vA, bA); --t; if (t < tile_lo) break;
        ATT_STEP(kB, vB, bB); --t; if (t < tile_lo) break;
    }
#undef ATT_STEP
    pv(o, vb0 + vprev * SLOTB, __builtin_bit_cast(bf16x8, pw0), __builtin_bit_cast(bf16x8, pw1), __builtin_bit_cast(bf16x8, pw2), __builtin_bit_cast(bf16x8, pw3));
    { auto rr = __builtin_amdgcn_permlane32_swap(__float_as_uint(l_reg), __float_as_uint(l_reg), false, false); l_reg = __uint_as_float(rr[0]) + __uint_as_float(rr[1]); }
    if (hi == 0) wsf[32 + r32] = l_reg;
    asm volatile("s_waitcnt lgkmcnt(0)" ::: "memory");
    LAS float* stg = (LAS float*)(shm + L_OST) + wid * 2048;
#pragma unroll
    for (int r = 0; r < 16; ++r) { const int orow = crow(r, hi); const float rl = __builtin_amdgcn_rcpf(wsf[32 + orow]);
        stg[orow * 64 + r32] = o[0][r] * rl; stg[orow * 64 + 32 + r32] = o[1][r] * rl; }
    asm volatile("s_waitcnt lgkmcnt(0)" ::: "memory");
    const bf16_t* GAw = (const bf16_t*)(ws + WS_GA) + (rowbase + q0 + wid * 32) * AW + h * HD;
    bf16_t* Ow = (bf16_t*)(ws + WS_YA) + (rowbase + q0 + wid * 32) * AW + h * HD;
#pragma unroll
    for (int i = 0; i < 4; ++i) { const int row = i * 8 + (lane >> 3), ch = lane & 7;
        f32x4 a = *(const LAS f32x4*)(stg + row * 64 + ch * 8), c = *(const LAS f32x4*)(stg + row * 64 + ch * 8 + 4);
        f32x4 g0, g1; unpack8(*(const u32x4*)(GAw + (long)row * AW + ch * 8), g0, g1);
        *(u32x4*)(Ow + (long)row * AW + ch * 8) = pack8(a * g0, c * g1); }
    __syncthreads();
}
}

__device__ __forceinline__ unsigned f2bf(float f) { unsigned u = __builtin_bit_cast(unsigned, f); return (u + 0x7fffu + ((u >> 16) & 1u)) >> 16; }
__device__ __forceinline__ unsigned pk2(float lo, float hi) { return f2bf(lo) | (f2bf(hi) << 16); }
__device__ __forceinline__ float wave_sum(float v) {
#pragma unroll
    for (int o = 1; o < 64; o <<= 1) v += __shfl_xor(v, o);
    return v;
}
__device__ __forceinline__ void transpose_item(const float* W, int K, int ldw, int N, int col_shift_from, bf16_t* WT, LAS float* scr, int item, int lane) {
    const int nblk = N / 32, kb = item / nblk, nb = item % nblk, k0 = 64 * kb, n0 = 32 * nb;
    int sc0 = n0;
    if (col_shift_from >= 0) { if (n0 >= 3072) { const int T = (n0 - 3072) >> 8, j = (n0 - 3072) & 255; sc0 = (j < 128) ? 3080 + T * 128 + j : 4104 + T * 128 + (j - 128); } else if (n0 >= 1536) sc0 = n0 + 8; }
#pragma unroll 8
    for (int i = 0; i < 32; ++i) { const int kk = 2 * i + (lane >> 5); scr[kk * 33 + (lane & 31)] = W[(size_t)(k0 + kk) * ldw + sc0 + (lane & 31)]; }
    asm volatile("s_waitcnt lgkmcnt(0)" ::: "memory");
    const int c = lane & 7;
#pragma unroll
    for (int j = 0; j < 4; ++j) { const int n = (lane >> 3) + 8 * j; const LAS float* s = scr + (8 * c) * 33 + n;
        u32x4 o; o.x = pk2(s[0 * 33], s[1 * 33]); o.y = pk2(s[2 * 33], s[3 * 33]); o.z = pk2(s[4 * 33], s[5 * 33]); o.w = pk2(s[6 * 33], s[7 * 33]);
        *(u32x4*)(WT + (size_t)(n0 + n) * K + k0 + 8 * c) = o; }
    asm volatile("s_waitcnt lgkmcnt(0)" ::: "memory");
}
__device__ __forceinline__ void sincos_d(double x, double& s, double& c) {
    const double k = rint(x * 0.63661977236758134308);
    const double r = (x - k * 1.57079632679489655800) - k * 6.123233995736766035869e-17;
    const double r2 = r * r;
    const double sp = r * (1.0 + r2 * (-1.0 / 6 + r2 * (1.0 / 120 + r2 * (-1.0 / 5040 + r2 * (1.0 / 362880 + r2 * (-1.0 / 39916800 + r2 * (1.0 / 6227020800.0)))))));
    const double cp = 1.0 + r2 * (-0.5 + r2 * (1.0 / 24 + r2 * (-1.0 / 720 + r2 * (1.0 / 40320 + r2 * (-1.0 / 3628800 + r2 * (1.0 / 479001600.0 + r2 * (-1.0 / 87178291200.0)))))));
    const int q = ((int)k) & 3;
    s = (q == 0) ? sp : (q == 1) ? cp : (q == 2) ? -sp : -cp;
    c = (q == 0) ? cp : (q == 1) ? -sp : (q == 2) ? -cp : sp;
}
__device__ __forceinline__ double exp_d(double x) {
    const double n = rint(x * 1.44269504088896340736);
    const double r = (x - n * 0.693147180369123816490) - n * 1.90821492927058770002e-10;
    double p = 1.0 / 6227020800.0;
    p = p * r + 1.0 / 479001600.0; p = p * r + 1.0 / 39916800.0; p = p * r + 1.0 / 3628800.0; p = p * r + 1.0 / 362880.0; p = p * r + 1.0 / 40320.0;
    p = p * r + 1.0 / 5040.0; p = p * r + 1.0 / 720.0; p = p * r + 1.0 / 120.0; p = p * r + 1.0 / 24.0; p = p * r + 1.0 / 6.0; p = p * r + 0.5; p = p * r + 1.0; p = p * r + 1.0;
    const long long bits = ((long long)((int)n + 1023)) << 52;
    return p * __builtin_bit_cast(double, bits);
}

__device__ __forceinline__ void ssm_ops_item(const Params& p, int g, int c, LAS unsigned char* lds) {
    typedef float f32x2 __attribute__((ext_vector_type(2)));
    LAS f32x2* P = (LAS f32x2*)lds;
    LAS f32x2* Bb = (LAS f32x2*)(lds + 33280);
    LAS f32x2* Cc = (LAS f32x2*)(lds + 41472);
    LAS float* Km = (LAS float*)(lds + 41984);
    const int tid = threadIdx.x;
    if (tid < 64) {
        const int pp = tid;
        const double dt = exp_d((double)p.log_dt[g]); const double lr = (double)p.lam_re[g * 64 + pp], li = (double)p.lam_im[g * 64 + pp];
        const double mag = exp_d(lr * dt); double sn, cs; sincos_d(li * dt, sn, cs);
        const double abr = mag * cs, abi = mag * sn, den = lr * lr + li * li, nre = abr - 1.0;
        const double fre = (nre * lr + abi * li) / den, fim = (abi * lr - nre * li) / den;
        double pr = 1.0, pi = 0.0;
        for (int j = 0; j <= 64; ++j) { P[j * 64 + pp] = (f32x2){(float)pr, (float)pi}; const double nr = pr * abr - pi * abi, ni = pr * abi + pi * abr; pr = nr; pi = ni; }
        if (c == 0) ((f32x2*)(p.ws + WS_LAM64))[g * 64 + pp] = P[64 * 64 + pp];
        for (int q = 0; q < 16; ++q) { const double br = (double)p.b_re[(g * 64 + pp) * 16 + q], bi = (double)p.b_im[(g * 64 + pp) * 16 + q];
            Bb[pp * 16 + q] = (f32x2){(float)(fre * br - fim * bi), (float)(fre * bi + fim * br)}; }
        Cc[pp] = (f32x2){p.c_re[(g * 16 + c) * 64 + pp], p.c_im[(g * 16 + c) * 64 + pp]};
    }
    __syncthreads();
    {
        const int j = tid >> 3, q0 = (tid & 7) * 2;
        float k0 = 0.f, k1 = 0.f;
        for (int pp = 0; pp < 64; ++pp) {
            const f32x2 cc = Cc[pp], gg = P[j * 64 + pp], b0 = Bb[pp * 16 + q0], b1 = Bb[pp * 16 + q0 + 1];
            const float clr = cc.x * gg.x - cc.y * gg.y, cli = cc.x * gg.y + cc.y * gg.x;
            k0 += clr * b0.x - cli * b0.y; k1 += clr * b1.x - cli * b1.y;
        }
        if (j == 0) { const float d = p.d_skip[g * 16 + c]; if (q0 == c) k0 += d; if (q0 + 1 == c) k1 += d; }
        Km[j * 16 + q0] = k0; Km[j * 16 + q0 + 1] = k1;
    }
    __syncthreads();
    {
        bf16_t* TZ = (bf16_t*)(p.ws + WS_TZ) + (size_t)g * 1024 * KX;
        for (int idx = tid; idx < 64 * 144; idx += 512) {
            const int t = idx / 144, i = idx % 144, col = 8 * i;
            float v[8];
            if (col >= 128) { const int s = (col - 128) >> 4, chh = (col >> 3) & 1;
                if (s <= t) { const LAS float* k = Km + (t - s) * 16 + chh * 8;
#pragma unroll
                    for (int e = 0; e < 8; ++e) v[e] = k[e]; }
                else {
#pragma unroll
                    for (int e = 0; e < 8; ++e) v[e] = 0.f; }
            } else { const int p0 = col >> 1;
#pragma unroll
                for (int e = 0; e < 4; ++e) { const f32x2 cc = Cc[p0 + e], gg = P[(t + 1) * 64 + p0 + e]; v[2 * e] = cc.x * gg.x - cc.y * gg.y; v[2 * e + 1] = -(cc.x * gg.y + cc.y * gg.x); } }
            u32x4 w; w.x = pk2(v[0], v[1]); w.y = pk2(v[2], v[3]); w.z = pk2(v[4], v[5]); w.w = pk2(v[6], v[7]);
            *(u32x4*)(TZ + (size_t)(t * 16 + c) * KX + col) = w;
        }
        bf16_t* WE = (bf16_t*)(p.ws + WS_WEND) + (size_t)g * 256 * 1024;
        for (int idx = tid; idx < 16 * 128; idx += 512) {
            const int rl = idx >> 7, i = idx & 127, s = i >> 1, chh = i & 1;
            const int row = (rl < 8) ? (8 * c + rl) : (128 + 8 * c + (rl - 8));
            float v[8];
            if (rl < 8) { const int pp = row >> 1, ri = row & 1; const f32x2 gg = P[(63 - s) * 64 + pp];
#pragma unroll
                for (int e = 0; e < 8; ++e) { const f32x2 bb = Bb[pp * 16 + chh * 8 + e]; v[e] = ri ? (gg.x * bb.y + gg.y * bb.x) : (gg.x * bb.x - gg.y * bb.y); } }
            else {
#pragma unroll
                for (int e = 0; e < 8; ++e) v[e] = 0.f; }
            u32x4 w; w.x = pk2(v[0], v[1]); w.y = pk2(v[2], v[3]); w.z = pk2(v[4], v[5]); w.w = pk2(v[6], v[7]);
            *(u32x4*)(WE + (size_t)row * 1024 + 8 * i) = w;
        }
    }
    __syncthreads();
}

#define XB_TMO      128
#define XB_XCNT(j)  (256  + 64 * (j))
#define XB_XSUB(j)  (1280 + 64 * (j))
#define XB_XGEN(j)  (2304 + 64 * (j))
#define XB_TOP      3328
#define XB_TOPGEN   3392
#define XCD_BAR_WORDS 3456
#define XB_SPIN_CAP (1u << 18)
__device__ __forceinline__ unsigned xb_ld(unsigned* p)              { return __hip_atomic_load(p, __ATOMIC_RELAXED, __HIP_MEMORY_SCOPE_AGENT); }
__device__ __forceinline__ unsigned xb_add(unsigned* p, unsigned v) { return __hip_atomic_fetch_add(p, v, __ATOMIC_RELAXED, __HIP_MEMORY_SCOPE_AGENT); }
__device__ __forceinline__ unsigned xb_xcc_id() { return (unsigned)__builtin_amdgcn_s_getreg((3 << 11) | 20) & 0xFu; }
#define XB_SPIN(cond, bar) do { unsigned _sp = 0; while (cond) { __builtin_amdgcn_s_sleep(1); \
    if ((++_sp & 255u) == 0u) { if (xb_ld(&(bar)[XB_TMO])) break; if (_sp > XB_SPIN_CAP) { atomicAdd(&(bar)[XB_TMO], 1u); break; } } } } while (0)
struct XcdBarrier { unsigned* bar; unsigned x; volatile LAS unsigned* st; };
__device__ __forceinline__ XcdBarrier xcd_barrier_post(unsigned* bar, volatile LAS unsigned* st) {
    XcdBarrier b; b.bar = bar; b.x = xb_xcc_id(); b.st = st;
    if (threadIdx.x == 0) (void)xb_add(&bar[XB_XCNT(b.x)], 1u);
    return b;
}
__device__ __forceinline__ void xcd_barrier_complete(unsigned* bar, unsigned x, unsigned& nloc, unsigned& nx) {
    const unsigned G = gridDim.x * gridDim.y * gridDim.z;
    unsigned sum, cnt, mine, sp = 0u;
    for (;;) {
        sum = 0u; cnt = 0u; mine = 0u;
#pragma unroll
        for (unsigned j = 0; j < 16; ++j) { const unsigned c = xb_ld(&bar[XB_XCNT(j)]); sum += c; cnt += (c > 0u) ? 1u : 0u; mine = (j == x) ? c : mine; }
        if (sum == G) break;
        __builtin_amdgcn_s_sleep(1);
        if ((++sp & 255u) == 0u) { if (xb_ld(&bar[XB_TMO])) break; if (sp > XB_SPIN_CAP) { atomicAdd(&bar[XB_TMO], 1u); break; } }
    }
    nloc = mine > 0u ? mine : 1u; nx = cnt > 0u ? cnt : 1u;
}
__device__ __forceinline__ void xcd_barrier(const XcdBarrier& b) {
    asm volatile("s_waitcnt vmcnt(0)" ::: "memory");
    __syncthreads();
    if (threadIdx.x == 0) {
        unsigned* bar = b.bar;
        __builtin_amdgcn_s_waitcnt(0);
        unsigned nloc = b.st[0], nx = b.st[1];
        if (nloc == 0u) { xcd_barrier_complete(bar, b.x, nloc, nx); b.st[0] = nloc; b.st[1] = nx; }
        const unsigned old = xb_add(&bar[XB_XSUB(b.x)], 1u);
        const unsigned gen = old / nloc;
        if (old + 1u == (gen + 1u) * nloc) {
            __builtin_amdgcn_fence(__ATOMIC_RELEASE, "agent");
            asm volatile("s_waitcnt vmcnt(0)" ::: "memory");
            const unsigned og = xb_add(&bar[XB_TOP], 1u);
            const unsigned tg = og / nx;
            if (og + 1u == (tg + 1u) * nx) xb_add(&bar[XB_TOPGEN], 1u);
            else XB_SPIN(xb_ld(&bar[XB_TOPGEN]) == tg, bar);
            __builtin_amdgcn_fence(__ATOMIC_ACQUIRE, "agent");
            xb_add(&bar[XB_XGEN(b.x)], 1u);
            asm volatile("s_waitcnt vmcnt(0)" ::: "memory");
        } else {
            XB_SPIN(xb_ld(&bar[XB_XGEN(b.x)]) == gen, bar);
            __builtin_amdgcn_fence(__ATOMIC_ACQUIRE, "agent");
            asm volatile("s_waitcnt vmcnt(0)" ::: "memory");
        }
    }
    __syncthreads();
}

__global__ void __launch_bounds__(512) fwd_megakernel(Params p) {
    extern __shared__ __attribute__((aligned(16))) unsigned char lds_raw[];
    LAS unsigned char* lds = (LAS unsigned char*)lds_raw;
    cg::grid_group grid = cg::this_grid();
    const int tid = threadIdx.x, lane = tid & 63, wave = __builtin_amdgcn_readfirstlane(tid >> 6);
    const int G = gridDim.x, bx = blockIdx.x;
    unsigned char* ws = p.ws;
    const int lo = p.ph_lo, hi = p.ph_hi;
#define IN(k) (lo <= (k) && (k) < hi)
    volatile LAS unsigned* bst = (volatile LAS unsigned*)(lds + 131072 + 128);
    if (tid == 0) { bst[0] = 0u; bst[1] = 0u; }
    __syncthreads();
    XcdBarrier xbar; xbar.bar = (unsigned*)(ws + WS_BAR); xbar.x = 0; xbar.st = bst;
#define SEAM(k) do { if (IN(k) && IN((k) + 1)) { if ((k) == 0) { grid.sync(); xbar = xcd_barrier_post((unsigned*)(ws + WS_BAR), bst); } else xcd_barrier(xbar); } } while (0)

    if (IN(0)) {
        for (int i = bx * 512 + tid; i < MTOK; i += G * 512) ((float*)(ws + WS_SUMSQ))[i] = 0.f;
        if (bx == 0) for (int i = tid; i < 2048; i += 512) ((unsigned*)(ws + WS_NRM))[i] = 0u;
        if (bx == 1 || G == 1) for (int i = tid; i < 256 * 64; i += 512) ((unsigned*)(ws + WS_CNT))[i] = 0u;
        if (bx == 2 || G < 3) for (int i = tid; i < XCD_BAR_WORDS; i += 512) ((unsigned*)(ws + WS_BAR))[i] = 0u;
        const int gw = bx * 8 + wave, NGW = G * 8;
        auto partL = [&]() __attribute__((always_inline)) {
        for (int it = bx; it < NG * 16; it += G) ssm_ops_item(p, it >> 4, it & 15, lds);
        LAS float* scr = (LAS float*)(lds + wave * 8704);
        constexpr int I_IN = 16 * (NPROJ / 32), I_GLU = 8 * 16, I_A = 8 * 32, I_S = 8 * 32, I_O = 16 * 32, NIT = I_IN + I_GLU + I_A + I_S + I_O;
        for (int it = gw; it < NIT; it += NGW) {
            int r = it;
            if (r < I_IN) { transpose_item(p.w_in, DM, INC, NPROJ, 0, (bf16_t*)(ws + WS_WIN), scr, r, lane); continue; } r -= I_IN;
            if (r < I_GLU) { transpose_item(p.w_glu, SW, SW, SW, -1, (bf16_t*)(ws + WS_WGLU), scr, r, lane); continue; } r -= I_GLU;
            if (r < I_A) { transpose_item(p.w_a, AW, DM, DM, -1, (bf16_t*)(ws + WS_WA), scr, r, lane); continue; } r -= I_A;
            if (r < I_S) { transpose_item(p.w_s, SW, DM, DM, -1, (bf16_t*)(ws + WS_WS), scr, r, lane); continue; } r -= I_S;
            transpose_item(p.w_out, DM, DM, DM, -1, (bf16_t*)(ws + WS_WOUT), scr, r, lane);
        }
        };
        auto partR = [&]() __attribute__((always_inline)) {
        LAS float* wf = (LAS float*)(lds + 73728);
        {
            f32x4 wa[2][2];
#pragma unroll
            for (int q = 0; q < 2; ++q) { const float* src = p.w_in + (size_t)(tid + 512 * q) * INC + 1536; wa[q][0] = *(const f32x4*)src; wa[q][1] = *(const f32x4*)(src + 4); }
#pragma unroll
            for (int q = 0; q < 2; ++q)
#pragma unroll
                for (int j = 0; j < 8; ++j) wf[j * 1024 + tid + 512 * q] = wa[q][j >> 2][j & 3];
        }
        __syncthreads();
        f32x4 gn[4];
#pragma unroll
        for (int j = 0; j < 4; ++j) gn[j] = ((const f32x4*)p.norm_pre)[lane + 64 * j];
        f32x4 wreg[8][4];
#pragma unroll
        for (int e = 0; e < 8; ++e)
#pragma unroll
            for (int j = 0; j < 4; ++j) wreg[e][j] = *(const LAS f32x4*)(wf + e * 1024 + 4 * lane + 256 * j);
        const int fidx = ((lane & 1) << 2) | (lane & 2) | ((lane & 4) >> 2);
        const float bfg = p.b_forget[fidx];
        f32x4 vn[4];
        if (gw < MTOK) {
#pragma unroll
            for (int j = 0; j < 4; ++j) vn[j] = ((const f32x4*)(p.x + (size_t)gw * DM) + lane)[64 * j];
        }
        for (int m = gw; m < MTOK; m += NGW) {
            f32x4 v[4]; float s = 0.f;
#pragma unroll
            for (int j = 0; j < 4; ++j) v[j] = vn[j];
            if (m + NGW < MTOK) {
#pragma unroll
                for (int j = 0; j < 4; ++j) vn[j] = ((const f32x4*)(p.x + (size_t)(m + NGW) * DM) + lane)[64 * j];
            }
#pragma unroll
            for (int j = 0; j < 4; ++j) s += (v[j][0] * v[j][0] + v[j][1] * v[j][1]) + (v[j][2] * v[j][2] + v[j][3] * v[j][3]);
            const float rstd = 1.0f / sqrtf(wave_sum(s) * (1.f / DM) + 1e-6f);
            if (lane == 0) ((float*)(ws + WS_RSTD))[m] = rstd;
            unsigned long long* o8 = (unsigned long long*)((bf16_t*)(ws + WS_H) + (size_t)m * DM) + lane;
            float fa[8];
#pragma unroll
            for (int e = 0; e < 8; ++e) fa[e] = 0.f;
#pragma unroll
            for (int j = 0; j < 4; ++j) { v[j] = v[j] * rstd * gn[j];
                o8[64 * j] = (unsigned long long)pk2(v[j][0], v[j][1]) | ((unsigned long long)pk2(v[j][2], v[j][3]) << 32);
#pragma unroll
                for (int e = 0; e < 8; ++e) { const f32x4 w = wreg[e][j]; fa[e] += (v[j][0] * w[0] + v[j][1] * w[1]) + (v[j][2] * w[2] + v[j][3] * w[3]); } }
#pragma unroll
            for (int e = 0; e < 4; ++e) { const float a = fa[e], c = fa[e + 4]; const bool up = lane & 1; fa[e] = (up ? c : a) + __shfl_xor(up ? a : c, 1); }
#pragma unroll
            for (int e = 0; e < 2; ++e) { const float a = fa[e], c = fa[e + 2]; const bool up = lane & 2; fa[e] = (up ? c : a) + __shfl_xor(up ? a : c, 2); }
            { const float a = fa[0], c = fa[1]; const bool up = lane & 4; fa[0] = (up ? c : a) + __shfl_xor(up ? a : c, 4); }
            float z = fa[0];
            z += __shfl_xor(z, 8); z += __shfl_xor(z, 16); z += __shfl_xor(z, 32);
            if (lane < 8) { z += bfg;
                const float ls = fminf(z, 0.f) - log1pf(expf(-fabsf(z)));
                ((float*)(ws + WS_LOGF))[(size_t)m * 8 + fidx] = ls; }
        }
        };
        if ((bx >> 3) & 1) { partR(); __syncthreads(); partL(); } else { partL(); __syncthreads(); partR(); }
        __syncthreads();
    }
    SEAM(0);

    if (IN(1)) {
        for (int bh = bx; bh < BATCH * NH; bh += G) {
            const int b = bh >> 3, h = bh & 7;
            const float* lf = (const float*)(ws + WS_LOGF) + (size_t)b * SEQ * 8 + h;
            float v[16]; float s = 0.f;
#pragma unroll
            for (int e = 0; e < 16; ++e) { s += lf[(size_t)(tid * 16 + e) * 8]; v[e] = s; }
            float incl = s;
#pragma unroll
            for (int o = 1; o < 64; o <<= 1) { const float n = __shfl_up(incl, o); if (lane >= o) incl += n; }
            LAS float* wt = (LAS float*)lds;
            if (lane == 63) wt[wave] = incl;
            __syncthreads();
            float base = incl - s;
            for (int w = 0; w < wave; ++w) base += wt[w];
            float* co = (float*)(ws + WS_CUM) + (size_t)bh * SEQ + tid * 16;
#pragma unroll
            for (int e = 0; e < 16; ++e) co[e] = (base + v[e]) * LOG2E;
            __syncthreads();
        }
        pg8::Gemm g{(const bf16_t*)(ws + WS_H), (const bf16_t*)(ws + WS_WIN), DM, DM, DM, 0, 0, nullptr, nullptr, 0, 16};
        pg8::TileOrder S{MTOK / 256, NPROJ / 256, 1, G, bx, 1};
        EpiProj E{ws};
        pg8::gemm_phase(lds, g, S, E);
    }
    SEAM(1);

    if (IN(2)) {
        {
            pg8::Gemm g{(const bf16_t*)(ws + WS_U2) + 128, (const bf16_t*)(ws + WS_WEND), 1024, KX, 1024, (long)NCHK * KX, 256L * 1024, nullptr, nullptr, 0, 16};
            pg8::TileOrder S{NCHK / 256, 1, NG, G, G - 1 - bx, 0};
            EpiSsmE E{(float*)(ws + WS_E)};
            pg8::gemm_phase(lds, g, S, E);
        }
        __syncthreads();
        {
            unsigned* uctr = (unsigned*)(ws + WS_NRM) + 1024;
            LAS int* nxt = (LAS int*)(lds + 131072 + 256);
            for (;;) {
                if (tid == 0) *nxt = (int)atomicAdd(uctr, 1u);
                __syncthreads();
                const int uidx = *nxt;
                __syncthreads();
                if (uidx >= BATCH * NH * 32) break;
                const int bh = uidx & 63, qb = 31 - (uidx >> 6);
                att::attn_unit(bh >> 3, bh & 7, qb, ws, lds);
            }
        }
    }
    SEAM(2);

    if (IN(3)) {
        typedef float f32x2 __attribute__((ext_vector_type(2)));
        LAS f32x2* ex = (LAS f32x2*)lds;
        for (int idx = bx; idx < BATCH * NG; idx += G) {
            const int b = idx >> 5, g = idx & 31, pp = lane;
            const f32x2 L = ((const f32x2*)(ws + WS_LAM64))[g * 64 + pp];
            f32x2 L16 = L;
#pragma unroll
            for (int q = 0; q < 4; ++q) L16 = (f32x2){L16.x * L16.x - L16.y * L16.y, 2.f * L16.x * L16.y};
            const float* Eb = (const float*)(ws + WS_E) + ((size_t)(g * NCHK + b * 128 + 16 * wave) * 128 + 2 * pp);
            bf16_t* Ub = (bf16_t*)(ws + WS_U2) + ((size_t)(g * NCHK + b * 128 + 16 * wave) * KX + 2 * pp);
            f32x2 e[16];
#pragma unroll
            for (int j = 0; j < 16; ++j) e[j] = *(const f32x2*)(Eb + (size_t)j * 128);
            float sr = 0.f, si = 0.f;
#pragma unroll
            for (int j = 0; j < 16; ++j) { const float nr = L.x * sr - L.y * si + e[j].x, ni = L.x * si + L.y * sr + e[j].y; sr = nr; si = ni; }
            ex[wave * 64 + pp] = (f32x2){sr, si};
            __syncthreads();
            sr = 0.f; si = 0.f;
            for (int w = 0; w < wave; ++w) { const f32x2 en = ex[w * 64 + pp]; const float nr = L16.x * sr - L16.y * si + en.x, ni = L16.x * si + L16.y * sr + en.y; sr = nr; si = ni; }
#pragma unroll
            for (int j = 0; j < 16; ++j) {
                *(unsigned*)(Ub + (size_t)j * KX) = pk2(sr, si);
                const float nr = L.x * sr - L.y * si + e[j].x, ni = L.x * si + L.y * sr + e[j].y; sr = nr; si = ni;
            }
            __syncthreads();
        }
    }
    SEAM(3);

    if (IN(4)) {
        pg8::Gemm g{(const bf16_t*)(ws + WS_U2), (const bf16_t*)(ws + WS_TZ), KX, KX, KX, (long)NCHK * KX, 1024L * KX, nullptr, nullptr, 0, 16};
        pg8::SsmYOrder S{G, bx};
        EpiSsmY E{(bf16_t*)(ws + WS_YS)};
        pg8::gemm_phase(lds, g, S, E);
    }
    SEAM(4);

    if (IN(5)) {
        pg8::Gemm g{(const bf16_t*)(ws + WS_YS), (const bf16_t*)(ws + WS_WGLU), SW, 16, SW, 0, 0, nullptr, nullptr, 0, (long)MTOK * 16};
        pg8::TileOrder S{MTOK / 256, SW / 256, 1, G, bx, 1};
        EpiGlu E{(const bf16_t*)(ws + WS_YS), (const bf16_t*)(ws + WS_GS), p.b_glu, (bf16_t*)(ws + WS_YS2)};
        pg8::gemm_phase(lds, g, S, E);
    }
    SEAM(5);

    if (IN(6)) {
        pg8::Gemm g{(const bf16_t*)(ws + WS_YA), (const bf16_t*)(ws + WS_WA), 1024, 512, 512, 0, 0, (const bf16_t*)(ws + WS_YS2), (const bf16_t*)(ws + WS_WS), 8, 16};
        pg8::TileOrder S{MTOK / 256, DM / 256, 1, G, bx, 1};
        EpiMerge E{(const bf16_t*)(ws + WS_MIXA), (const bf16_t*)(ws + WS_MIXS), (bf16_t*)(ws + WS_MERGED)};
        pg8::gemm_phase(lds, g, S, E);
    }
    SEAM(6);

    if (IN(7)) {
        pg8::Gemm g{(const bf16_t*)(ws + WS_MERGED), (const bf16_t*)(ws + WS_WOUT), DM, DM, DM, 0, 0, nullptr, nullptr, 0, 16};
        pg8::TileOrder S{MTOK / 256, DM / 256, 1, G, bx, 1};
        EpiOut E{(bf16_t*)(ws + WS_PRE), (float*)(ws + WS_SUMSQ)};
        pg8::gemm_phase(lds, g, S, E);
    }

    SEAM(7);

    if (IN(8)) {
        const int gw = bx * 8 + wave, NGW = G * 8;
        f32x4 gn[4], ig[4]; bool gsmall = false;
#pragma unroll
        for (int j = 0; j < 4; ++j) { gn[j] = ((const f32x4*)p.norm_post)[lane + 64 * j]; const f32x4 g = ((const f32x4*)p.norm_pre)[lane + 64 * j];
#pragma unroll
            for (int e = 0; e < 4; ++e) { gsmall = gsmall || (fabsf(g[e]) < 1e-2f); ig[j][e] = 1.0f / g[e]; } }
        const bool use_x = __any(gsmall ? 1 : 0) != 0;
        for (int m = gw; m < MTOK; m += NGW) {
            const float rstd = 1.0f / sqrtf(((const float*)(ws + WS_SUMSQ))[m] * (1.f / DM) + 1e-6f);
            f32x4* orow = (f32x4*)(p.out + (size_t)m * DM) + lane;
            const unsigned long long* pr = (const unsigned long long*)((const bf16_t*)(ws + WS_PRE) + (size_t)m * DM) + lane;
            f32x4 xv[4]; unsigned long long pv8[4];
            if (!use_x) {
                const unsigned long long* hr = (const unsigned long long*)((const bf16_t*)(ws + WS_H) + (size_t)m * DM) + lane;
                const float inv = 1.0f / ((const float*)(ws + WS_RSTD))[m];
                unsigned long long h8[4];
#pragma unroll
                for (int j = 0; j < 4; ++j) { h8[j] = hr[64 * j]; pv8[j] = pr[64 * j]; }
#pragma unroll
                for (int j = 0; j < 4; ++j) { const unsigned lo32 = (unsigned)h8[j], hi32 = (unsigned)(h8[j] >> 32);
                    xv[j] = (f32x4){bf_lo(lo32), bf_hi(lo32), bf_lo(hi32), bf_hi(hi32)} * ig[j] * inv; }
            } else {
                const f32x4* xr = (const f32x4*)(p.x + (size_t)m * DM) + lane;
#pragma unroll
                for (int j = 0; j < 4; ++j) { xv[j] = xr[64 * j]; pv8[j] = pr[64 * j]; }
            }
#pragma unroll
            for (int j = 0; j < 4; ++j) { const unsigned lo32 = (unsigned)pv8[j], hi32 = (unsigned)(pv8[j] >> 32);
                const f32x4 pf = (f32x4){bf_lo(lo32), bf_hi(lo32), bf_lo(hi32), bf_hi(hi32)};
                orow[64 * j] = xv[j] + pf * rstd * gn[j]; }
        }
    }
#undef IN
#undef SEAM
}

extern "C" void kernel_launch(void* const* d_in, const int* in_sizes, int n_in, void* d_out, int out_size, void* d_ws, size_t ws_size, hipStream_t stream) {
    static int grid = 0;
    if (grid == 0) {
        if (n_in != 18 || out_size != MTOK * DM || ws_size < WS_END) { fprintf(stderr, "kernel_launch: unexpected shapes (n_in %d, out %d, ws %zu)\n", n_in, out_size, ws_size); grid = -1; return; }
        int dev = 0, cus = 0, per_cu = 0;
        hipGetDevice(&dev); hipDeviceGetAttribute(&cus, hipDeviceAttributeMultiprocessorCount, dev);
        if (hipFuncSetAttribute((const void*)fwd_megakernel, hipFuncAttributeMaxDynamicSharedMemorySize, LDS_BYTES) != hipSuccess) { fprintf(stderr, "kernel_launch: hipFuncSetAttribute failed\n"); grid = -1; return; }
        if (hipOccupancyMaxActiveBlocksPerMultiprocessor(&per_cu, (const void*)fwd_megakernel, 512, LDS_BYTES) != hipSuccess || per_cu < 1) { fprintf(stderr, "kernel_launch: occupancy query says %d\n", per_cu); per_cu = 1; }
        (void)hipGetLastError();
        grid = cus < 256 ? cus : 256;
    }
    if (grid < 0) return;
    Params p{};
    p.x = (const float*)d_in[0]; p.norm_pre = (const float*)d_in[1]; p.w_in = (const float*)d_in[2]; p.b_forget = (const float*)d_in[3];
    p.lam_re = (const float*)d_in[4]; p.lam_im = (const float*)d_in[5]; p.log_dt = (const float*)d_in[6]; p.b_re = (const float*)d_in[7]; p.b_im = (const float*)d_in[8];
    p.c_re = (const float*)d_in[9]; p.c_im = (const float*)d_in[10]; p.d_skip = (const float*)d_in[11]; p.w_glu = (const float*)d_in[12]; p.b_glu = (const float*)d_in[13];
    p.w_a = (const float*)d_in[14]; p.w_s = (const float*)d_in[15]; p.w_out = (const float*)d_in[16]; p.norm_post = (const float*)d_in[17];
    p.out = (float*)d_out; p.ws = (unsigned char*)d_ws;
#if MK_MULTI
    for (int ph = 0; ph < 9; ++ph) { p.ph_lo = ph; p.ph_hi = ph + 1; hipLaunchKernelGGL(fwd_megakernel, dim3(grid), dim3(512), LDS_BYTES, stream, p); }
#else
    p.ph_lo = 0; p.ph_hi = 9;
    void* args[] = {&p};
    hipError_t e = hipLaunchCooperativeKernel((const void*)fwd_megakernel, dim3(grid), dim3(512), args, LDS_BYTES, stream);
    if (e != hipSuccess) fprintf(stderr, "cooperative launch failed: %s (grid %d)\n", hipGetErrorString(e), grid);
#endif
}
```

```cpp
#include <hip/hip_runtime.h>
#include <hip/hip_cooperative_groups.h>
#include <hip/hip_bf16.h>
#include <cstdio>
#include <cstdint>
#include <cmath>
namespace cg = cooperative_groups;

#ifndef MK_MULTI
#define MK_MULTI 0
#endif

namespace pg8 {
#define PG8_LAS __attribute__((address_space(3)))
typedef unsigned short bf16_t;
typedef short bf16x8 __attribute__((ext_vector_type(8)));
typedef float f32x4 __attribute__((ext_vector_type(4)));
typedef unsigned u32x4 __attribute__((ext_vector_type(4)));
constexpr int BM = 256, BK = 64, HALF = 128, HTB = HALF * BK * 2, STAGE_BYTES = 8 * HTB, NXCD = 8, WGM = 8;

__host__ __device__ __forceinline__ int lds_byte(int r, int c) { const int st = (r >> 4) * 2 + (c >> 5), rr = r & 15, cc = c & 31, ob = rr * 64 + cc * 2; return st * 1024 + (ob ^ (((ob >> 9) & 1) << 5)); }
__host__ __device__ __forceinline__ void stage_rc(int b, int& R, int& C) { const int st = b / 1024, sb = b % 1024, swz = sb ^ (((sb >> 9) & 1) << 5); R = (st >> 1) * 16 + swz / 64; C = (st & 1) * 32 + (swz % 64) / 2; }
__host__ __device__ __forceinline__ int perm32(int rho) { const int n = rho >> 4, i = rho & 15; return 8 * (i >> 2) + 4 * n + (i & 3); }

struct Unit { int pm, pn, z; };
struct Gemm { const bf16_t* A; const bf16_t* Bt; int K, lda, ldb; long zsA, zsB; const bf16_t* A2; const bf16_t* Bt2; int ksplit; long cgA; };

__device__ __forceinline__ void swz_map(int L, int nM, int nN, int& pm, int& pn) {
    const int nwg = nM * nN; int wgid = L; { const int q = nwg / NXCD, r = nwg % NXCD, xcd = wgid % NXCD, off = wgid / NXCD; wgid = (xcd < r ? xcd * (q + 1) : r * (q + 1) + (xcd - r) * q) + off; }
    const int nig = WGM * nN, gid = wgid / nig, fm = gid * WGM, gsz = (nM - fm) < WGM ? (nM - fm) : WGM;
    pm = fm + ((wgid % nig) % gsz); pn = (wgid % nig) / gsz;
}
struct TileOrder {
    int nM, nN, nz, G, c, swz;
    __device__ __forceinline__ bool next(int i, Unit& u) const {
        const long L = (long)i * G + c; const int per = nM * nN; if (L >= (long)per * nz) return false;
        const int z = (int)(L / per), l = (int)(L % per); u.z = z;
        if (swz) swz_map(l, nM, nN, u.pm, u.pn); else { u.pm = l % nM; u.pn = l / nM; }
        return true;
    }
    __device__ __forceinline__ int nt(const Unit&, int K) const { return K / BK; }
};
struct SsmYOrder {
    int G, c;
    __device__ __forceinline__ bool next(int i, Unit& u) const {
        const long L = (long)i * G + c; if (L >= 32 * 16) return false;
        u.z = (int)(L >> 4); const int l = (int)(L & 15); u.pm = l & 3; u.pn = (i & 1) ? 3 - (l >> 2) : (l >> 2); return true;
    }
    __device__ __forceinline__ int nt(const Unit& u, int) const { return 6 + 4 * u.pn; }
};
struct PassOrder {
    int nM, nN, G, c;
    __device__ __forceinline__ bool next(int i, Unit& u) const {
        const long L = (long)(i >> 1) * G + c; if (L >= (long)nM * nN) return false;
        u.z = i & 1; swz_map((int)L, nM, nN, u.pm, u.pn); return true;
    }
    __device__ __forceinline__ int nt(const Unit&, int K) const { return K / BK; }
};

__device__ __forceinline__ unsigned cvt_pk_bf16(float lo, float hi) { unsigned r; asm volatile("v_cvt_pk_bf16_f32 %0, %1, %2" : "=v"(r) : "v"(lo), "v"(hi)); return r; }
__device__ __forceinline__ float bf_lo(unsigned w) { return __uint_as_float(w << 16); }
__device__ __forceinline__ float bf_hi(unsigned w) { return __uint_as_float(w & 0xffff0000u); }
__device__ __forceinline__ float sigm(float v) { return __builtin_amdgcn_rcpf(1.0f + __expf(-v)); }

template <class Epi, class Sched>
__device__ __forceinline__ void gemm_phase(PG8_LAS unsigned char* lds, const Gemm g, const Sched& S, const Epi& E) {
    const int tid = threadIdx.x, wid = __builtin_amdgcn_readfirstlane(tid >> 6), lane = tid & 63, wr = wid >> 2, wc = wid & 3, fr = lane & 15, fq = lane >> 4;
    unsigned voffA[2], voffB[2];
#pragma unroll
    for (int i = 0; i < 2; ++i) { int R, C; stage_rc(tid * 16 + i * 8192, R, C); const int Rb = (R & ~31) + perm32(R & 31);
        voffA[i] = (unsigned)(R * g.lda + (C & 15) + (long)(C >> 4) * g.cgA) * 2u; voffB[i] = (unsigned)(Rb * g.ldb + C) * 2u; }
    const size_t kstepA = (size_t)(4 * g.cgA * 2), kstepB = (size_t)(BK * 2);
    const size_t hstepA = (size_t)HALF * g.lda * 2, hstepB = (size_t)HALF * g.ldb * 2;
    const size_t tstepA = 2 * hstepA, tstepB = 2 * hstepB;
    const unsigned ldsw = (unsigned)wid * 1024u;
    const int aoff = lds_byte(wr * 64 + fr, fq * 8), boff = lds_byte(wc * 32 + fr, fq * 8);
#define PG8_SA(b, h) (((b) * 2 + (h)) * HTB)
#define PG8_SB(b, h) ((4 + (b) * 2 + (h)) * HTB)
#define PG8_STAGE(bufoff, gbase, voff) do { _Pragma("unroll") for (int _i = 0; _i < 2; ++_i) \
        __builtin_amdgcn_global_load_lds((const unsigned*)((const char*)(gbase) + (voff)[_i]), (PG8_LAS unsigned*)(lds + (bufoff) + ldsw + _i * 8192), 16, 0, 0); } while (0)
#define PG8_LDA(dst, b, h) do { _Pragma("unroll") for (int m = 0; m < 4; ++m) _Pragma("unroll") for (int k = 0; k < 2; ++k) dst[m][k] = *(const PG8_LAS bf16x8*)(lds + PG8_SA(b, h) + aoff + m * 2048 + k * 1024); } while (0)
#define PG8_LDB(dst, b, h) do { _Pragma("unroll") for (int n = 0; n < 2; ++n) _Pragma("unroll") for (int k = 0; k < 2; ++k) dst[n][k] = *(const PG8_LAS bf16x8*)(lds + PG8_SB(b, h) + boff + n * 2048 + k * 1024); } while (0)
#define PG8_MMA(ai, bj, At, Bt) do { __builtin_amdgcn_s_setprio(1); _Pragma("unroll") for (int m = 0; m < 4; ++m) _Pragma("unroll") for (int n = 0; n < 2; ++n) _Pragma("unroll") for (int k = 0; k < 2; ++k) \
        acc[ai][bj][m][n] = __builtin_amdgcn_mfma_f32_16x16x32_bf16(Bt[n][k], At[m][k], acc[ai][bj][m][n], 0, 0, 0); __builtin_amdgcn_s_setprio(0); } while (0)
#define PG8_WAIT_V(n) asm volatile("s_waitcnt vmcnt(" #n ")" ::: "memory")
#define PG8_WAIT_L(n) asm volatile("s_waitcnt lgkmcnt(" #n ")" ::: "memory")
#define PG8_BAR __builtin_amdgcn_s_barrier()
#define PG8_SCHED __builtin_amdgcn_sched_barrier(0)
    Unit cur, nxt; int ui = 0;
    if (!S.next(0, cur)) return;
    f32x4 acc[2][2][4][2];
#pragma unroll
    for (int a = 0; a < 2; ++a)
#pragma unroll
        for (int b = 0; b < 2; ++b)
#pragma unroll
            for (int m = 0; m < 4; ++m)
#pragma unroll
                for (int n = 0; n < 2; ++n) acc[a][b][m][n] = (f32x4){0.f, 0.f, 0.f, 0.f};
    bf16x8 At[4][2], B0[2][2], B1[2][2];
    const char* cA = (const char*)(g.A + (size_t)cur.z * g.zsA) + (size_t)cur.pm * tstepA; const char* cB = (const char*)(g.Bt + (size_t)cur.z * g.zsB) + (size_t)cur.pn * tstepB;
    PG8_STAGE(PG8_SB(0, 0), cB, voffB); PG8_STAGE(PG8_SB(0, 1), cB + hstepB, voffB); PG8_STAGE(PG8_SA(0, 0), cA, voffA); PG8_STAGE(PG8_SA(0, 1), cA + hstepA, voffA);
    if (wr == 1) PG8_BAR;
    PG8_WAIT_V(2); PG8_BAR;
    PG8_STAGE(PG8_SB(1, 0), cB + kstepB, voffB); PG8_STAGE(PG8_SA(1, 0), cA + kstepA, voffA); PG8_STAGE(PG8_SB(1, 1), cB + hstepB + kstepB, voffB);
    PG8_WAIT_V(6); PG8_BAR;
    for (;;) {
        const bool has_next = S.next(ui + 1, nxt);
        const int nt = S.nt(cur, g.K);
        const char* nA = has_next ? (const char*)(g.A + (size_t)nxt.z * g.zsA) + (size_t)nxt.pm * tstepA : cA; const char* nB = has_next ? (const char*)(g.Bt + (size_t)nxt.z * g.zsB) + (size_t)nxt.pn * tstepB : cB;
        const int ks = g.ksplit;
        const char* cA2 = ks ? (const char*)g.A2 + (size_t)cur.pm * tstepA - (size_t)ks * kstepA : cA; const char* cB2 = ks ? (const char*)g.Bt2 + (size_t)cur.pn * tstepB - (size_t)ks * kstepB : cB;
        for (int t = 0; t < nt; t += 2) {
            const bool last = (t == nt - 2);
            if constexpr (Epi::HAS_MID) { if (t == ks) E.mid(acc, cur, wr, wc, fr, fq); }
            const bool s1 = ks && (t + 1 >= ks), s2 = ks && (t + 2 >= ks);
            const char* a1 = (s1 ? cA2 : cA) + (size_t)(t + 1) * kstepA;
            const char* a2 = last ? nA : (s2 ? cA2 : cA) + (size_t)(t + 2) * kstepA; const char* b2 = last ? nB : (s2 ? cB2 : cB) + (size_t)(t + 2) * kstepB;
            const char* a3 = a2 + kstepA; const char* b3 = b2 + kstepB;
            PG8_LDB(B0, 0, 0); PG8_LDB(B1, 0, 1); PG8_SCHED; PG8_LDA(At, 0, 0); PG8_STAGE(PG8_SA(1, 1), a1 + hstepA, voffA);
            PG8_WAIT_V(8); PG8_WAIT_L(0); PG8_BAR; PG8_MMA(0, 0, At, B0); PG8_MMA(0, 1, At, B1); PG8_BAR; PG8_SCHED;
            PG8_LDA(At, 0, 1); PG8_STAGE(PG8_SB(0, 0), b2, voffB); PG8_STAGE(PG8_SB(0, 1), b2 + hstepB, voffB); PG8_STAGE(PG8_SA(0, 0), a2, voffA);
            PG8_WAIT_V(8); PG8_WAIT_L(0); PG8_BAR; PG8_MMA(1, 0, At, B0); PG8_MMA(1, 1, At, B1); PG8_BAR; PG8_SCHED;
            PG8_LDB(B0, 1, 0); PG8_LDB(B1, 1, 1); PG8_SCHED; PG8_LDA(At, 1, 0); PG8_STAGE(PG8_SA(0, 1), a2 + hstepA, voffA);
            PG8_WAIT_V(8); PG8_WAIT_L(0); PG8_BAR; PG8_MMA(0, 0, At, B0); PG8_MMA(0, 1, At, B1); PG8_BAR; PG8_SCHED;
            PG8_LDA(At, 1, 1); PG8_STAGE(PG8_SB(1, 0), b3, voffB); PG8_STAGE(PG8_SB(1, 1), b3 + hstepB, voffB); PG8_STAGE(PG8_SA(1, 0), a3, voffA);
            PG8_WAIT_V(8); PG8_WAIT_L(0); PG8_BAR; PG8_MMA(1, 0, At, B0); PG8_MMA(1, 1, At, B1); PG8_BAR; PG8_SCHED;
        }
        if (wr == 0) PG8_BAR;
        E(acc, cur, wr, wc, fr, fq);
        if (!has_next) break;
#pragma unroll
        for (int a = 0; a < 2; ++a)
#pragma unroll
            for (int b = 0; b < 2; ++b)
#pragma unroll
                for (int m = 0; m < 4; ++m)
#pragma unroll
                    for (int n = 0; n < 2; ++n) acc[a][b][m][n] = (f32x4){0.f, 0.f, 0.f, 0.f};
        cur = nxt; cA = nA; cB = nB; ++ui;
        if (wr == 1) PG8_BAR;
    }
    PG8_WAIT_V(0);
    PG8_BAR;
#undef PG8_SA
#undef PG8_SB
#undef PG8_STAGE
#undef PG8_LDA
#undef PG8_LDB
#undef PG8_MMA
#undef PG8_WAIT_V
#undef PG8_WAIT_L
#undef PG8_BAR
#undef PG8_SCHED
}
}

using pg8::bf16_t; using pg8::f32x4; using pg8::u32x4; using pg8::Unit; using pg8::cvt_pk_bf16; using pg8::bf_lo; using pg8::bf_hi; using pg8::sigm;
#define LAS __attribute__((address_space(3)))

constexpr int BATCH = 8, SEQ = 8192, DM = 1024, MTOK = BATCH * SEQ;
constexpr int NH = 8, HD = 64, AW = 512, SW = 512, NG = 32, GC = 16, NP = 64;
constexpr int INC = 5640;
constexpr int NPROJ = 5120;
constexpr int CH = 64, NCHK = MTOK / CH;
constexpr int KX = 1152;
constexpr float C2 = 0.125f * 1.4426950408889634f;
constexpr float LOG2E = 1.4426950408889634f;
constexpr float SKIP_LOG2 = 40.0f;

constexpr size_t MiB = 1u << 20;
constexpr size_t WS_SUMSQ = 0;
constexpr size_t WS_NRM = 512 * 1024;
constexpr size_t WS_LAM64 = 520 * 1024;
constexpr size_t WS_CNT = 576 * 1024;
constexpr size_t WS_BAR = 640 * 1024;
constexpr size_t WS_WIN = 1 * MiB;
constexpr size_t WS_WGLU = 11 * MiB;
constexpr size_t WS_WA = 12 * MiB;
constexpr size_t WS_WS = 13 * MiB;
constexpr size_t WS_WOUT = 14 * MiB;
constexpr size_t WS_LOGF = 16 * MiB;
constexpr size_t WS_CUM = 18 * MiB;
constexpr size_t WS_WEND = 20 * MiB;
constexpr size_t WS_E = 36 * MiB;
constexpr size_t WS_TZ = 52 * MiB;
constexpr size_t WS_U2 = 124 * MiB;
constexpr size_t WS_H = 196 * MiB;
constexpr size_t WS_RSTD = 704 * 1024;
constexpr size_t WS_Q = 324 * MiB, WS_K = 388 * MiB, WS_V = 452 * MiB, WS_GA = 516 * MiB, WS_GS = 580 * MiB;
constexpr size_t WS_MERGED = WS_Q;
constexpr size_t WS_MIXA = 644 * MiB, WS_MIXS = 772 * MiB;
constexpr size_t WS_PRE = WS_MIXA;
constexpr size_t WS_YA = 900 * MiB;
constexpr size_t WS_YS = WS_GA;
constexpr size_t WS_YS2 = WS_V;
constexpr size_t WS_END = 964 * MiB;

constexpr int LDS_BYTES = 147456;

struct Params {
    const float *x, *norm_pre, *w_in, *b_forget, *lam_re, *lam_im, *log_dt, *b_re, *b_im, *c_re, *c_im, *d_skip, *w_glu, *b_glu, *w_a, *w_s, *w_out, *norm_post;
    float* out; unsigned char* ws; int ph_lo, ph_hi;
};

#define EPI_LOOP_BEGIN \
    _Pragma("unroll") for (int ai = 0; ai < 2; ++ai) _Pragma("unroll") for (int m = 0; m < 4; ++m) { const int row = u.pm * 256 + ai * 128 + wr * 64 + m * 16 + fr; \
    _Pragma("unroll") for (int bj = 0; bj < 2; ++bj) { const int ct = bj * 128 + wc * 32 + 8 * fq; f32x4 v0 = acc[ai][bj][m][0], v1 = acc[ai][bj][m][1];
#define EPI_LOOP_END } }
__device__ __forceinline__ u32x4 pack8(f32x4 a, f32x4 b) { u32x4 w; w.x = cvt_pk_bf16(a[0], a[1]); w.y = cvt_pk_bf16(a[2], a[3]); w.z = cvt_pk_bf16(b[0], b[1]); w.w = cvt_pk_bf16(b[2], b[3]); return w; }
__device__ __forceinline__ void unpack8(u32x4 w, f32x4& a, f32x4& b) { a = (f32x4){bf_lo(w.x), bf_hi(w.x), bf_lo(w.y), bf_hi(w.y)}; b = (f32x4){bf_lo(w.z), bf_hi(w.z), bf_lo(w.w), bf_hi(w.w)}; }

struct EpiProj {
    static constexpr bool HAS_MID = false;
    unsigned char* ws;
    __device__ __forceinline__ void operator()(const f32x4 (&acc)[2][2][4][2], const Unit& u, int wr, int wc, int fr, int fq) const {
        const int pn = u.pn;
        int act = 0, pitch = 512, cb = (pn & 1) * 256; size_t off; float sc = 1.f;
        if (pn < 2) { off = WS_Q; sc = C2; } else if (pn < 4) off = WS_K; else if (pn < 6) off = WS_V; else if (pn < 8) { off = WS_GA; act = 1; }
        else if (pn < 10) { off = WS_U2; act = 3; } else if (pn < 12) { off = WS_GS; act = 1; }
        else {
            bf16_t* RA = (bf16_t*)(ws + WS_MIXA); bf16_t* SS = (bf16_t*)(ws + WS_MIXS);
#pragma unroll
            for (int ai = 0; ai < 2; ++ai)
#pragma unroll
                for (int m = 0; m < 4; ++m) { const int row = u.pm * 256 + ai * 128 + wr * 64 + m * 16 + fr; const size_t o = (size_t)row * DM + (pn - 12) * 128 + wc * 32 + 8 * fq;
                    f32x4 r0, r1, s0, s1;
#pragma unroll
                    for (int e = 0; e < 4; ++e) {
                        const float ea0 = __expf(-fmaxf(acc[ai][0][m][0][e], -30.f)), ea1 = __expf(-fmaxf(acc[ai][0][m][1][e], -30.f));
                        const float es0 = __expf(-fmaxf(acc[ai][1][m][0][e], -30.f)), es1 = __expf(-fmaxf(acc[ai][1][m][1][e], -30.f));
                        r0[e] = (1.f + es0) * __builtin_amdgcn_rcpf(1.f + ea0); r1[e] = (1.f + es1) * __builtin_amdgcn_rcpf(1.f + ea1);
                        s0[e] = __builtin_amdgcn_rcpf(1.f + es0); s1[e] = __builtin_amdgcn_rcpf(1.f + es1); }
                    *(u32x4*)(RA + o) = pack8(r0, r1); *(u32x4*)(SS + o) = pack8(s0, s1); }
            return;
        }
        bf16_t* base = (bf16_t*)(ws + off);
        float mx0 = 0.f, mx1 = 0.f;
        EPI_LOOP_BEGIN
            v0 = v0 * sc; v1 = v1 * sc;
            if (act == 1) {
#pragma unroll
                for (int e = 0; e < 4; ++e) { v0[e] = v0[e] * sigm(v0[e]); v1[e] = v1[e] * sigm(v1[e]); }
            } else if (act == 2) {
#pragma unroll
                for (int e = 0; e < 4; ++e) { v0[e] = sigm(fmaxf(v0[e], -30.f)); v1[e] = sigm(fmaxf(v1[e], -30.f)); }
            }
            const u32x4 w = pack8(v0, v1);
            if (act == 3) { const int cu = cb + ct, gg = cu >> 4, c0 = cu & 15; *(u32x4*)(base + ((size_t)(gg * NCHK + (row >> 6)) * KX + 128 + (row & 63) * 16 + c0)) = w; }
            else *(u32x4*)(base + (size_t)row * pitch + cb + ct) = w;
            if (pn < 4) {
                float s = (v0[0] * v0[0] + v0[1] * v0[1]) + (v0[2] * v0[2] + v0[3] * v0[3]) + (v1[0] * v1[0] + v1[1] * v1[1]) + (v1[2] * v1[2] + v1[3] * v1[3]);
                s += __shfl_xor(s, 16); s += __shfl_xor(s, 32);
                if (bj == 0) mx0 = fmaxf(mx0, s); else mx1 = fmaxf(mx1, s);
            }
        EPI_LOOP_END
        if (pn < 4) {
#pragma unroll
            for (int o = 1; o < 16; o <<= 1) { mx0 = fmaxf(mx0, __shfl_xor(mx0, o)); mx1 = fmaxf(mx1, __shfl_xor(mx1, o)); }
            if ((threadIdx.x & 63) == 0) {
                unsigned* nrm = (unsigned*)(ws + WS_NRM); const int b = u.pm >> 5, which = (pn >> 1) * 2 + (wc & 1);
                const int h0 = (pn & 1) * 4 + (wc >> 1), h1 = h0 + 2;
                atomicMax(nrm + (b * 8 + h0) * 4 + which, __float_as_uint(mx0 * 1.02f));
                atomicMax(nrm + (b * 8 + h1) * 4 + which, __float_as_uint(mx1 * 1.02f));
            }
        }
    }
};
struct EpiSsmE {
    static constexpr bool HAS_MID = false;
    float* E;
    __device__ __forceinline__ void operator()(const f32x4 (&acc)[2][2][4][2], const Unit& u, int wr, int wc, int fr, int fq) const {
        EPI_LOOP_BEGIN
            if (bj == 0) { float* p = E + ((size_t)(u.z * NCHK + row) * 128 + ct); *(f32x4*)p = v0; *(f32x4*)(p + 4) = v1; }
        EPI_LOOP_END
    }
};
__device__ __forceinline__ float gelu_t(float x) { const float y = 0.7978845608028654f * (x + 0.044715f * x * x * x); return x * sigm(2.0f * y); }
struct EpiSsmY {
    static constexpr bool HAS_MID = false;
    bf16_t* YS;
    __device__ __forceinline__ void operator()(const f32x4 (&acc)[2][2][4][2], const Unit& u, int wr, int wc, int fr, int fq) const {
        EPI_LOOP_BEGIN
#pragma unroll
            for (int e = 0; e < 4; ++e) { v0[e] = gelu_t(v0[e]); v1[e] = gelu_t(v1[e]); }
            const int j = u.pn * 256 + ct, t = j >> 4, c0 = j & 15;
            *(u32x4*)(YS + (((size_t)u.z * MTOK + row * CH + t) * 16 + c0)) = pack8(v0, v1);
        EPI_LOOP_END
    }
};
struct EpiGlu {
    static constexpr bool HAS_MID = false;
    const bf16_t* YS; const bf16_t* GS; const float* bias; bf16_t* O;
    __device__ __forceinline__ void operator()(const f32x4 (&acc)[2][2][4][2], const Unit& u, int wr, int wc, int fr, int fq) const {
        EPI_LOOP_BEGIN
            const int col = u.pn * 256 + ct; const size_t o = (size_t)row * SW + col;
            const f32x4 b0 = *(const f32x4*)(bias + col), b1 = *(const f32x4*)(bias + col + 4);
            f32x4 y0, y1, g0, g1; unpack8(*(const u32x4*)(YS + (((size_t)(col >> 4) * MTOK + row) * 16 + (col & 15))), y0, y1); unpack8(*(const u32x4*)(GS + o), g0, g1);
#pragma unroll
            for (int e = 0; e < 4; ++e) { v0[e] = y0[e] * sigm(v0[e] + b0[e]) * g0[e]; v1[e] = y1[e] * sigm(v1[e] + b1[e]) * g1[e]; }
            *(u32x4*)(O + o) = pack8(v0, v1);
        EPI_LOOP_END
    }
};
struct EpiMerge {
    static constexpr bool HAS_MID = true;
    const bf16_t* MA; const bf16_t* MS; bf16_t* O;
    __device__ __forceinline__ void mid(f32x4 (&acc)[2][2][4][2], const Unit& u, int wr, int wc, int fr, int fq) const {
        __builtin_amdgcn_sched_barrier(0);
        unsigned o0 = (unsigned)((u.pm * 256 + wr * 64 + fr) * DM + u.pn * 256 + wc * 32 + 8 * fq);
        asm volatile("" : "+v"(o0));
#pragma unroll
        for (int ai = 0; ai < 2; ++ai) { u32x4 rr[2][4];
#pragma unroll
            for (int bj = 0; bj < 2; ++bj)
#pragma unroll
                for (int m = 0; m < 4; ++m) rr[bj][m] = *(const u32x4*)(MA + (o0 + (unsigned)((ai * 128 + m * 16) * DM + bj * 128)));
#pragma unroll
            for (int bj = 0; bj < 2; ++bj)
#pragma unroll
                for (int m = 0; m < 4; ++m) { f32x4 a0, a1; unpack8(rr[bj][m], a0, a1); acc[ai][bj][m][0] *= a0; acc[ai][bj][m][1] *= a1; }
            __builtin_amdgcn_sched_barrier(0); }
    }
    __device__ __forceinline__ void operator()(const f32x4 (&acc)[2][2][4][2], const Unit& u, int wr, int wc, int fr, int fq) const {
        unsigned o0 = (unsigned)((u.pm * 256 + wr * 64 + fr) * DM + u.pn * 256 + wc * 32 + 8 * fq);
#pragma unroll
        for (int ai = 0; ai < 2; ++ai) { u32x4 gg[2][4];
#pragma unroll
            for (int bj = 0; bj < 2; ++bj)
#pragma unroll
                for (int m = 0; m < 4; ++m) gg[bj][m] = *(const u32x4*)(MS + (o0 + (unsigned)((ai * 128 + m * 16) * DM + bj * 128)));
#pragma unroll
            for (int bj = 0; bj < 2; ++bj)
#pragma unroll
                for (int m = 0; m < 4; ++m) { f32x4 s0, s1; unpack8(gg[bj][m], s0, s1);
                    *(u32x4*)(O + (o0 + (unsigned)((ai * 128 + m * 16) * DM + bj * 128))) = pack8(acc[ai][bj][m][0] * s0, acc[ai][bj][m][1] * s1); }
            __builtin_amdgcn_sched_barrier(0); }
    }
};
struct EpiOut {
    static constexpr bool HAS_MID = false;
    bf16_t* pre; float* sumsq;
    __device__ __forceinline__ void operator()(const f32x4 (&acc)[2][2][4][2], const Unit& u, int wr, int wc, int fr, int fq) const {
#pragma unroll
        for (int ai = 0; ai < 2; ++ai)
#pragma unroll
            for (int m = 0; m < 4; ++m) { const int row = u.pm * 256 + ai * 128 + wr * 64 + m * 16 + fr; float s = 0.f;
#pragma unroll
                for (int bj = 0; bj < 2; ++bj) { const f32x4 v0 = acc[ai][bj][m][0], v1 = acc[ai][bj][m][1];
                    *(u32x4*)(pre + (size_t)row * DM + u.pn * 256 + bj * 128 + wc * 32 + 8 * fq) = pack8(v0, v1);
                    s += (v0[0] * v0[0] + v0[1] * v0[1]) + (v0[2] * v0[2] + v0[3] * v0[3]) + (v1[0] * v1[0] + v1[1] * v1[1]) + (v1[2] * v1[2] + v1[3] * v1[3]); }
                s += __shfl_xor(s, 16); s += __shfl_xor(s, 32);
                if (fq == 0) atomicAdd(sumsq + row, s); }
    }
};

namespace att {
typedef short bf16x8 __attribute__((ext_vector_type(8)));
typedef short s16x4 __attribute__((ext_vector_type(4)));
typedef float f32x16 __attribute__((ext_vector_type(16)));
constexpr int SLOTB = 8192;
constexpr int L_K = 0, L_V = 2 * SLOTB, L_B = 5 * SLOTB, L_WS = L_B + 512,
                         L_CNT = L_WS + 2048, L_OST = L_CNT + 128;
static_assert(L_OST + 8 * 8192 <= 131072, "attention LDS");
__device__ __forceinline__ int crow(int r, int hi) { return (r & 3) + 8 * (r >> 2) + 4 * hi; }
typedef float f32x2_t __attribute__((ext_vector_type(2))); typedef __bf16 bf16x2_t __attribute__((ext_vector_type(2)));
__device__ __forceinline__ unsigned cvtpk_s(float lo, float hi) { f32x2_t v = {lo, hi}; bf16x2_t b = __builtin_convertvector(v, bf16x2_t); return __builtin_bit_cast(unsigned, b); }
__device__ __forceinline__ float rowmax(const f32x16& p0, const f32x16& p1) {
    float a = fmaxf(p0[0], p1[0]);
#pragma unroll
    for (int r = 1; r < 16; ++r) a = fmaxf(a, fmaxf(p0[r], p1[r]));
    auto rr = __builtin_amdgcn_permlane32_swap(__float_as_uint(a), __float_as_uint(a), false, false);
    return fmaxf(__uint_as_float(rr[0]), __uint_as_float(rr[1]));
}
__device__ __forceinline__ void pv(f32x16* o, int vb, bf16x8 pa0, bf16x8 pa1, bf16x8 pa2, bf16x8 pa3) {
#pragma unroll
    for (int d0 = 0; d0 < 2; ++d0) { s16x4 lo[4], hi[4];
#pragma unroll
        for (int ks = 0; ks < 4; ++ks) {
            asm volatile("ds_read_b64_tr_b16 %0,%1 offset:%c2" : "=&v"(lo[ks]) : "v"(vb), "i"(d0 * 4096 + ks * 1024) : "memory");
            asm volatile("ds_read_b64_tr_b16 %0,%1 offset:%c2" : "=&v"(hi[ks]) : "v"(vb), "i"(d0 * 4096 + ks * 1024 + 512) : "memory"); }
        asm volatile("s_waitcnt lgkmcnt(0)" ::: "memory"); __builtin_amdgcn_sched_barrier(0);
#define PK(k) (bf16x8){lo[k][0], lo[k][1], lo[k][2], lo[k][3], hi[k][0], hi[k][1], hi[k][2], hi[k][3]}
        o[d0] = __builtin_amdgcn_mfma_f32_32x32x16_bf16(pa0, PK(0), o[d0], 0, 0, 0);
        o[d0] = __builtin_amdgcn_mfma_f32_32x32x16_bf16(pa1, PK(1), o[d0], 0, 0, 0);
        o[d0] = __builtin_amdgcn_mfma_f32_32x32x16_bf16(pa2, PK(2), o[d0], 0, 0, 0);
        o[d0] = __builtin_amdgcn_mfma_f32_32x32x16_bf16(pa3, PK(3), o[d0], 0, 0, 0);
#undef PK
    }
}
__device__ __forceinline__ void attn_unit(int b, int h, int qb, unsigned char* ws, LAS unsigned char* shm) {
    const int tid = threadIdx.x, lane = tid & 63, r32 = lane & 31, hi = lane >> 5; const int wid = __builtin_amdgcn_readfirstlane(tid >> 6);
    const long rowbase = (long)b * SEQ; const int q0 = qb * 256;
    const bf16_t* Qw = (const bf16_t*)(ws + WS_Q) + (rowbase + q0 + wid * 32) * AW + h * HD;
    const bf16_t* Kh = (const bf16_t*)(ws + WS_K) + rowbase * AW + h * HD; const bf16_t* Vh = (const bf16_t*)(ws + WS_V) + rowbase * AW + h * HD;
    const float* cum = (const float*)(ws + WS_CUM) + (size_t)(b * NH + h) * SEQ;
    const unsigned lds0 = (unsigned)(uintptr_t)shm;
    LAS float* wsf = (LAS float*)(shm + L_WS) + wid * 64;
    LAS int* cnt = (LAS int*)(shm + L_CNT);
    const float cref = cum[q0];
    const unsigned* nr = (const unsigned*)(ws + WS_NRM) + (b * NH + h) * 4;
    const float qn2 = __uint_as_float(nr[0]) + __uint_as_float(nr[1]), kn2 = __uint_as_float(nr[2]) + __uint_as_float(nr[3]);
    const float X = SKIP_LOG2 + 2.0f * (sqrtf(qn2 * kn2) * 1.01f + 0.01f);
    const float Sb = sqrtf(qn2 * kn2) * 1.01f + 0.01f;
    float bend = 0.f; if (tid < 4 * qb) bend = cref - cum[64 * tid + 63];
    int pred = (tid < 4 * qb && bend < -X) ? 1 : 0;
    { const unsigned long long bal = __ballot(pred); if (lane == 0) cnt[wid] = __popcll(bal); }
    __syncthreads();
    int tile_lo = 0;
#pragma unroll
    for (int w = 0; w < 8; ++w) tile_lo += cnt[w];
    const int NT = 4 * qb + 4;
    bf16x8 qr[4];
#pragma unroll
    for (int d0 = 0; d0 < 4; ++d0) qr[d0] = *(const bf16x8*)(Qw + (long)r32 * AW + d0 * 16 + hi * 8);
    const bf16_t* ksrc = Kh + (long)lane * AW + wid * 8;
    const bf16_t* vsrc = Vh + (long)(16 * (wid & 3) + (lane >> 2)) * AW + (wid >> 2) * 32 + (lane & 3) * 8;
    const int koff = wid * 1024 + lane * 16;
    const int vb0 = (int)(lds0 + L_V) + ((lane >> 4) & 1) * 32 + (lane & 3) * 8 + (4 * hi + ((lane & 15) >> 2)) * 64;
    int t = NT - 1;
    u32x4 kA = *(const u32x4*)(ksrc + (long)t * 64 * AW), vA = *(const u32x4*)(vsrc + (long)t * 64 * AW);
    float bA = (tid < 64) ? (cref - cum[64 * t + tid]) : 0.f;
    u32x4 kB = kA, vB = vA; float bB = 0.f;
    if (t - 1 >= tile_lo) { kB = *(const u32x4*)(ksrc + (long)(t - 1) * 64 * AW); vB = *(const u32x4*)(vsrc + (long)(t - 1) * 64 * AW); bB = (tid < 64) ? (cref - cum[64 * (t - 1) + tid]) : 0.f; }
    float mhat = -1e30f, l_reg = 0.f; f32x16 o[2]; o[0] = f32x16{}; o[1] = f32x16{};
    const int qrel = wid * 32 + r32;
    int cur = 0, vcur = 0, vprev = 2;
    u32x4 pw0 = (u32x4){0u, 0u, 0u, 0u}, pw1 = pw0, pw2 = pw0, pw3 = pw0;
#define ATT_STEP(KR, VR, BR) do { \
        *(LAS u32x4*)(shm + L_K + cur * SLOTB + koff) = KR; *(LAS u32x4*)(shm + L_V + vcur * SLOTB + koff) = VR; \
        if (tid < 64) *(LAS float*)(shm + L_B + cur * 256 + tid * 4) = BR; \
        asm volatile("s_waitcnt lgkmcnt(0)\n\ts_barrier" ::: "memory");     \
        if (t - 2 >= tile_lo) { KR = *(const u32x4*)(ksrc + (long)(t - 2) * 64 * AW); VR = *(const u32x4*)(vsrc + (long)(t - 2) * 64 * AW); BR = (tid < 64) ? (cref - cum[64 * (t - 2) + tid]) : 0.f; } \
        att_tile(); \
    } while (0)
    auto att_tile = [&]() __attribute__((always_inline)) {
        const int jb = t - (NT - 4);
        if (jb <= (wid >> 1)) {
            f32x16 p0, p1;
            { const LAS float* bb = (const LAS float*)(shm + L_B + cur * 256);
#pragma unroll
              for (int g4 = 0; g4 < 4; ++g4) { const f32x4 a = *(const LAS f32x4*)(bb + 8 * g4 + 4 * hi), c = *(const LAS f32x4*)(bb + 32 + 8 * g4 + 4 * hi);
#pragma unroll
                  for (int e = 0; e < 4; ++e) { p0[4 * g4 + e] = a[e]; p1[4 * g4 + e] = c[e]; } } }
            { const LAS unsigned char* kb = shm + L_K + cur * SLOTB + hi * 1024 + r32 * 16;
              __builtin_amdgcn_s_setprio(1);
#pragma unroll
              for (int d0 = 0; d0 < 4; ++d0) { const bf16x8 b0 = *(const LAS bf16x8*)(kb + d0 * 2048), b1 = *(const LAS bf16x8*)(kb + d0 * 2048 + 512);
                  p0 = __builtin_amdgcn_mfma_f32_32x32x16_bf16(b0, qr[d0], p0, 0, 0, 0); p1 = __builtin_amdgcn_mfma_f32_32x32x16_bf16(b1, qr[d0], p1, 0, 0, 0); } }
            pv(o, vb0 + vprev * SLOTB, __builtin_bit_cast(bf16x8, pw0), __builtin_bit_cast(bf16x8, pw1), __builtin_bit_cast(bf16x8, pw2), __builtin_bit_cast(bf16x8, pw3));
            __builtin_amdgcn_s_setprio(0);
            if (jb >= 0) { const int kb0 = 64 * jb + 4 * hi;
#pragma unroll
                for (int r = 0; r < 16; ++r) { const int kv = kb0 + (r & 3) + 8 * (r >> 2); if (kv > qrel) p0[r] = -INFINITY; if (kv + 32 > qrel) p1[r] = -INFINITY; } }
            const float rm = rowmax(p0, p1);
            const float mnew = fmaxf(mhat, rm);
            if (__any(mnew > mhat)) {
                const float alpha = __builtin_amdgcn_exp2f(mhat - mnew); l_reg *= alpha; mhat = mnew;
                if (hi == 0) wsf[r32] = alpha;
                asm volatile("s_waitcnt lgkmcnt(0)" ::: "memory");
#pragma unroll
                for (int r = 0; r < 16; ++r) { const float f = wsf[crow(r, hi)]; o[0][r] *= f; o[1][r] *= f; }
            }
            float sacc = 0.f;
#pragma unroll
            for (int r = 0; r < 16; ++r) { p0[r] = __builtin_amdgcn_exp2f(p0[r] - mhat); p1[r] = __builtin_amdgcn_exp2f(p1[r] - mhat); sacc += p0[r] + p1[r]; }
            l_reg += sacc;
            pw0 = (u32x4){cvtpk_s(p0[0], p0[1]), cvtpk_s(p0[2], p0[3]), cvtpk_s(p0[4], p0[5]), cvtpk_s(p0[6], p0[7])};
            pw1 = (u32x4){cvtpk_s(p0[8], p0[9]), cvtpk_s(p0[10], p0[11]), cvtpk_s(p0[12], p0[13]), cvtpk_s(p0[14], p0[15])};
            pw2 = (u32x4){cvtpk_s(p1[0], p1[1]), cvtpk_s(p1[2], p1[3]), cvtpk_s(p1[4], p1[5]), cvtpk_s(p1[6], p1[7])};
            pw3 = (u32x4){cvtpk_s(p1[8], p1[9]), cvtpk_s(p1[10], p1[11]), cvtpk_s(p1[12], p1[13]), cvtpk_s(p1[14], p1[15])};
        }
        cur ^= 1; vprev = vcur; vcur = (vcur == 2) ? 0 : vcur + 1;
        if (jb == 0 && tile_lo < NT - 4) {
            float mm = mhat;
#pragma unroll
            for (int o2 = 1; o2 < 64; o2 <<= 1) mm = fminf(mm, __shfl_xor(mm, o2));
            LAS float* mw = (LAS float*)(shm + L_CNT) + 8;
            if (lane == 0) mw[wid] = mm;
            __syncthreads();
            float mmin = mw[0];
#pragma unroll
            for (int w = 1; w < 8; ++w) mmin = fminf(mmin, mw[w]);
            const float X2 = SKIP_LOG2 + Sb - mmin;
            const int pred2 = (tid < 4 * qb && bend < -X2) ? 1 : 0;
            { const unsigned long long bal = __ballot(pred2); if (lane == 0) cnt[wid] = __popcll(bal); }
            __syncthreads();
            int tl2 = 0;
#pragma unroll
            for (int w = 0; w < 8; ++w) tl2 += cnt[w];
            tile_lo = tl2 > tile_lo ? tl2 : tile_lo;
        }
    };
    for (;;) {
        ATT_STEP(kA, vA, bA); --t; if (t < tile_lo) break;
        ATT_STEP(kB, vB, bB); --t; if (t < tile_lo) break;
    }
#undef ATT_STEP
    pv(o, vb0 + vprev * SLOTB, __builtin_bit_cast(bf16x8, pw0), __builtin_bit_cast(bf16x8, pw1), __builtin_bit_cast(bf16x8, pw2), __builtin_bit_cast(bf16x8, pw3));
    { auto rr = __builtin_amdgcn_permlane32_swap(__float_as_uint(l_reg), __float_as_uint(l_reg), false, false); l_reg = __uint_as_float(rr[0]) + __uint_as_float(rr[1]); }
    if (hi == 0) wsf[32 + r32] = l_reg;
    asm volatile("s_waitcnt lgkmcnt(0)" ::: "memory");
    LAS float* stg = (LAS float*)(shm + L_OST) + wid * 2048;
#pragma unroll
    for (int r = 0; r < 16; ++r) { const int orow = crow(r, hi); const float rl = __builtin_amdgcn_rcpf(wsf[32 + orow]);
        stg[orow * 64 + r32] = o[0][r] * rl; stg[orow * 64 + 32 + r32] = o[1][r] * rl; }
    asm volatile("s_waitcnt lgkmcnt(0)" ::: "memory");
    const bf16_t* GAw = (const bf16_t*)(ws + WS_GA) + (rowbase + q0 + wid * 32) * AW + h * HD;
    bf16_t* Ow = (bf16_t*)(ws + WS_YA) + (rowbase + q0 + wid * 32) * AW + h * HD;
#pragma unroll
    for (int i = 0; i < 4; ++i) { const int row = i * 8 + (lane >> 3), ch = lane & 7;
        f32x4 a = *(const LAS f32x4*)(stg + row * 64 + ch * 8), c = *(const LAS f32x4*)(stg + row * 64 + ch * 8 + 4);
        f32x4 g0, g1; unpack8(*(const u32x4*)(GAw + (long)row * AW + ch * 8), g0, g1);
        *(u32x4*)(Ow + (long)row * AW + ch * 8) = pack8(a * g0, c * g1); }
    __syncthreads();
}
}

__device__ __forceinline__ unsigned f2bf(float f) { unsigned u = __builtin_bit_cast(unsigned, f); return (u + 0x7fffu + ((u >> 16) & 1u)) >> 16; }
__device__ __forceinline__ unsigned pk2(float lo, float hi) { return f2bf(lo) | (f2bf(hi) << 16); }
__device__ __forceinline__ float wave_sum(float v) {
#pragma unroll
    for (int o = 1; o < 64; o <<= 1) v += __shfl_xor(v, o);
    return v;
}
__device__ __forceinline__ void transpose_item(const float* W, int K, int ldw, int N, int col_shift_from, bf16_t* WT, LAS float* scr, int item, int lane) {
    const int nblk = N / 32, kb = item / nblk, nb = item % nblk, k0 = 64 * kb, n0 = 32 * nb;
    int sc0 = n0;
    if (col_shift_from >= 0) { if (n0 >= 3072) { const int T = (n0 - 3072) >> 8, j = (n0 - 3072) & 255; sc0 = (j < 128) ? 3080 + T * 128 + j : 4104 + T * 128 + (j - 128); } else if (n0 >= 1536) sc0 = n0 + 8; }
#pragma unroll 8
    for (int i = 0; i < 32; ++i) { const int kk = 2 * i + (lane >> 5); scr[kk * 33 + (lane & 31)] = W[(size_t)(k0 + kk) * ldw + sc0 + (lane & 31)]; }
    asm volatile("s_waitcnt lgkmcnt(0)" ::: "memory");
    const int c = lane & 7;
#pragma unroll
    for (int j = 0; j < 4; ++j) { const int n = (lane >> 3) + 8 * j; const LAS float* s = scr + (8 * c) * 33 + n;
        u32x4 o; o.x = pk2(s[0 * 33], s[1 * 33]); o.y = pk2(s[2 * 33], s[3 * 33]); o.z = pk2(s[4 * 33], s[5 * 33]); o.w = pk2(s[6 * 33], s[7 * 33]);
        *(u32x4*)(WT + (size_t)(n0 + n) * K + k0 + 8 * c) = o; }
    asm volatile("s_waitcnt lgkmcnt(0)" ::: "memory");
}
__device__ __forceinline__ void sincos_d(double x, double& s, double& c) {
    const double k = rint(x * 0.63661977236758134308);
    const double r = (x - k * 1.57079632679489655800) - k * 6.123233995736766035869e-17;
    const double r2 = r * r;
    const double sp = r * (1.0 + r2 * (-1.0 / 6 + r2 * (1.0 / 120 + r2 * (-1.0 / 5040 + r2 * (1.0 / 362880 + r2 * (-1.0 / 39916800 + r2 * (1.0 / 6227020800.0)))))));
    const double cp = 1.0 + r2 * (-0.5 + r2 * (1.0 / 24 + r2 * (-1.0 / 720 + r2 * (1.0 / 40320 + r2 * (-1.0 / 3628800 + r2 * (1.0 / 479001600.0 + r2 * (-1.0 / 87178291200.0)))))));
    const int q = ((int)k) & 3;
    s = (q == 0) ? sp : (q == 1) ? cp : (q == 2) ? -sp : -cp;
    c = (q == 0) ? cp : (q == 1) ? -sp : (q == 2) ? -cp : sp;
}
__device__ __forceinline__ double exp_d(double x) {
    const double n = rint(x * 1.44269504088896340736);
    const double r = (x - n * 0.693147180369123816490) - n * 1.90821492927058770002e-10;
    double p = 1.0 / 6227020800.0;
    p = p * r + 1.0 / 479001600.0; p = p * r + 1.0 / 39916800.0; p = p * r + 1.0 / 3628800.0; p = p * r + 1.0 / 362880.0; p = p * r + 1.0 / 40320.0;
    p = p * r + 1.0 / 5040.0; p = p * r + 1.0 / 720.0; p = p * r + 1.0 / 120.0; p = p * r + 1.0 / 24.0; p = p * r + 1.0 / 6.0; p = p * r + 0.5; p = p * r + 1.0; p = p * r + 1.0;
    const long long bits = ((long long)((int)n + 1023)) << 52;
    return p * __builtin_bit_cast(double, bits);
}

__device__ __forceinline__ void ssm_ops_item(const Params& p, int g, int c, LAS unsigned char* lds) {
    typedef float f32x2 __attribute__((ext_vector_type(2)));
    LAS f32x2* P = (LAS f32x2*)lds;
    LAS f32x2* Bb = (LAS f32x2*)(lds + 33280);
    LAS f32x2* Cc = (LAS f32x2*)(lds + 41472);
    LAS float* Km = (LAS float*)(lds + 41984);
    const int tid = threadIdx.x;
    if (tid < 64) {
        const int pp = tid;
        f32x4 brv[4], biv[4];
#pragma unroll
        for (int q = 0; q < 4; ++q) { brv[q] = *(const f32x4*)(p.b_re + (g * 64 + pp) * 16 + 4 * q); biv[q] = *(const f32x4*)(p.b_im + (g * 64 + pp) * 16 + 4 * q); }
        const float ldt = p.log_dt[g], lrf = p.lam_re[g * 64 + pp], lif = p.lam_im[g * 64 + pp];
        const float crf = p.c_re[(g * 16 + c) * 64 + pp], cif = p.c_im[(g * 16 + c) * 64 + pp];
        const double dt = exp_d((double)ldt); const double lr = (double)lrf, li = (double)lif;
        const double mag = exp_d(lr * dt); double sn, cs; sincos_d(li * dt, sn, cs);
        const double abr = mag * cs, abi = mag * sn, den = lr * lr + li * li, nre = abr - 1.0;
        const double fre = (nre * lr + abi * li) / den, fim = (abi * lr - nre * li) / den;
        double pr = 1.0, pi = 0.0;
        for (int j = 0; j <= 64; ++j) { P[j * 64 + pp] = (f32x2){(float)pr, (float)pi}; const double nr = pr * abr - pi * abi, ni = pr * abi + pi * abr; pr = nr; pi = ni; }
        if (c == 0) ((f32x2*)(p.ws + WS_LAM64))[g * 64 + pp] = P[64 * 64 + pp];
#pragma unroll
        for (int q = 0; q < 16; ++q) { const double br = (double)brv[q >> 2][q & 3], bi = (double)biv[q >> 2][q & 3];
            Bb[pp * 16 + q] = (f32x2){(float)(fre * br - fim * bi), (float)(fre * bi + fim * br)}; }
        Cc[pp] = (f32x2){crf, cif};
    }
    __syncthreads();
    {
        const int j = tid >> 3, q0 = (tid & 7) * 2;
        float k0 = 0.f, k1 = 0.f;
        for (int pp = 0; pp < 64; ++pp) {
            const f32x2 cc = Cc[pp], gg = P[j * 64 + pp], b0 = Bb[pp * 16 + q0], b1 = Bb[pp * 16 + q0 + 1];
            const float clr = cc.x * gg.x - cc.y * gg.y, cli = cc.x * gg.y + cc.y * gg.x;
            k0 += clr * b0.x - cli * b0.y; k1 += clr * b1.x - cli * b1.y;
        }
        if (j == 0) { const float d = p.d_skip[g * 16 + c]; if (q0 == c) k0 += d; if (q0 + 1 == c) k1 += d; }
        Km[j * 16 + q0] = k0; Km[j * 16 + q0 + 1] = k1;
    }
    __syncthreads();
    {
        bf16_t* TZ = (bf16_t*)(p.ws + WS_TZ) + (size_t)g * 1024 * KX;
        for (int idx = tid; idx < 64 * 144; idx += 512) {
            const int t = idx / 144, i = idx % 144, col = 8 * i;
            float v[8];
            if (col >= 128) { const int s = (col - 128) >> 4, chh = (col >> 3) & 1;
                if (s <= t) { const LAS float* k = Km + (t - s) * 16 + chh * 8;
#pragma unroll
                    for (int e = 0; e < 8; ++e) v[e] = k[e]; }
                else {
#pragma unroll
                    for (int e = 0; e < 8; ++e) v[e] = 0.f; }
            } else { const int p0 = col >> 1;
#pragma unroll
                for (int e = 0; e < 4; ++e) { const f32x2 cc = Cc[p0 + e], gg = P[(t + 1) * 64 + p0 + e]; v[2 * e] = cc.x * gg.x - cc.y * gg.y; v[2 * e + 1] = -(cc.x * gg.y + cc.y * gg.x); } }
            u32x4 w; w.x = pk2(v[0], v[1]); w.y = pk2(v[2], v[3]); w.z = pk2(v[4], v[5]); w.w = pk2(v[6], v[7]);
            *(u32x4*)(TZ + (size_t)(t * 16 + c) * KX + col) = w;
        }
        bf16_t* WE = (bf16_t*)(p.ws + WS_WEND) + (size_t)g * 256 * 1024;
        for (int idx = tid; idx < 16 * 128; idx += 512) {
            const int rl = idx >> 7, i = idx & 127, s = i >> 1, chh = i & 1;
            const int row = (rl < 8) ? (8 * c + rl) : (128 + 8 * c + (rl - 8));
            float v[8];
            if (rl < 8) { const int pp = row >> 1, ri = row & 1; const f32x2 gg = P[(63 - s) * 64 + pp];
#pragma unroll
                for (int e = 0; e < 8; ++e) { const f32x2 bb = Bb[pp * 16 + chh * 8 + e]; v[e] = ri ? (gg.x * bb.y + gg.y * bb.x) : (gg.x * bb.x - gg.y * bb.y); } }
            else {
#pragma unroll
                for (int e = 0; e < 8; ++e) v[e] = 0.f; }
            u32x4 w; w.x = pk2(v[0], v[1]); w.y = pk2(v[2], v[3]); w.z = pk2(v[4], v[5]); w.w = pk2(v[6], v[7]);
            *(u32x4*)(WE + (size_t)row * 1024 + 8 * i) = w;
        }
    }
    __syncthreads();
}

#define XB_TMO      128
#define XB_XCNT(j)  (256  + 64 * (j))
#define XB_XSUB(j)  (1280 + 64 * (j))
#define XB_XGEN(j)  (2304 + 64 * (j))
#define XB_TOP      3328
#define XB_TOPGEN   3392
#define XCD_BAR_WORDS 3456
#define XB_SPIN_CAP (1u << 18)
__device__ __forceinline__ unsigned xb_ld(unsigned* p)              { return __hip_atomic_load(p, __ATOMIC_RELAXED, __HIP_MEMORY_SCOPE_AGENT); }
__device__ __forceinline__ unsigned xb_add(unsigned* p, unsigned v) { return __hip_atomic_fetch_add(p, v, __ATOMIC_RELAXED, __HIP_MEMORY_SCOPE_AGENT); }
__device__ __forceinline__ unsigned xb_xcc_id() { return (unsigned)__builtin_amdgcn_s_getreg((3 << 11) | 20) & 0xFu; }
#define XB_SPIN(cond, bar) do { unsigned _sp = 0; while (cond) { __builtin_amdgcn_s_sleep(1); \
    if ((++_sp & 255u) == 0u) { if (xb_ld(&(bar)[XB_TMO])) break; if (_sp > XB_SPIN_CAP) { atomicAdd(&(bar)[XB_TMO], 1u); break; } } } } while (0)
struct XcdBarrier { unsigned* bar; unsigned x; volatile LAS unsigned* st; };
__device__ __forceinline__ XcdBarrier xcd_barrier_post(unsigned* bar, volatile LAS unsigned* st) {
    XcdBarrier b; b.bar = bar; b.x = xb_xcc_id(); b.st = st;
    if (threadIdx.x == 0) (void)xb_add(&bar[XB_XCNT(b.x)], 1u);
    return b;
}
__device__ __forceinline__ void xcd_barrier_complete(unsigned* bar, unsigned x, unsigned& nloc, unsigned& nx) {
    const unsigned G = gridDim.x * gridDim.y * gridDim.z;
    unsigned sum, cnt, mine, sp = 0u;
    for (;;) {
        sum = 0u; cnt = 0u; mine = 0u;
#pragma unroll
        for (unsigned j = 0; j < 16; ++j) { const unsigned c = xb_ld(&bar[XB_XCNT(j)]); sum += c; cnt += (c > 0u) ? 1u : 0u; mine = (j == x) ? c : mine; }
        if (sum == G) break;
        __builtin_amdgcn_s_sleep(1);
        if ((++sp & 255u) == 0u) { if (xb_ld(&bar[XB_TMO])) break; if (sp > XB_SPIN_CAP) { atomicAdd(&bar[XB_TMO], 1u); break; } }
    }
    nloc = mine > 0u ? mine : 1u; nx = cnt > 0u ? cnt : 1u;
}
__device__ __forceinline__ void xcd_barrier(const XcdBarrier& b) {
    asm volatile("s_waitcnt vmcnt(0)" ::: "memory");
    __syncthreads();
    if (threadIdx.x == 0) {
        unsigned* bar = b.bar;
        __builtin_amdgcn_s_waitcnt(0);
        unsigned nloc = b.st[0], nx = b.st[1];
        if (nloc == 0u) { xcd_barrier_complete(bar, b.x, nloc, nx); b.st[0] = nloc; b.st[1] = nx; }
        const unsigned old = xb_add(&bar[XB_XSUB(b.x)], 1u);
        const unsigned gen = old / nloc;
        if (old + 1u == (gen + 1u) * nloc) {
            __builtin_amdgcn_fence(__ATOMIC_RELEASE, "agent");
            asm volatile("s_waitcnt vmcnt(0)" ::: "memory");
            const unsigned og = xb_add(&bar[XB_TOP], 1u);
            const unsigned tg = og / nx;
            if (og + 1u == (tg + 1u) * nx) xb_add(&bar[XB_TOPGEN], 1u);
            else XB_SPIN(xb_ld(&bar[XB_TOPGEN]) == tg, bar);
            __builtin_amdgcn_fence(__ATOMIC_ACQUIRE, "agent");
            xb_add(&bar[XB_XGEN(b.x)], 1u);
            asm volatile("s_waitcnt vmcnt(0)" ::: "memory");
        } else {
            XB_SPIN(xb_ld(&bar[XB_XGEN(b.x)]) == gen, bar);
            __builtin_amdgcn_fence(__ATOMIC_ACQUIRE, "agent");
            asm volatile("s_waitcnt vmcnt(0)" ::: "memory");
        }
    }
    __syncthreads();
}

__global__ void __launch_bounds__(512) fwd_megakernel(Params p) {
    extern __shared__ __attribute__((aligned(16))) unsigned char lds_raw[];
    LAS unsigned char* lds = (LAS unsigned char*)lds_raw;
    cg::grid_group grid = cg::this_grid();
    const int tid = threadIdx.x, lane = tid & 63, wave = __builtin_amdgcn_readfirstlane(tid >> 6);
    const int G = gridDim.x, bx = blockIdx.x;
    unsigned char* ws = p.ws;
    const int lo = p.ph_lo, hi = p.ph_hi;
#define IN(k) (lo <= (k) && (k) < hi)
    volatile LAS unsigned* bst = (volatile LAS unsigned*)(lds + 131072 + 128);
    if (tid == 0) { bst[0] = 0u; bst[1] = 0u; }
    __syncthreads();
    XcdBarrier xbar; xbar.bar = (unsigned*)(ws + WS_BAR); xbar.x = 0; xbar.st = bst;
#define SEAM(k) do { if (IN(k) && IN((k) + 1)) { if ((k) == 0) { grid.sync(); xbar = xcd_barrier_post((unsigned*)(ws + WS_BAR), bst); } else xcd_barrier(xbar); } } while (0)

    if (IN(0)) {
        for (int i = bx * 512 + tid; i < MTOK; i += G * 512) ((float*)(ws + WS_SUMSQ))[i] = 0.f;
        if (bx == 0) for (int i = tid; i < 2048; i += 512) ((unsigned*)(ws + WS_NRM))[i] = 0u;
        if (bx == 1 || G == 1) for (int i = tid; i < 256 * 64; i += 512) ((unsigned*)(ws + WS_CNT))[i] = 0u;
        if (bx == 2 || G < 3) for (int i = tid; i < XCD_BAR_WORDS; i += 512) ((unsigned*)(ws + WS_BAR))[i] = 0u;
        const int gw = bx * 8 + wave, NGW = G * 8;
        auto partL = [&]() __attribute__((always_inline)) {
        for (int it = bx; it < NG * 16; it += G) ssm_ops_item(p, it >> 4, it & 15, lds);
        LAS float* scr = (LAS float*)(lds + wave * 8704);
        constexpr int I_IN = 16 * (NPROJ / 32), I_GLU = 8 * 16, I_A = 8 * 32, I_S = 8 * 32, I_O = 16 * 32, NIT = I_IN + I_GLU + I_A + I_S + I_O;
        for (int it = gw; it < NIT; it += NGW) {
            int r = it;
            if (r < I_IN) { transpose_item(p.w_in, DM, INC, NPROJ, 0, (bf16_t*)(ws + WS_WIN), scr, r, lane); continue; } r -= I_IN;
            if (r < I_GLU) { transpose_item(p.w_glu, SW, SW, SW, -1, (bf16_t*)(ws + WS_WGLU), scr, r, lane); continue; } r -= I_GLU;
            if (r < I_A) { transpose_item(p.w_a, AW, DM, DM, -1, (bf16_t*)(ws + WS_WA), scr, r, lane); continue; } r -= I_A;
            if (r < I_S) { transpose_item(p.w_s, SW, DM, DM, -1, (bf16_t*)(ws + WS_WS), scr, r, lane); continue; } r -= I_S;
            transpose_item(p.w_out, DM, DM, DM, -1, (bf16_t*)(ws + WS_WOUT), scr, r, lane);
        }
        };
        auto partR = [&]() __attribute__((always_inline)) {
        LAS float* wf = (LAS float*)(lds + 73728);
        {
            f32x4 wa[2][2];
#pragma unroll
            for (int q = 0; q < 2; ++q) { const float* src = p.w_in + (size_t)(tid + 512 * q) * INC + 1536; wa[q][0] = *(const f32x4*)src; wa[q][1] = *(const f32x4*)(src + 4); }
#pragma unroll
            for (int q = 0; q < 2; ++q)
#pragma unroll
                for (int j = 0; j < 8; ++j) wf[j * 1024 + tid + 512 * q] = wa[q][j >> 2][j & 3];
        }
        __syncthreads();
        f32x4 gn[4];
#pragma unroll
        for (int j = 0; j < 4; ++j) gn[j] = ((const f32x4*)p.norm_pre)[lane + 64 * j];
        f32x4 wreg[8][4];
#pragma unroll
        for (int e = 0; e < 8; ++e)
#pragma unroll
            for (int j = 0; j < 4; ++j) wreg[e][j] = *(const LAS f32x4*)(wf + e * 1024 + 4 * lane + 256 * j);
        const int fidx = ((lane & 1) << 2) | (lane & 2) | ((lane & 4) >> 2);
        const float bfg = p.b_forget[fidx];
        f32x4 vn[4];
        if (gw < MTOK) {
#pragma unroll
            for (int j = 0; j < 4; ++j) vn[j] = ((const f32x4*)(p.x + (size_t)gw * DM) + lane)[64 * j];
        }
        for (int m = gw; m < MTOK; m += NGW) {
            f32x4 v[4]; float s = 0.f;
#pragma unroll
            for (int j = 0; j < 4; ++j) v[j] = vn[j];
            if (m + NGW < MTOK) {
#pragma unroll
                for (int j = 0; j < 4; ++j) vn[j] = ((const f32x4*)(p.x + (size_t)(m + NGW) * DM) + lane)[64 * j];
            }
#pragma unroll
            for (int j = 0; j < 4; ++j) s += (v[j][0] * v[j][0] + v[j][1] * v[j][1]) + (v[j][2] * v[j][2] + v[j][3] * v[j][3]);
            const float rstd = 1.0f / sqrtf(wave_sum(s) * (1.f / DM) + 1e-6f);
            if (lane == 0) ((float*)(ws + WS_RSTD))[m] = rstd;
            unsigned long long* o8 = (unsigned long long*)((bf16_t*)(ws + WS_H) + (size_t)m * DM) + lane;
            float fa[8];
#pragma unroll
            for (int e = 0; e < 8; ++e) fa[e] = 0.f;
#pragma unroll
            for (int j = 0; j < 4; ++j) { v[j] = v[j] * rstd * gn[j];
                o8[64 * j] = (unsigned long long)pk2(v[j][0], v[j][1]) | ((unsigned long long)pk2(v[j][2], v[j][3]) << 32);
#pragma unroll
                for (int e = 0; e < 8; ++e) { const f32x4 w = wreg[e][j]; fa[e] += (v[j][0] * w[0] + v[j][1] * w[1]) + (v[j][2] * w[2] + v[j][3] * w[3]); } }
#pragma unroll
            for (int e = 0; e < 4; ++e) { const float a = fa[e], c = fa[e + 4]; const bool up = lane & 1; fa[e] = (up ? c : a) + __shfl_xor(up ? a : c, 1); }
#pragma unroll
            for (int e = 0; e < 2; ++e) { const float a = fa[e], c = fa[e + 2]; const bool up = lane & 2; fa[e] = (up ? c : a) + __shfl_xor(up ? a : c, 2); }
            { const float a = fa[0], c = fa[1]; const bool up = lane & 4; fa[0] = (up ? c : a) + __shfl_xor(up ? a : c, 4); }
            float z = fa[0];
            z += __shfl_xor(z, 8); z += __shfl_xor(z, 16); z += __shfl_xor(z, 32);
            if (lane < 8) { z += bfg;
                const float ls = fminf(z, 0.f) - log1pf(expf(-fabsf(z)));
                ((float*)(ws + WS_LOGF))[(size_t)m * 8 + fidx] = ls; }
        }
        };
        if ((bx >> 3) & 1) { partR(); __syncthreads(); partL(); } else { partL(); __syncthreads(); partR(); }
        __syncthreads();
    }
    SEAM(0);

    if (IN(1)) {
        for (int bh = bx; bh < BATCH * NH; bh += G) {
            const int b = bh >> 3, h = bh & 7;
            const float* lf = (const float*)(ws + WS_LOGF) + (size_t)b * SEQ * 8 + h;
            float v[16]; float s = 0.f;
#pragma unroll
            for (int e = 0; e < 16; ++e) { s += lf[(size_t)(tid * 16 + e) * 8]; v[e] = s; }
            float incl = s;
#pragma unroll
            for (int o = 1; o < 64; o <<= 1) { const float n = __shfl_up(incl, o); if (lane >= o) incl += n; }
            LAS float* wt = (LAS float*)lds;
            if (lane == 63) wt[wave] = incl;
            __syncthreads();
            float base = incl - s;
            for (int w = 0; w < wave; ++w) base += wt[w];
            float* co = (float*)(ws + WS_CUM) + (size_t)bh * SEQ + tid * 16;
#pragma unroll
            for (int e = 0; e < 16; ++e) co[e] = (base + v[e]) * LOG2E;
            __syncthreads();
        }
        pg8::Gemm g{(const bf16_t*)(ws + WS_H), (const bf16_t*)(ws + WS_WIN), DM, DM, DM, 0, 0, nullptr, nullptr, 0, 16};
        pg8::TileOrder S{MTOK / 256, NPROJ / 256, 1, G, bx, 1};
        EpiProj E{ws};
        pg8::gemm_phase(lds, g, S, E);
    }
    SEAM(1);

    if (IN(2)) {
        {
            pg8::Gemm g{(const bf16_t*)(ws + WS_U2) + 128, (const bf16_t*)(ws + WS_WEND), 1024, KX, 1024, (long)NCHK * KX, 256L * 1024, nullptr, nullptr, 0, 16};
            pg8::TileOrder S{NCHK / 256, 1, NG, G, G - 1 - bx, 0};
            EpiSsmE E{(float*)(ws + WS_E)};
            pg8::gemm_phase(lds, g, S, E);
        }
        __syncthreads();
        {
            unsigned* uctr = (unsigned*)(ws + WS_NRM) + 1024;
            LAS int* nxt = (LAS int*)(lds + 131072 + 256);
            for (;;) {
                if (tid == 0) *nxt = (int)atomicAdd(uctr, 1u);
                __syncthreads();
                const int uidx = *nxt;
                __syncthreads();
                if (uidx >= BATCH * NH * 32) break;
                const int bh = uidx & 63, qb = 31 - (uidx >> 6);
                att::attn_unit(bh >> 3, bh & 7, qb, ws, lds);
            }
        }
    }
    SEAM(2);

    if (IN(3)) {
        typedef float f32x2 __attribute__((ext_vector_type(2)));
        LAS f32x2* ex = (LAS f32x2*)lds;
        for (int idx = bx; idx < BATCH * NG; idx += G) {
            const int b = idx >> 5, g = idx & 31, pp = lane;
            const f32x2 L = ((const f32x2*)(ws + WS_LAM64))[g * 64 + pp];
            f32x2 L16 = L;
#pragma unroll
            for (int q = 0; q < 4; ++q) L16 = (f32x2){L16.x * L16.x - L16.y * L16.y, 2.f * L16.x * L16.y};
            const float* Eb = (const float*)(ws + WS_E) + ((size_t)(g * NCHK + b * 128 + 16 * wave) * 128 + 2 * pp);
            bf16_t* Ub = (bf16_t*)(ws + WS_U2) + ((size_t)(g * NCHK + b * 128 + 16 * wave) * KX + 2 * pp);
            f32x2 e[16];
#pragma unroll
            for (int j = 0; j < 16; ++j) e[j] = *(const f32x2*)(Eb + (size_t)j * 128);
            float sr = 0.f, si = 0.f;
#pragma unroll
            for (int j = 0; j < 16; ++j) { const float nr = L.x * sr - L.y * si + e[j].x, ni = L.x * si + L.y * sr + e[j].y; sr = nr; si = ni; }
            ex[wave * 64 + pp] = (f32x2){sr, si};
            __syncthreads();
            sr = 0.f; si = 0.f;
            for (int w = 0; w < wave; ++w) { const f32x2 en = ex[w * 64 + pp]; const float nr = L16.x * sr - L16.y * si + en.x, ni = L16.x * si + L16.y * sr + en.y; sr = nr; si = ni; }
#pragma unroll
            for (int j = 0; j < 16; ++j) {
                *(unsigned*)(Ub + (size_t)j * KX) = pk2(sr, si);
                const float nr = L.x * sr - L.y * si + e[j].x, ni = L.x * si + L.y * sr + e[j].y; sr = nr; si = ni;
            }
            __syncthreads();
        }
    }
    SEAM(3);

    if (IN(4)) {
        pg8::Gemm g{(const bf16_t*)(ws + WS_U2), (const bf16_t*)(ws + WS_TZ), KX, KX, KX, (long)NCHK * KX, 1024L * KX, nullptr, nullptr, 0, 16};
        pg8::SsmYOrder S{G, bx};
        EpiSsmY E{(bf16_t*)(ws + WS_YS)};
        pg8::gemm_phase(lds, g, S, E);
    }
    SEAM(4);

    if (IN(5)) {
        pg8::Gemm g{(const bf16_t*)(ws + WS_YS), (const bf16_t*)(ws + WS_WGLU), SW, 16, SW, 0, 0, nullptr, nullptr, 0, (long)MTOK * 16};
        pg8::TileOrder S{MTOK / 256, SW / 256, 1, G, bx, 1};
        EpiGlu E{(const bf16_t*)(ws + WS_YS), (const bf16_t*)(ws + WS_GS), p.b_glu, (bf16_t*)(ws + WS_YS2)};
        pg8::gemm_phase(lds, g, S, E);
    }
    SEAM(5);

    if (IN(6)) {
        pg8::Gemm g{(const bf16_t*)(ws + WS_YA), (const bf16_t*)(ws + WS_WA), 1024, 512, 512, 0, 0, (const bf16_t*)(ws + WS_YS2), (const bf16_t*)(ws + WS_WS), 8, 16};
        pg8::TileOrder S{MTOK / 256, DM / 256, 1, G, bx, 1};
        EpiMerge E{(const bf16_t*)(ws + WS_MIXA), (const bf16_t*)(ws + WS_MIXS), (bf16_t*)(ws + WS_MERGED)};
        pg8::gemm_phase(lds, g, S, E);
    }
    SEAM(6);

    if (IN(7)) {
        pg8::Gemm g{(const bf16_t*)(ws + WS_MERGED), (const bf16_t*)(ws + WS_WOUT), DM, DM, DM, 0, 0, nullptr, nullptr, 0, 16};
        pg8::TileOrder S{MTOK / 256, DM / 256, 1, G, bx, 1};
        EpiOut E{(bf16_t*)(ws + WS_PRE), (float*)(ws + WS_SUMSQ)};
        pg8::gemm_phase(lds, g, S, E);
    }

    SEAM(7);

    if (IN(8)) {
        const int gw = bx * 8 + wave, NGW = G * 8;
        f32x4 gn[4], ig[4]; bool gsmall = false;
#pragma unroll
        for (int j = 0; j < 4; ++j) { gn[j] = ((const f32x4*)p.norm_post)[lane + 64 * j]; const f32x4 g = ((const f32x4*)p.norm_pre)[lane + 64 * j];
#pragma unroll
            for (int e = 0; e < 4; ++e) { gsmall = gsmall || (fabsf(g[e]) < 1e-2f); ig[j][e] = 1.0f / g[e]; } }
        const bool use_x = __any(gsmall ? 1 : 0) != 0;
        for (int m = gw; m < MTOK; m += NGW) {
            const float rstd = 1.0f / sqrtf(((const float*)(ws + WS_SUMSQ))[m] * (1.f / DM) + 1e-6f);
            f32x4* orow = (f32x4*)(p.out + (size_t)m * DM) + lane;
            const unsigned long long* pr = (const unsigned long long*)((const bf16_t*)(ws + WS_PRE) + (size_t)m * DM) + lane;
            f32x4 xv[4]; unsigned long long pv8[4];
            if (!use_x) {
                const unsigned long long* hr = (const unsigned long long*)((const bf16_t*)(ws + WS_H) + (size_t)m * DM) + lane;
                const float inv = 1.0f / ((const float*)(ws + WS_RSTD))[m];
                unsigned long long h8[4];
#pragma unroll
                for (int j = 0; j < 4; ++j) { h8[j] = hr[64 * j]; pv8[j] = pr[64 * j]; }
#pragma unroll
                for (int j = 0; j < 4; ++j) { const unsigned lo32 = (unsigned)h8[j], hi32 = (unsigned)(h8[j] >> 32);
                    xv[j] = (f32x4){bf_lo(lo32), bf_hi(lo32), bf_lo(hi32), bf_hi(hi32)} * ig[j] * inv; }
            } else {
                const f32x4* xr = (const f32x4*)(p.x + (size_t)m * DM) + lane;
#pragma unroll
                for (int j = 0; j < 4; ++j) { xv[j] = xr[64 * j]; pv8[j] = pr[64 * j]; }
            }
#pragma unroll
            for (int j = 0; j < 4; ++j) { const unsigned lo32 = (unsigned)pv8[j], hi32 = (unsigned)(pv8[j] >> 32);
                const f32x4 pf = (f32x4){bf_lo(lo32), bf_hi(lo32), bf_lo(hi32), bf_hi(hi32)};
                orow[64 * j] = xv[j] + pf * rstd * gn[j]; }
        }
    }
#undef IN
#undef SEAM
}

extern "C" void kernel_launch(void* const* d_in, const int* in_sizes, int n_in, void* d_out, int out_size, void* d_ws, size_t ws_size, hipStream_t stream) {
    static int grid = 0;
    if (grid == 0) {
        if (n_in != 18 || out_size != MTOK * DM || ws_size < WS_END) { fprintf(stderr, "kernel_launch: unexpected shapes (n_in %d, out %d, ws %zu)\n", n_in, out_size, ws_size); grid = -1; return; }
        int dev = 0, cus = 0, per_cu = 0;
        hipGetDevice(&dev); hipDeviceGetAttribute(&cus, hipDeviceAttributeMultiprocessorCount, dev);
        if (hipFuncSetAttribute((const void*)fwd_megakernel, hipFuncAttributeMaxDynamicSharedMemorySize, LDS_BYTES) != hipSuccess) { fprintf(stderr, "kernel_launch: hipFuncSetAttribute failed\n"); grid = -1; return; }
        if (hipOccupancyMaxActiveBlocksPerMultiprocessor(&per_cu, (const void*)fwd_megakernel, 512, LDS_BYTES) != hipSuccess || per_cu < 1) { fprintf(stderr, "kernel_launch: occupancy query says %d\n", per_cu); per_cu = 1; }
        (void)hipGetLastError();
        grid = cus < 256 ? cus : 256;
    }
    if (grid < 0) return;
    Params p{};
    p.x = (const float*)d_in[0]; p.norm_pre = (const float*)d_in[1]; p.w_in = (const float*)d_in[2]; p.b_forget = (const float*)d_in[3];
    p.lam_re = (const float*)d_in[4]; p.lam_im = (const float*)d_in[5]; p.log_dt = (const float*)d_in[6]; p.b_re = (const float*)d_in[7]; p.b_im = (const float*)d_in[8];
    p.c_re = (const float*)d_in[9]; p.c_im = (const float*)d_in[10]; p.d_skip = (const float*)d_in[11]; p.w_glu = (const float*)d_in[12]; p.b_glu = (const float*)d_in[13];
    p.w_a = (const float*)d_in[14]; p.w_s = (const float*)d_in[15]; p.w_out = (const float*)d_in[16]; p.norm_post = (const float*)d_in[17];
    p.out = (float*)d_out; p.ws = (unsigned char*)d_ws;
#if MK_MULTI
    for (int ph = 0; ph < 9; ++ph) { p.ph_lo = ph; p.ph_hi = ph + 1; hipLaunchKernelGGL(fwd_megakernel, dim3(grid), dim3(512), LDS_BYTES, stream, p); }
#else
    p.ph_lo = 0; p.ph_hi = 9;
    void* args[] = {&p};
    hipError_t e = hipLaunchCooperativeKernel((const void*)fwd_megakernel, dim3(grid), dim3(512), args, LDS_BYTES, stream);
    if (e != hipSuccess) fprintf(stderr, "cooperative launch failed: %s (grid %d)\n", hipGetErrorString(e), grid);
#endif
}
```
